# Optimizing an MI355X kernel written in HIP

```python
import math
import jax, jax.numpy as jnp
from jax import lax
import numpy as np

D_MODEL = 1024
BATCH = 8
SEQ = 2048
DEPTH = 1

N_HEADS_ATTN = 8
HEAD_DIM = 64
ATTN_WIDTH = N_HEADS_ATTN * HEAD_DIM
KV_LATENT = 128
N_HEADS_IDX = 8
IDX_DIM = 64
TOPK_MAX = 256
Q_BLOCK = 128
CONV_WIDTH = 512
CONV_GROUPS = 8
CONV_K = 3
MIX_WIDTH = ATTN_WIDTH + CONV_WIDTH
D_FF = 2816
N_BUCKETS = 32
MAX_DISTANCE = 128
EPS = 1e-6
IN_SIZES = (ATTN_WIDTH, KV_LATENT, N_HEADS_IDX * IDX_DIM, IDX_DIM, N_HEADS_IDX, CONV_WIDTH, CONV_WIDTH, CONV_WIDTH)
IN_WIDTH = ATTN_WIDTH + KV_LATENT + N_HEADS_IDX * IDX_DIM + IDX_DIM + N_HEADS_IDX + 3 * CONV_WIDTH

kernel_name = "hybrid_dsa_shortconv_macaron"


def rmsnorm(x, g):
    xf = x.astype(jnp.float32)
    y = xf * lax.rsqrt(jnp.mean(xf * xf, axis=-1, keepdims=True) + EPS)
    return (y * g.astype(jnp.float32)).astype(x.dtype)


def swiglu(x, w_gate, w_up, w_down):
    return (jax.nn.silu(x @ w_gate) * (x @ w_up)) @ w_down


def rel_bucket(dist):
    max_exact = N_BUCKETS // 2
    d = jnp.maximum(dist, 1).astype(jnp.float32)
    large = max_exact + (jnp.log(d / max_exact) / math.log(MAX_DISTANCE / max_exact)
                         * (N_BUCKETS - max_exact)).astype(jnp.int32)
    large = jnp.minimum(large, N_BUCKETS - 1)
    return jnp.where(dist < max_exact, dist, large)


def dsa_attention(q, c_kv, q_idx, k_idx, w_idx, w_uk, w_uv, rel_bias, n_keep):
    B, S = q.shape[0], q.shape[1]
    nb = S // Q_BLOCK
    q_abs = jnp.einsum('bshd,chd->bshc', q, w_uk)
    key_pos = jnp.arange(S, dtype=jnp.int32)
    idx_scale = (N_HEADS_IDX * IDX_DIM) ** -0.5

    def to_blocks(a):
        return jnp.moveaxis(a.reshape((B, nb, Q_BLOCK) + a.shape[2:]), 1, 0)

    def one_block(args):
        qa, qi, wi, start = args
        qpos = start + jnp.arange(Q_BLOCK, dtype=jnp.int32)
        dots = jnp.einsum('bthd,bsd->bths', qi, k_idx).astype(jnp.float32)
        score = jnp.einsum('bth,bths->bts', wi.astype(jnp.float32) * idx_scale, jax.nn.relu(dots))
        causal = key_pos[None, :] <= qpos[:, None]
        score = jnp.where(causal[None], score, -jnp.inf)
        _, sel = lax.top_k(score, n_keep)
        valid = sel <= qpos[None, :, None]
        ckv_sel = jax.vmap(lambda c, i: c[i])(c_kv, sel)
        logits = jnp.einsum('bthc,btkc->bthk', qa, ckv_sel).astype(jnp.float32) * (HEAD_DIM ** -0.5)
        bias = rel_bias[rel_bucket(qpos[None, :, None] - sel)]
        logits = logits + jnp.moveaxis(bias, -1, 2).astype(jnp.float32)
        logits = jnp.where(valid[:, :, None, :], logits, -jnp.inf)
        p = jax.nn.softmax(logits, axis=-1).astype(c_kv.dtype)
        return jnp.einsum('bthk,btkc->bthc', p, ckv_sel)

    starts = jnp.arange(nb, dtype=jnp.int32) * Q_BLOCK
    ctx = lax.map(one_block, (to_blocks(q_abs), to_blocks(q_idx), to_blocks(w_idx), starts))
    ctx = jnp.moveaxis(ctx, 0, 1).reshape(B, S, N_HEADS_ATTN, KV_LATENT)
    out = jnp.einsum('bshc,chd->bshd', ctx, w_uv)
    return out.reshape(B, S, ATTN_WIDTH)


def short_conv(gate_b, gate_c, u, conv_w):
    v = gate_c * u
    S = v.shape[1]
    vp = jnp.pad(v, ((0, 0), (CONV_K - 1, 0), (0, 0)))
    y = conv_w[0] * vp[:, 0:S]
    for j in range(1, CONV_K):
        y = y + conv_w[j] * vp[:, j:j + S]
    return gate_b * y


def setup_inputs(seed: int = 0) -> dict:
    key = jax.random.key(seed)
    ks = jax.random.split(key, 24)
    f32 = jnp.float32

    def w(k, shape, fan_in):
        return jax.random.normal(k, shape, f32) * (fan_in ** -0.5)

    def gain(k, shape):
        return 1.0 + 0.01 * jax.random.normal(k, shape, f32)

    L = DEPTH
    return {
        "x": jax.random.normal(ks[0], (BATCH, SEQ, D_MODEL), f32),
        "ffn1_norm": gain(ks[1], (L, D_MODEL)),
        "ffn1_w_gate": w(ks[2], (L, D_MODEL, D_FF), D_MODEL),
        "ffn1_w_up": w(ks[3], (L, D_MODEL, D_FF), D_MODEL),
        "ffn1_w_down": w(ks[4], (L, D_FF, D_MODEL), D_FF),
        "mix_norm": gain(ks[5], (L, D_MODEL)),
        "w_in": w(ks[6], (L, D_MODEL, IN_WIDTH), D_MODEL),
        "kv_norm": gain(ks[7], (L, KV_LATENT)),
        "w_uk": w(ks[8], (L, KV_LATENT, N_HEADS_ATTN, HEAD_DIM), KV_LATENT),
        "w_uv": w(ks[9], (L, KV_LATENT, N_HEADS_ATTN, HEAD_DIM), KV_LATENT),
        "rel_bias": 0.5 * jax.random.normal(ks[10], (N_BUCKETS, N_HEADS_ATTN), f32),
        "conv_w": w(ks[11], (L, CONV_K, CONV_WIDTH), CONV_K),
        "attn_out_norm": gain(ks[12], (L, ATTN_WIDTH)),
        "conv_out_norm": gain(ks[13], (L, CONV_WIDTH)),
        "w_out": w(ks[14], (L, MIX_WIDTH, D_MODEL), MIX_WIDTH),
        "ffn2_norm": gain(ks[15], (L, D_MODEL)),
        "ffn2_w_gate": w(ks[16], (L, D_MODEL, D_FF), D_MODEL),
        "ffn2_w_up": w(ks[17], (L, D_MODEL, D_FF), D_MODEL),
        "ffn2_w_down": w(ks[18], (L, D_FF, D_MODEL), D_FF),
        "final_norm": gain(ks[19], (D_MODEL,)),
    }


def reference(x, ffn1_norm, ffn1_w_gate, ffn1_w_up, ffn1_w_down, mix_norm, w_in, kv_norm,
              w_uk, w_uv, rel_bias, conv_w, attn_out_norm, conv_out_norm, w_out,
              ffn2_norm, ffn2_w_gate, ffn2_w_up, ffn2_w_down, final_norm):
    B, S, _ = x.shape
    n_keep = min(TOPK_MAX, S // 4)
    split_at = np.cumsum(IN_SIZES)[:-1].tolist()
    h = x
    for l in range(DEPTH):
        h = h + 0.5 * swiglu(rmsnorm(h, ffn1_norm[l]), ffn1_w_gate[l], ffn1_w_up[l], ffn1_w_down[l])
        u = rmsnorm(h, mix_norm[l])
        proj = u @ w_in[l]
        q, ckv, qi, ki, wi, gb, gc, xin = jnp.split(proj, split_at, axis=-1)
        q = q.reshape(B, S, N_HEADS_ATTN, HEAD_DIM)
        ckv = rmsnorm(ckv, kv_norm[l])
        qi = qi.reshape(B, S, N_HEADS_IDX, IDX_DIM)
        attn_out = dsa_attention(q, ckv, qi, ki, wi, w_uk[l], w_uv[l], rel_bias, n_keep)
        conv_out = short_conv(gb, gc, xin, conv_w[l])
        mixed = jnp.concatenate([rmsnorm(attn_out, attn_out_norm[l]),
                                 rmsnorm(conv_out, conv_out_norm[l])], axis=-1)
        h = h + mixed @ w_out[l]
        h = h + 0.5 * swiglu(rmsnorm(h, ffn2_norm[l]), ffn2_w_gate[l], ffn2_w_up[l], ffn2_w_down[l])
    return rmsnorm(h, final_norm)
```

```cpp
#include <hip/hip_runtime.h>
#include <cstdio>
#include <cstdint>
namespace pg8 {
#define PG8_LAS __attribute__((address_space(3)))
typedef unsigned short bf16_t;
typedef short bf16x8 __attribute__((ext_vector_type(8)));
typedef float f32x4 __attribute__((ext_vector_type(4)));
typedef unsigned u32x4 __attribute__((ext_vector_type(4)));
constexpr int BM = 256, BK = 64, HALF = 128, HTB = HALF * BK * 2  , STAGE_BYTES = 8 * HTB, NXCD = 8, WGM = 8;

__host__ __device__ __forceinline__ int lds_byte(int r, int c) { const int st = (r >> 4) * 2 + (c >> 5), rr = r & 15, cc = c & 31, ob = rr * 64 + cc * 2; return st * 1024 + (ob ^ (((ob >> 9) & 1) << 5)); }
__host__ __device__ __forceinline__ void stage_rc(int b, int& R, int& C) { const int st = b / 1024, sb = b % 1024, swz = sb ^ (((sb >> 9) & 1) << 5); R = (st >> 1) * 16 + swz / 64; C = (st & 1) * 32 + (swz % 64) / 2; }
__host__ __device__ __forceinline__ int perm32(int rho) { const int n = rho >> 4, i = rho & 15; return 8 * (i >> 2) + 4 * n + (i & 3); }

struct Unit { int pm, pn; };
struct Gemm { const bf16_t* A; const bf16_t* Bt; int M, N, K; };

struct StaticOrder {
    int nM, nN, nwg, G, c;
    __host__ __device__ void init(int M, int N, int G_, int c_) { nM = M / BM; nN = N / BM; nwg = nM * nN; G = G_; c = c_; }
    __host__ __device__ bool next(int i, Unit& u) const {
        const long L = (long)i * G + c; if (L >= nwg) return false;
        int wgid = (int)L; { const int q = nwg / NXCD, r = nwg % NXCD, xcd = wgid % NXCD, off = wgid / NXCD; wgid = (xcd < r ? xcd * (q + 1) : r * (q + 1) + (xcd - r) * q) + off; }
        const int nig = WGM * nN, gid = wgid / nig, fm = gid * WGM, gsz = (nM - fm) < WGM ? (nM - fm) : WGM;
        u.pm = fm + ((wgid % nig) % gsz); u.pn = (wgid % nig) / gsz; return true;
    }
    __device__ __forceinline__ void a_ready(const Unit&) const {}
    __device__ __forceinline__ void done(const Unit&) const {}
};

__device__ __forceinline__ unsigned cvt_pk_bf16(float lo, float hi) { unsigned r; asm volatile("v_cvt_pk_bf16_f32 %0, %1, %2" : "=v"(r) : "v"(lo), "v"(hi)); return r; }
typedef float f32x2 __attribute__((ext_vector_type(2)));
__device__ __forceinline__ f32x2 gelu_pk(f32x2 v) {
    const f32x2 av = __builtin_elementwise_abs(v), d = av * 0.2316418882f + 1.0f;
    f32x2 t; t.x = __builtin_amdgcn_rcpf(d.x); t.y = __builtin_amdgcn_rcpf(d.y);
    f32x2 q = t * 0.5307027145f + (-0.7265760135f); q = q * t + 0.7107068705f; q = q * t + (-0.142248368f); q = q * t + 0.127414796f; q = q * t;
    const f32x2 s = (v * v) * (-0.72134752044f);
    f32x2 e; e.x = __builtin_amdgcn_exp2f(s.x); e.y = __builtin_amdgcn_exp2f(s.y);
    const f32x2 m = v * (q * e), r = v - m;
    f32x2 o; o.x = v.x < 0.f ? m.x : r.x; o.y = v.y < 0.f ? m.y : r.y; return o;
}

template <int ACT  > struct EpiBf16 {
    static constexpr bool PERM = true, AFTER_DRAIN = false; static_assert(ACT == 0 || ACT == 1, "EpiBf16: ACT is 0 (none) or 1 (gelu_pk)");
    bf16_t* O; int ldc; const float* bias; int split_cols; size_t split_stride; float scale0;
    __device__ __forceinline__ void operator()(const f32x4 (&acc)[2][2][4][2], const Unit& u, int wr, int wc, int fr, int fq) const {
        const int row0 = u.pm * BM + wr * 64 + fr; int colt = u.pn * BM; bf16_t* base = O;
        float sc = 1.f; if (split_cols) { const int t = colt / split_cols; base += (size_t)t * split_stride; colt -= t * split_cols; if (t == 0) sc = scale0; }
        const int col0 = colt + wc * 32 + 8 * fq, bcol0 = u.pn * BM + wc * 32 + 8 * fq;
        f32x4 bv[2][2];
#pragma unroll
        for (int bj = 0; bj < 2; ++bj)
#pragma unroll
            for (int n = 0; n < 2; ++n) bv[bj][n] = bias ? *(const f32x4*)(bias + bcol0 + bj * HALF + 4 * n) : (f32x4){0.f, 0.f, 0.f, 0.f};
#pragma unroll
        for (int ai = 0; ai < 2; ++ai)
#pragma unroll
            for (int m = 0; m < 4; ++m) { bf16_t* rowp = base + (size_t)(row0 + ai * HALF + m * 16) * ldc + col0;
#pragma unroll
                for (int bj = 0; bj < 2; ++bj) { f32x4 v0 = acc[ai][bj][m][0] + bv[bj][0], v1 = acc[ai][bj][m][1] + bv[bj][1];
                    if (ACT == 1) { f32x2 a = gelu_pk((f32x2){v0[0], v0[1]}), b = gelu_pk((f32x2){v0[2], v0[3]}), c = gelu_pk((f32x2){v1[0], v1[1]}), d = gelu_pk((f32x2){v1[2], v1[3]});
                        v0 = (f32x4){a.x, a.y, b.x, b.y}; v1 = (f32x4){c.x, c.y, d.x, d.y}; }
                    v0 = v0 * sc; v1 = v1 * sc; u32x4 w; w.x = cvt_pk_bf16(v0[0], v0[1]); w.y = cvt_pk_bf16(v0[2], v0[3]); w.z = cvt_pk_bf16(v1[0], v1[1]); w.w = cvt_pk_bf16(v1[2], v1[3]);
                    *(u32x4*)(rowp + bj * HALF) = w; } }
    }
};


__device__ __forceinline__ float silu_mul(float g, float u) { const float e = __builtin_amdgcn_exp2f(g * -1.4426950408889634f); return g * __builtin_amdgcn_rcpf(1.0f + e) * u; }
struct EpiSwiglu {
    static constexpr bool PERM = true, AFTER_DRAIN = false;
    bf16_t* O; int ldc;
    __device__ __forceinline__ void operator()(const f32x4 (&acc)[2][2][4][2], const Unit& u, int wr, int wc, int fr, int fq) const {
        const int row0 = u.pm * BM + wr * 64 + fr, col0 = u.pn * HALF + wc * 32 + 8 * fq;
#pragma unroll
        for (int ai = 0; ai < 2; ++ai)
#pragma unroll
            for (int m = 0; m < 4; ++m) { bf16_t* rowp = O + (size_t)(row0 + ai * HALF + m * 16) * ldc + col0;
                const f32x4 g0 = acc[ai][0][m][0], g1 = acc[ai][0][m][1], u0 = acc[ai][1][m][0], u1 = acc[ai][1][m][1];
                u32x4 w; w.x = cvt_pk_bf16(silu_mul(g0[0], u0[0]), silu_mul(g0[1], u0[1])); w.y = cvt_pk_bf16(silu_mul(g0[2], u0[2]), silu_mul(g0[3], u0[3]));
                w.z = cvt_pk_bf16(silu_mul(g1[0], u1[0]), silu_mul(g1[1], u1[1])); w.w = cvt_pk_bf16(silu_mul(g1[2], u1[2]), silu_mul(g1[3], u1[3]));
                *(u32x4*)rowp = w; }
    }
};
struct EpiRes {
    static constexpr bool PERM = false, AFTER_DRAIN = false;
    const float* base; float* out; int ldc; float scale;
    __device__ __forceinline__ void operator()(const f32x4 (&acc)[2][2][4][2], const Unit& u, int wr, int wc, int fr, int fq) const {
        const int row0 = u.pm * BM + wr * 64 + fr, col0 = u.pn * BM + wc * 32 + 4 * fq;
#pragma unroll
        for (int ai = 0; ai < 2; ++ai) {
            f32x4 pre[4][2][2];
#pragma unroll
            for (int m = 0; m < 4; ++m) { const size_t off = (size_t)(row0 + ai * HALF + m * 16) * ldc + col0;
#pragma unroll
                for (int bj = 0; bj < 2; ++bj)
#pragma unroll
                    for (int n = 0; n < 2; ++n) pre[m][bj][n] = *(const f32x4*)(base + off + bj * HALF + n * 16); }
#pragma unroll
            for (int m = 0; m < 4; ++m) { const size_t off = (size_t)(row0 + ai * HALF + m * 16) * ldc + col0;
#pragma unroll
                for (int bj = 0; bj < 2; ++bj)
#pragma unroll
                    for (int n = 0; n < 2; ++n) *(f32x4*)(out + off + bj * HALF + n * 16) = pre[m][bj][n] + acc[ai][bj][m][n] * scale; }
        }
    }
};

template <class Epi, class Sched, bool ALIGN_EPI = false, bool SP2 = false>
__device__ __forceinline__ void gemm_phase(PG8_LAS unsigned char* lds, const Gemm g, const Sched& S, const Epi& E) {
    const int tid = threadIdx.x, wid = __builtin_amdgcn_readfirstlane(tid >> 6), lane = tid & 63, wr = wid >> 2, wc = wid & 3, fr = lane & 15, fq = lane >> 4;
    const int K = g.K, nt = K / BK;
    unsigned voffA[2], voffB[2];
#pragma unroll
    for (int i = 0; i < 2; ++i) { int R, C; stage_rc(tid * 16 + i * 8192, R, C); const int Rb = Epi::PERM ? ((R & ~31) + perm32(R & 31)) : R;
        voffA[i] = (unsigned)(R * K + C) * 2u; voffB[i] = (unsigned)(Rb * K + C) * 2u; }
    const size_t kstep = (size_t)(BK * 2);
    const size_t hstep = (size_t)HALF * K * 2;
    const size_t tstep = 2 * hstep;
    const unsigned ldsw = (unsigned)wid * 1024u;
    const int aoff = lds_byte(wr * 64 + fr, fq * 8), boff = lds_byte(wc * 32 + fr, fq * 8);
#define PG8_SA(b, h) (((b) * 2 + (h)) * HTB)
#define PG8_SB(b, h) ((4 + (b) * 2 + (h)) * HTB)
#define PG8_STAGE(bufoff, gbase, voff) do { _Pragma("unroll") for (int _i = 0; _i < 2; ++_i) \
        __builtin_amdgcn_global_load_lds((const unsigned*)((const char*)(gbase) + (voff)[_i]), (PG8_LAS unsigned*)(lds + (bufoff) + ldsw + _i * 8192), 16, 0, 0); } while (0)
#define PG8_LDA(dst, b, h) do { _Pragma("unroll") for (int m = 0; m < 4; ++m) _Pragma("unroll") for (int k = 0; k < 2; ++k) dst[m][k] = *(const PG8_LAS bf16x8*)(lds + PG8_SA(b, h) + aoff + m * 2048 + k * 1024); } while (0)
#define PG8_LDB(dst, b, h) do { _Pragma("unroll") for (int n = 0; n < 2; ++n) _Pragma("unroll") for (int k = 0; k < 2; ++k) dst[n][k] = *(const PG8_LAS bf16x8*)(lds + PG8_SB(b, h) + boff + n * 2048 + k * 1024); } while (0)
#define PG8_MMA(ai, bj, At, Bt) do { __builtin_amdgcn_s_setprio(1); _Pragma("unroll") for (int m = 0; m < 4; ++m) _Pragma("unroll") for (int n = 0; n < 2; ++n) _Pragma("unroll") for (int k = 0; k < 2; ++k) \
        acc[ai][bj][m][n] = __builtin_amdgcn_mfma_f32_16x16x32_bf16(Bt[n][k], At[m][k], acc[ai][bj][m][n], 0, 0, 0); __builtin_amdgcn_s_setprio(0); } while (0)
#define PG8_WAIT_V(n) asm volatile("s_waitcnt vmcnt(" #n ")" ::: "memory")
#define PG8_WAIT_L(n) asm volatile("s_waitcnt lgkmcnt(" #n ")" ::: "memory")
#define PG8_BAR __builtin_amdgcn_s_barrier()
#define PG8_SCHED __builtin_amdgcn_sched_barrier(0)
    Unit cur, nxt; int ui = 0;
    if (!S.next(0, cur)) return;
    f32x4 acc[2][2][4][2];
#pragma unroll
    for (int a = 0; a < 2; ++a)
#pragma unroll
        for (int b = 0; b < 2; ++b)
#pragma unroll
            for (int m = 0; m < 4; ++m)
#pragma unroll
                for (int n = 0; n < 2; ++n) acc[a][b][m][n] = (f32x4){0.f, 0.f, 0.f, 0.f};
    bf16x8 At[4][2], B0[2][2], B1[2][2];
    const char* cA = (const char*)g.A + (size_t)cur.pm * tstep; const char* cB = (const char*)g.Bt + (size_t)cur.pn * tstep;
    S.a_ready(cur);
    if constexpr (SP2) {
        PG8_STAGE(PG8_SB(0, 0), cB, voffB); PG8_STAGE(PG8_SB(0, 1), cB + hstep, voffB); PG8_STAGE(PG8_SA(0, 0), cA, voffA); PG8_STAGE(PG8_SA(0, 1), cA + hstep, voffA);
        if (wr == 1) PG8_BAR;
        PG8_WAIT_V(2); PG8_BAR;
        PG8_STAGE(PG8_SB(1, 0), cB + kstep, voffB); PG8_STAGE(PG8_SA(1, 0), cA + kstep, voffA); PG8_STAGE(PG8_SB(1, 1), cB + hstep + kstep, voffB);
        PG8_WAIT_V(6); PG8_BAR;
    } else {
        PG8_STAGE(PG8_SB(0, 0), cB, voffB); PG8_STAGE(PG8_SA(0, 0), cA, voffA); PG8_STAGE(PG8_SB(0, 1), cB + hstep, voffB); PG8_STAGE(PG8_SA(0, 1), cA + hstep, voffA);
        if (wr == 1) PG8_BAR;
        PG8_WAIT_V(4); PG8_BAR;
        PG8_STAGE(PG8_SB(1, 0), cB + kstep, voffB); PG8_STAGE(PG8_SA(1, 0), cA + kstep, voffA); PG8_STAGE(PG8_SB(1, 1), cB + hstep + kstep, voffB);
        PG8_WAIT_V(6); PG8_BAR;
    }
    for (;;) {
        const bool has_next = S.next(ui + 1, nxt);
        const char* nA = has_next ? (const char*)g.A + (size_t)nxt.pm * tstep : cA; const char* nB = has_next ? (const char*)g.Bt + (size_t)nxt.pn * tstep : cB;
        for (int t = 0; t < nt; t += 2) {
            const bool last = (t == nt - 2);
            const char* a1 = cA + (size_t)(t + 1) * kstep;
            const char* a2 = last ? nA : cA + (size_t)(t + 2) * kstep; const char* b2 = last ? nB : cB + (size_t)(t + 2) * kstep;
            const char* a3 = a2 + kstep; const char* b3 = b2 + kstep;
            if (last && has_next) S.a_ready(nxt);
            if constexpr (SP2) {
            PG8_LDB(B0, 0, 0); PG8_LDB(B1, 0, 1); PG8_SCHED; PG8_LDA(At, 0, 0); PG8_STAGE(PG8_SA(1, 1), a1 + hstep, voffA);
            PG8_WAIT_V(8); PG8_WAIT_L(0); PG8_BAR; PG8_MMA(0, 0, At, B0); PG8_MMA(0, 1, At, B1); PG8_BAR; PG8_SCHED;
            PG8_LDA(At, 0, 1); PG8_STAGE(PG8_SB(0, 0), b2, voffB); PG8_STAGE(PG8_SB(0, 1), b2 + hstep, voffB); PG8_STAGE(PG8_SA(0, 0), a2, voffA);
            PG8_WAIT_V(8); PG8_WAIT_L(0); PG8_BAR; PG8_MMA(1, 0, At, B0); PG8_MMA(1, 1, At, B1); PG8_BAR; PG8_SCHED;
            PG8_LDB(B0, 1, 0); PG8_LDB(B1, 1, 1); PG8_SCHED; PG8_LDA(At, 1, 0); PG8_STAGE(PG8_SA(0, 1), a2 + hstep, voffA);
            PG8_WAIT_V(8); PG8_WAIT_L(0); PG8_BAR; PG8_MMA(0, 0, At, B0); PG8_MMA(0, 1, At, B1); PG8_BAR; PG8_SCHED;
            PG8_LDA(At, 1, 1); PG8_STAGE(PG8_SB(1, 0), b3, voffB); PG8_STAGE(PG8_SB(1, 1), b3 + hstep, voffB); PG8_STAGE(PG8_SA(1, 0), a3, voffA);
            PG8_WAIT_V(8); PG8_WAIT_L(0); PG8_BAR; PG8_MMA(1, 0, At, B0); PG8_MMA(1, 1, At, B1); PG8_BAR; PG8_SCHED;
            } else {
            PG8_LDB(B0, 0, 0); PG8_SCHED; PG8_LDA(At, 0, 0); PG8_STAGE(PG8_SA(1, 1), a1 + hstep, voffA);
            PG8_WAIT_L(8); PG8_BAR; PG8_WAIT_L(0); PG8_MMA(0, 0, At, B0); PG8_BAR; PG8_SCHED;
            PG8_LDB(B1, 0, 1); PG8_STAGE(PG8_SB(0, 0), b2, voffB);
            PG8_BAR; PG8_WAIT_L(0); PG8_MMA(0, 1, At, B1); PG8_BAR;
            PG8_LDA(At, 0, 1); PG8_STAGE(PG8_SA(0, 0), a2, voffA);
            PG8_BAR; PG8_WAIT_L(0); PG8_MMA(1, 0, At, B0); PG8_BAR; PG8_SCHED;
            PG8_STAGE(PG8_SB(0, 1), b2 + hstep, voffB);
            PG8_WAIT_V(6); PG8_BAR; PG8_MMA(1, 1, At, B1); PG8_BAR;
            PG8_LDB(B0, 1, 0); PG8_SCHED; PG8_LDA(At, 1, 0); PG8_STAGE(PG8_SA(0, 1), a2 + hstep, voffA);
            PG8_WAIT_L(8); PG8_BAR; PG8_WAIT_L(0); PG8_MMA(0, 0, At, B0); PG8_BAR; PG8_SCHED;
            PG8_LDB(B1, 1, 1); PG8_STAGE(PG8_SB(1, 0), b3, voffB);
            PG8_BAR; PG8_WAIT_L(0); PG8_MMA(0, 1, At, B1); PG8_BAR;
            PG8_LDA(At, 1, 1); PG8_STAGE(PG8_SA(1, 0), a3, voffA);
            PG8_BAR; PG8_WAIT_L(0); PG8_MMA(1, 0, At, B0); PG8_BAR; PG8_SCHED;
            PG8_STAGE(PG8_SB(1, 1), b3 + hstep, voffB);
            PG8_WAIT_V(6); PG8_BAR; PG8_MMA(1, 1, At, B1); PG8_BAR;
            }
        }
        if constexpr (ALIGN_EPI) { if (wr == 0) PG8_BAR; }
        if constexpr (!Epi::AFTER_DRAIN) { E(acc, cur, wr, wc, fr, fq); S.done(cur); }
        if (!has_next) break;
#pragma unroll
        for (int a = 0; a < 2; ++a)
#pragma unroll
            for (int b = 0; b < 2; ++b)
#pragma unroll
                for (int m = 0; m < 4; ++m)
#pragma unroll
                    for (int n = 0; n < 2; ++n) acc[a][b][m][n] = (f32x4){0.f, 0.f, 0.f, 0.f};
        cur = nxt; cA = nA; cB = nB; ++ui;
        if constexpr (ALIGN_EPI) { if (wr == 1) PG8_BAR; }
    }
    PG8_WAIT_V(0);
    if constexpr (!ALIGN_EPI) { if (wr == 0) PG8_BAR; }
    PG8_BAR;
    if constexpr (Epi::AFTER_DRAIN) { E.fused(acc, cur, wr, wc, fr, fq, lds, wid, lane); S.done(cur); }
#undef PG8_SA
#undef PG8_SB
#undef PG8_STAGE
#undef PG8_LDA
#undef PG8_LDB
#undef PG8_MMA
#undef PG8_WAIT_V
#undef PG8_WAIT_L
#undef PG8_BAR
#undef PG8_SCHED
}
}

#ifndef PG8_SP2
#define PG8_SP2 true
#endif
#ifndef PG8_ALIGN
#define PG8_ALIGN true
#endif

constexpr int NWAVES = 8;
#ifndef MK_N_LAUNCHES
#define MK_N_LAUNCHES 12
#endif
constexpr int PER_PHASE = 12;
constexpr int N_LAUNCHES = MK_N_LAUNCHES;
static_assert(N_LAUNCHES == 1 || N_LAUNCHES == PER_PHASE, "MK_N_LAUNCHES is 1 or 12");

constexpr int BATCH = 8, SEQ = 2048, D = 1024, M = BATCH * SEQ;
constexpr int FF = 2816, FF2 = 2 * FF;
constexpr int NH = 8, HD = 64, CL = 128, TOPK = 256;
constexpr int NPROJ = 2816;
constexpr int PQ = 0, PQI = 512, PCKV = 1024, PKI = 1152, PWI = 1216, PGB = 1280, PGC = 1792, PXIN = 2304;
constexpr int WIN_N = 2760;
constexpr float EPS = 1e-6f;
constexpr float IDX_SCALE = 0.044194173824159216f;

constexpr size_t MiB = 1u << 20;
constexpr size_t WS_CTL = 0, CTL_ZERO_BYTES = 1 * MiB;
constexpr size_t WS_WUK = 1 * MiB, WS_WUV = 1 * MiB + 256 * 1024;
constexpr size_t WS_WGU1 = 2 * MiB, WS_WD1 = 14 * MiB, WS_WIN = 20 * MiB, WS_WOUT = 26 * MiB, WS_WGU2 = 28 * MiB, WS_WD2 = 40 * MiB;
constexpr size_t WS_XN = 48 * MiB;
constexpr size_t WS_MIX = 80 * MiB;
constexpr size_t WS_KV = 112 * MiB;
constexpr size_t WS_MASK = 116 * MiB;
constexpr size_t WS_ACT = 128 * MiB;
constexpr size_t WS_END = 216 * MiB;
static_assert(WS_WGU1 + (size_t)FF2 * D * 2 <= WS_WD1 && WS_WD1 + (size_t)D * FF * 2 <= WS_WIN && WS_WIN + (size_t)NPROJ * D * 2 <= WS_WOUT && WS_WOUT + (size_t)D * D * 2 <= WS_WGU2 &&
              WS_WGU2 + (size_t)FF2 * D * 2 <= WS_WD2 && WS_WD2 + (size_t)D * FF * 2 <= WS_XN && WS_ACT + (size_t)M * FF * 2 <= WS_END, "d_ws map");
constexpr int CW_BAR = 4096;

constexpr int RING_OFF = 0, RING_BYTES = 131072;
constexpr int LDSCTL_OFF = RING_BYTES, MISC_OFF = LDSCTL_OFF + 320;
constexpr int LDS_BYTES = 147456;
static_assert(MISC_OFF + 128 <= LDS_BYTES, "LDS map");
#define GAS __attribute__((address_space(1)))
#define LAS __attribute__((address_space(3)))
typedef unsigned short bf16;
typedef unsigned v4u __attribute__((ext_vector_type(4)));
typedef float f32x4 __attribute__((ext_vector_type(4)));
typedef short bf16x8 __attribute__((ext_vector_type(8)));
typedef GAS unsigned gu32;
typedef GAS unsigned long long gu64;
#define RLX_AGENT __ATOMIC_RELAXED, __HIP_MEMORY_SCOPE_AGENT
#define LDS_WAIT() asm volatile("s_waitcnt lgkmcnt(0)" ::: "memory")
#define VM_WAIT() asm volatile("s_waitcnt vmcnt(0)" ::: "memory")
__device__ __forceinline__ unsigned long long rt() { return __builtin_amdgcn_s_memrealtime(); }
__device__ __forceinline__ unsigned f2bf(float f) { unsigned u = __builtin_bit_cast(unsigned, f); return (u + 0x7fffu + ((u >> 16) & 1u)) >> 16; }
__device__ __forceinline__ unsigned pk2(float lo, float hi) { return f2bf(lo) | (f2bf(hi) << 16); }

#define XB_TMO      128
#define XB_XCNT(j)  (256  + 64 * (j))
#define XB_XSUB(j)  (1280 + 64 * (j))
#define XB_XGEN(j)  (2304 + 64 * (j))
#define XB_TOP      3328
#define XB_TOPGEN   3392
#define XCD_BAR_WORDS 3456
#define XB_SPIN_CAP (1u << 18)

__device__ __forceinline__ unsigned xb_ld(unsigned* p)              { return __hip_atomic_load(p, __ATOMIC_RELAXED, __HIP_MEMORY_SCOPE_AGENT); }
__device__ __forceinline__ unsigned xb_add(unsigned* p, unsigned v) { return __hip_atomic_fetch_add(p, v, __ATOMIC_RELAXED, __HIP_MEMORY_SCOPE_AGENT); }
__device__ __forceinline__ unsigned xb_xcc_id() { return (unsigned)__builtin_amdgcn_s_getreg((3 << 11) | 20) & 0xFu; }
#define XB_SPIN(cond, bar) do { unsigned _sp = 0; while (cond) { __builtin_amdgcn_s_sleep(1); \
    if ((++_sp & 255u) == 0u) { if (xb_ld(&(bar)[XB_TMO])) break; if (_sp > XB_SPIN_CAP) { atomicAdd(&(bar)[XB_TMO], 1u); break; } } } } while (0)

struct XcdBarrier {
    unsigned* bar; unsigned x;
    volatile LAS unsigned* st;
};

__device__ __forceinline__ XcdBarrier xcd_barrier_post(unsigned* bar, volatile LAS unsigned* st) {
    XcdBarrier b; b.bar = bar; b.x = xb_xcc_id(); b.st = st;
    if (threadIdx.x == 0) (void)xb_add(&bar[XB_XCNT(b.x)], 1u);
    return b;
}
__device__ __forceinline__ void xcd_barrier_complete(unsigned* bar, unsigned x, unsigned& nloc, unsigned& nx) {
    const unsigned G = gridDim.x * gridDim.y * gridDim.z;
    unsigned sum, cnt, mine, sp = 0u;
    for (;;) {
        sum = 0u; cnt = 0u; mine = 0u;
#pragma unroll
        for (unsigned j = 0; j < 16; ++j) { const unsigned c = xb_ld(&bar[XB_XCNT(j)]); sum += c; cnt += (c > 0u) ? 1u : 0u; mine = (j == x) ? c : mine; }
        if (sum == G) break;
        __builtin_amdgcn_s_sleep(1);
        if ((++sp & 255u) == 0u) { if (xb_ld(&bar[XB_TMO])) break; if (sp > XB_SPIN_CAP) { atomicAdd(&bar[XB_TMO], 1u); break; } }
    }
    nloc = mine > 0u ? mine : 1u; nx = cnt > 0u ? cnt : 1u;
}

__device__ __forceinline__ void xcd_barrier(const XcdBarrier& b) {
    asm volatile("s_waitcnt vmcnt(0)" ::: "memory");
    __syncthreads();
    if (threadIdx.x == 0) {
        unsigned* bar = b.bar;
        __builtin_amdgcn_s_waitcnt(0);
        unsigned nloc = b.st[0], nx = b.st[1];
        if (nloc == 0u) { xcd_barrier_complete(bar, b.x, nloc, nx); b.st[0] = nloc; b.st[1] = nx; }
        const unsigned old = xb_add(&bar[XB_XSUB(b.x)], 1u);
        const unsigned gen = old / nloc;
        if (old + 1u == (gen + 1u) * nloc) {
            __builtin_amdgcn_fence(__ATOMIC_RELEASE, "agent");
            asm volatile("s_waitcnt vmcnt(0)" ::: "memory");
            const unsigned og = xb_add(&bar[XB_TOP], 1u);
            const unsigned tg = og / nx;
            if (og + 1u == (tg + 1u) * nx) xb_add(&bar[XB_TOPGEN], 1u);
            else XB_SPIN(xb_ld(&bar[XB_TOPGEN]) == tg, bar);
            __builtin_amdgcn_fence(__ATOMIC_ACQUIRE, "agent");
            xb_add(&bar[XB_XGEN(b.x)], 1u);
            asm volatile("s_waitcnt vmcnt(0)" ::: "memory");
        } else {
            XB_SPIN(xb_ld(&bar[XB_XGEN(b.x)]) == gen, bar);
            __builtin_amdgcn_fence(__ATOMIC_ACQUIRE, "agent");
            asm volatile("s_waitcnt vmcnt(0)" ::: "memory");
        }
    }
    __syncthreads();
}


struct Frame {
    LAS unsigned char* lds;
    volatile LAS unsigned* MISC;
    gu32* ctl;
    int tid, lane, wave;
    int vcu, G;
    const float* in[20]; float* out;
    bf16 *Wgu1, *Wd1, *Win, *Wout, *Wgu2, *Wd2, *Wuk, *WuvT;
    bf16 *XN, *MIX, *KV, *ACT, *PROJ; unsigned* MASK;
};
enum { I_X = 0, I_N1, I_G1, I_U1, I_D1, I_NMIX, I_WIN, I_NKV, I_WUK, I_WUV, I_RELB, I_CONVW, I_NATT, I_NCONV, I_WOUT, I_N2, I_G2, I_U2, I_D2, I_NF };

__device__ __forceinline__ float wave_sum(float v) {
#pragma unroll
    for (int o = 1; o < 64; o <<= 1) v += __shfl_xor(v, o);
    return v;
}
__device__ __forceinline__ float wave_max(float v) {
#pragma unroll
    for (int o = 1; o < 64; o <<= 1) v = fmaxf(v, __shfl_xor(v, o));
    return v;
}
__device__ __forceinline__ float bflo(unsigned w) { return __uint_as_float(w << 16); }
__device__ __forceinline__ float bfhi(unsigned w) { return __uint_as_float(w & 0xffff0000u); }

struct Src { const float* W; int N; int col; };
struct MapPlain { const float* W; int N; __device__ __forceinline__ Src operator()(int d) const { return Src{W, N, d}; } };
struct MapGU { const float* W; __device__ __forceinline__ Src operator()(int d) const { return Src{W, FF, (d >> 8) * 128 + (d & 127)}; } };
struct MapWin { const float* W; __device__ __forceinline__ Src operator()(int d) const { int c;
    if (d < 512) c = d;
    else if (d < 1024) c = 640 + (d - 512);
    else if (d < 1152) c = 512 + (d - 1024);
    else if (d < 1224) c = d;
    else if (d < 1280) c = -1;
    else if (d < 1792) c = 1224 + (d - 1280);
    else if (d < 2304) c = 1736 + (d - 1792);
    else c = 2248 + (d - 2304);
    return Src{W, WIN_N, c}; } };
template <class MAP>
__device__ __forceinline__ void p0_transpose_item(const MAP& map, int K, int ndg, bf16* WT, LAS float* scr, int item, int lane) {
    const int kb = item / ndg, dg = item % ndg, k0 = 64 * kb, d0 = 32 * dg;
    const Src src = map(d0 + (lane & 31)); const int sc = src.col; const float* wp = src.W + (size_t)(k0 + (lane >> 5)) * src.N + (sc >= 0 ? sc : 0);
#pragma unroll 8
    for (int i = 0; i < 32; ++i) { const int kk = 2 * i + (lane >> 5); scr[kk * 33 + (lane & 31)] = sc >= 0 ? wp[(size_t)(2 * i) * src.N] : 0.f; }
    LDS_WAIT(); asm volatile("" ::: "memory");
    const int c = lane & 7;
#pragma unroll
    for (int j = 0; j < 4; ++j) { const int n = (lane >> 3) + 8 * j; const LAS float* s = scr + (8 * c) * 33 + n;
        v4u o; o.x = pk2(s[0 * 33], s[1 * 33]); o.y = pk2(s[2 * 33], s[3 * 33]); o.z = pk2(s[4 * 33], s[5 * 33]); o.w = pk2(s[6 * 33], s[7 * 33]);
        *(GAS v4u*)(WT + (size_t)(d0 + n) * K + k0 + 8 * c) = o; }
    LDS_WAIT(); asm volatile("" ::: "memory");
}
__device__ __forceinline__ void rms_row_to_bf16(int lane, const float* xrow, const float* gain, bf16* orow) {
    const GAS f32x4* xr = (const GAS f32x4*)xrow + lane; const GAS f32x4* gr = (const GAS f32x4*)gain + lane;
    f32x4 v[4]; float s = 0.f;
#pragma unroll
    for (int j = 0; j < 4; ++j) { v[j] = xr[64 * j]; s += (v[j].x * v[j].x + v[j].y * v[j].y) + (v[j].z * v[j].z + v[j].w * v[j].w); }
    const float rstd = 1.f / sqrtf(wave_sum(s) * (1.f / D) + EPS);
    GAS unsigned long long* o8 = (GAS unsigned long long*)orow + lane;
#pragma unroll
    for (int j = 0; j < 4; ++j) { const f32x4 g = gr[64 * j]; o8[64 * j] = (unsigned long long)pk2(v[j].x * rstd * g.x, v[j].y * rstd * g.y) | ((unsigned long long)pk2(v[j].z * rstd * g.z, v[j].w * rstd * g.w) << 32); }
}
__device__ __forceinline__ void rms_row_to_f32(int lane, const float* xrow, const float* gain, float* orow, bool poison) {
    const GAS f32x4* xr = (const GAS f32x4*)xrow + lane; const GAS f32x4* gr = (const GAS f32x4*)gain + lane;
    f32x4 v[4]; float s = 0.f;
#pragma unroll
    for (int j = 0; j < 4; ++j) { v[j] = xr[64 * j]; s += (v[j].x * v[j].x + v[j].y * v[j].y) + (v[j].z * v[j].z + v[j].w * v[j].w); }
    float rstd = 1.f / sqrtf(wave_sum(s) * (1.f / D) + EPS); if (poison) rstd = __builtin_nanf("");
    GAS f32x4* o = (GAS f32x4*)orow + lane;
#pragma unroll
    for (int j = 0; j < 4; ++j) { const f32x4 g = gr[64 * j]; o[64 * j] = v[j] * rstd * g; }
}
__device__ __forceinline__ void p0_prologue(Frame& F) {
    LAS float* scr = (LAS float*)(F.lds + RING_OFF + F.wave * 16384);
    const int gw = F.vcu * NWAVES + F.wave, NGW = F.G * NWAVES;
    constexpr int I_GU = (D / 64) * (FF2 / 32), I_DN = (FF / 64) * (D / 32), I_IN = (D / 64) * (NPROJ / 32), I_OUT = (D / 64) * (D / 32);
    constexpr int NITEMS = 2 * I_GU + 2 * I_DN + I_IN + I_OUT;
    for (int it = gw; it < NITEMS; it += NGW) {
        int r = it;
        if (r < I_GU) { if (((r % (FF2 / 32)) & 7) < 4) p0_transpose_item(MapGU{F.in[I_G1]}, D, FF2 / 32, F.Wgu1, scr, r, F.lane); else p0_transpose_item(MapGU{F.in[I_U1]}, D, FF2 / 32, F.Wgu1, scr, r, F.lane); continue; } r -= I_GU;
        if (r < I_GU) { if (((r % (FF2 / 32)) & 7) < 4) p0_transpose_item(MapGU{F.in[I_G2]}, D, FF2 / 32, F.Wgu2, scr, r, F.lane); else p0_transpose_item(MapGU{F.in[I_U2]}, D, FF2 / 32, F.Wgu2, scr, r, F.lane); continue; } r -= I_GU;
        if (r < I_DN) { p0_transpose_item(MapPlain{F.in[I_D1], D}, FF, D / 32, F.Wd1, scr, r, F.lane); continue; } r -= I_DN;
        if (r < I_DN) { p0_transpose_item(MapPlain{F.in[I_D2], D}, FF, D / 32, F.Wd2, scr, r, F.lane); continue; } r -= I_DN;
        if (r < I_IN) { p0_transpose_item(MapWin{F.in[I_WIN]}, D, NPROJ / 32, F.Win, scr, r, F.lane); continue; } r -= I_IN;
        p0_transpose_item(MapPlain{F.in[I_WOUT], D}, D, D / 32, F.Wout, scr, r, F.lane);
    }
    for (int m = gw; m < M; m += NGW) rms_row_to_bf16(F.lane, F.in[I_X] + (size_t)m * D, F.in[I_N1], F.XN + (size_t)m * D);
}
__device__ __forceinline__ void norm_phase(Frame& F, const float* src, const float* gain) {
    const int gw = F.vcu * NWAVES + F.wave, NGW = F.G * NWAVES;
    for (int m = gw; m < M; m += NGW) rms_row_to_bf16(F.lane, src + (size_t)m * D, gain, F.XN + (size_t)m * D);
}

__device__ __forceinline__ void ld8bf(const bf16* p, float (&f)[8]) { const v4u w = *(const GAS v4u*)p; f[0] = bflo(w.x); f[1] = bfhi(w.x); f[2] = bflo(w.y); f[3] = bfhi(w.y); f[4] = bflo(w.z); f[5] = bfhi(w.z); f[6] = bflo(w.w); f[7] = bfhi(w.w); }
__device__ __forceinline__ void prep_phase(Frame& F) {
    const int gw = F.vcu * NWAVES + F.wave, NGW = F.G * NWAVES, lane = F.lane;
    const float* cw = F.in[I_CONVW];
    for (int m = gw; m < M; m += NGW) {
        const bf16* prow = F.PROJ + (size_t)m * NPROJ; const int t = m & (SEQ - 1);
        {
            const unsigned w = *(const GAS unsigned*)(prow + PCKV + 2 * lane); const float a = bflo(w), b = bfhi(w);
            const float rstd = 1.f / sqrtf(wave_sum(a * a + b * b) * (1.f / CL) + EPS);
            const float g0 = F.in[I_NKV][2 * lane], g1 = F.in[I_NKV][2 * lane + 1];
            *(GAS unsigned*)(F.KV + (size_t)m * CL + 2 * lane) = pk2(a * rstd * g0, b * rstd * g1);
        }
        {
            const int c0 = 8 * lane; float gb[8], gc[8], xi[8], y[8];
            ld8bf(prow + PGB + c0, gb); ld8bf(prow + PGC + c0, gc); ld8bf(prow + PXIN + c0, xi);
#pragma unroll
            for (int e = 0; e < 8; ++e) y[e] = cw[2 * 512 + c0 + e] * (gc[e] * xi[e]);
            if (t >= 1) { ld8bf(prow - NPROJ + PGC + c0, gc); ld8bf(prow - NPROJ + PXIN + c0, xi);
#pragma unroll
                for (int e = 0; e < 8; ++e) y[e] += cw[1 * 512 + c0 + e] * (gc[e] * xi[e]); }
            if (t >= 2) { ld8bf(prow - 2 * NPROJ + PGC + c0, gc); ld8bf(prow - 2 * NPROJ + PXIN + c0, xi);
#pragma unroll
                for (int e = 0; e < 8; ++e) y[e] += cw[0 * 512 + c0 + e] * (gc[e] * xi[e]); }
            float ss = 0.f;
#pragma unroll
            for (int e = 0; e < 8; ++e) { y[e] *= gb[e]; ss += y[e] * y[e]; }
            const float rstd = 1.f / sqrtf(wave_sum(ss) * (1.f / 512.f) + EPS);
            const float* g = F.in[I_NCONV] + c0;
            v4u o; o.x = pk2(y[0] * rstd * g[0], y[1] * rstd * g[1]); o.y = pk2(y[2] * rstd * g[2], y[3] * rstd * g[3]); o.z = pk2(y[4] * rstd * g[4], y[5] * rstd * g[5]); o.w = pk2(y[6] * rstd * g[6], y[7] * rstd * g[7]);
            *(GAS v4u*)(F.MIX + (size_t)m * D + 512 + c0) = o;
        }
    }
}

__device__ __forceinline__ int wave_sum_i(int v) {
#pragma unroll
    for (int o = 1; o < 64; o <<= 1) v += __shfl_xor(v, o);
    return v;
}
__device__ __forceinline__ int rel_bucket(int d) {
    if (d < 16) return d;
    return 16 + (d >= 19) + (d >= 21) + (d >= 24) + (d >= 27) + (d >= 31) + (d >= 35) + (d >= 40) + (d >= 46) + (d >= 52) + (d >= 59) + (d >= 67) + (d >= 77) + (d >= 87) + (d >= 99) + (d >= 113);
}
__device__ __forceinline__ void naive_attn_query(Frame& F, int m, LAS float* L) {
    const int lane = F.lane, b = m >> 11, t = m & (SEQ - 1);
    LAS float* qi_s = L;
    LAS float* qa_s = L + 512;
    LAS int* sel_s = (LAS int*)(L + 1536);
    LAS unsigned* sc_s = (LAS unsigned*)(L + 1792);
    LAS float* p_s = L + 1792;
    const bf16* prow = F.PROJ + (size_t)m * NPROJ;
    const bf16* pb = F.PROJ + (size_t)(b * SEQ) * NPROJ;
    float f8[8];
    ld8bf(prow + PQI + 8 * lane, f8);
#pragma unroll
    for (int e = 0; e < 8; ++e) qi_s[8 * lane + e] = f8[e];
    float wv[8]; ld8bf(prow + PWI, wv);
#pragma unroll
    for (int h = 0; h < 8; ++h) wv[h] *= IDX_SCALE;
    LDS_WAIT();
    for (int s = lane; s <= t; s += 64) {
        const bf16* kr = pb + (size_t)s * NPROJ + PKI; float dot[8];
#pragma unroll
        for (int h = 0; h < 8; ++h) dot[h] = 0.f;
#pragma unroll 1
        for (int ch = 0; ch < 8; ++ch) { float k[8]; ld8bf(kr + 8 * ch, k);
#pragma unroll
            for (int h = 0; h < 8; ++h)
#pragma unroll
                for (int e = 0; e < 8; ++e) dot[h] += qi_s[h * 64 + ch * 8 + e] * k[e]; }
        float score = 0.f;
#pragma unroll
        for (int h = 0; h < 8; ++h) score += wv[h] * fmaxf(dot[h], 0.f);
        unsigned u = __float_as_uint(score); u = (u & 0x80000000u) ? ~u : (u | 0x80000000u);
        sc_s[s] = u;
    }
    LDS_WAIT();
    int nsel;
    if (t < TOPK) { nsel = t + 1; for (int i = lane; i < nsel; i += 64) sel_s[i] = i; }
    else {
        unsigned T = 0u;
        for (int bit = 31; bit >= 0; --bit) { const unsigned cand = T | (1u << bit); int cnt = 0;
            for (int s = lane; s <= t; s += 64) cnt += (sc_s[s] >= cand) ? 1 : 0;
            cnt = wave_sum_i(cnt); if (cnt >= TOPK) T = cand; }
        int cgt = 0; for (int s = lane; s <= t; s += 64) cgt += (sc_s[s] > T) ? 1 : 0;
        cgt = wave_sum_i(cgt);
        const int need = TOPK - cgt; int base = 0, taken = 0; const unsigned long long lt = (1ull << lane) - 1ull;
        for (int s0 = 0; s0 <= t; s0 += 64) { const int s = s0 + lane; const bool valid = s <= t; const unsigned key = valid ? sc_s[s] : 0u;
            const bool gt = valid && key > T, eq = valid && key == T;
            const unsigned long long eqm = __ballot(eq); const int eqrank = taken + __popcll(eqm & lt);
            const bool selb = gt || (eq && eqrank < need);
            const unsigned long long sm = __ballot(selb); const int pos = base + __popcll(sm & lt);
            if (selb) sel_s[pos] = s;
            base += __popcll(sm); taken += __popcll(eqm); }
        nsel = TOPK;
    }
    ld8bf(prow + PQ + 8 * lane, f8);
#pragma unroll
    for (int e = 0; e < 8; ++e) qi_s[8 * lane + e] = f8[e];
    LDS_WAIT();
    for (int i = 0; i < 16; ++i) { const int o = lane + 64 * i, h = o >> 7, c = o & 127; const GAS f32x4* w = (const GAS f32x4*)(F.in[I_WUK] + ((size_t)c * 8 + h) * 64); float a = 0.f;
#pragma unroll
        for (int d4 = 0; d4 < 16; ++d4) { const f32x4 wv4 = w[d4]; a += qi_s[h * 64 + 4 * d4] * wv4.x + qi_s[h * 64 + 4 * d4 + 1] * wv4.y + qi_s[h * 64 + 4 * d4 + 2] * wv4.z + qi_s[h * 64 + 4 * d4 + 3] * wv4.w; }
        qa_s[o] = a * 0.125f; }
    LDS_WAIT();
    for (int i = 0; i < 4; ++i) { const int kidx = lane + 64 * i; float lg[8];
        if (kidx < nsel) { const int s = sel_s[kidx]; const bf16* kr = F.KV + (size_t)(b * SEQ + s) * CL;
#pragma unroll
            for (int h = 0; h < 8; ++h) lg[h] = 0.f;
#pragma unroll 1
            for (int ch = 0; ch < 16; ++ch) { float k[8]; ld8bf(kr + 8 * ch, k);
#pragma unroll
                for (int h = 0; h < 8; ++h)
#pragma unroll
                    for (int e = 0; e < 8; ++e) lg[h] += qa_s[h * 128 + ch * 8 + e] * k[e]; }
            const float* rb = F.in[I_RELB] + rel_bucket(t - s) * 8;
#pragma unroll
            for (int h = 0; h < 8; ++h) lg[h] += rb[h];
        } else {
#pragma unroll
            for (int h = 0; h < 8; ++h) lg[h] = -INFINITY; }
#pragma unroll
        for (int h = 0; h < 8; ++h) p_s[h * 256 + kidx] = lg[h]; }
    LDS_WAIT();
    for (int h = 0; h < 8; ++h) { float v[4], mx = -INFINITY;
#pragma unroll
        for (int i = 0; i < 4; ++i) { v[i] = p_s[h * 256 + lane + 64 * i]; mx = fmaxf(mx, v[i]); }
        mx = wave_max(mx); float sm = 0.f;
#pragma unroll
        for (int i = 0; i < 4; ++i) { v[i] = __expf(v[i] - mx); sm += v[i]; }
        sm = wave_sum(sm); const float inv = 1.f / sm;
#pragma unroll
        for (int i = 0; i < 4; ++i) p_s[h * 256 + lane + 64 * i] = v[i] * inv; }
    LDS_WAIT();
    float cx[8][2];
#pragma unroll
    for (int h = 0; h < 8; ++h) { cx[h][0] = 0.f; cx[h][1] = 0.f; }
    for (int k = 0; k < nsel; ++k) { const int s = sel_s[k]; const unsigned w = *(const GAS unsigned*)(F.KV + (size_t)(b * SEQ + s) * CL + 2 * lane); const float k0 = bflo(w), k1 = bfhi(w);
#pragma unroll
        for (int h = 0; h < 8; ++h) { const float p = p_s[h * 256 + k]; cx[h][0] += p * k0; cx[h][1] += p * k1; } }
#pragma unroll
    for (int h = 0; h < 8; ++h) { qa_s[h * 128 + 2 * lane] = cx[h][0]; qa_s[h * 128 + 2 * lane + 1] = cx[h][1]; }
    LDS_WAIT();
    float o8[8]; float ss = 0.f;
#pragma unroll
    for (int h = 0; h < 8; ++h) { float a = 0.f; const float* w = F.in[I_WUV] + h * 64 + lane;
        for (int c = 0; c < 128; ++c) a += qa_s[h * 128 + c] * w[(size_t)c * 512];
        o8[h] = a; ss += a * a; }
    const float rstd = 1.f / sqrtf(wave_sum(ss) * (1.f / 512.f) + EPS);
#pragma unroll
    for (int h = 0; h < 8; ++h) F.MIX[(size_t)m * D + h * 64 + lane] = (bf16)f2bf(o8[h] * rstd * F.in[I_NATT][h * 64 + lane]);
    LDS_WAIT();
}
__device__ __forceinline__ void naive_attn_phase(Frame& F) {
    LAS float* L = (LAS float*)(F.lds + RING_OFF + F.wave * 16384);
    const int gw = F.vcu * NWAVES + F.wave, NGW = F.G * NWAVES;
    for (int idx = gw; idx < M; idx += NGW) { const int b = idx >> 11, tt = idx & (SEQ - 1), t = (b & 1) ? (SEQ - 1 - tt) : tt; naive_attn_query(F, b * SEQ + t, L); }
}

struct Args { const float* in[20]; float* out; unsigned char* ws; int ph_lo, ph_hi, li, pad; };
__global__ void __launch_bounds__(NWAVES * 64, 2) mk_fwd(Args args) {
    extern __shared__ __attribute__((aligned(16))) unsigned char lds[];
    Frame F;
    F.lds = (LAS unsigned char*)lds;
    F.MISC = (volatile LAS unsigned*)(F.lds + MISC_OFF);
    F.tid = threadIdx.x; F.lane = F.tid & 63; F.wave = __builtin_amdgcn_readfirstlane(F.tid >> 6);
    F.G = gridDim.x; { const int bx = blockIdx.x; F.vcu = (F.G % 8 == 0) ? (bx % 8) * (F.G / 8) + bx / 8 : bx; }
    unsigned char* ws = args.ws;
    F.ctl = (gu32*)(ws + WS_CTL);
#pragma unroll
    for (int i = 0; i < 20; ++i) F.in[i] = args.in[i];
    F.out = args.out;
    F.Wgu1 = (bf16*)(ws + WS_WGU1); F.Wd1 = (bf16*)(ws + WS_WD1); F.Win = (bf16*)(ws + WS_WIN); F.Wout = (bf16*)(ws + WS_WOUT); F.Wgu2 = (bf16*)(ws + WS_WGU2); F.Wd2 = (bf16*)(ws + WS_WD2);
    F.Wuk = (bf16*)(ws + WS_WUK); F.WuvT = (bf16*)(ws + WS_WUV);
    F.XN = (bf16*)(ws + WS_XN); F.MIX = (bf16*)(ws + WS_MIX); F.KV = (bf16*)(ws + WS_KV); F.ACT = (bf16*)(ws + WS_ACT); F.PROJ = (bf16*)(ws + WS_ACT); F.MASK = (unsigned*)(ws + WS_MASK);
    for (int u = F.tid; u < (LDS_BYTES - LDSCTL_OFF) / 4; u += NWAVES * 64) ((LAS unsigned*)(F.lds + LDSCTL_OFF))[u] = 0u;
    __syncthreads();
    XcdBarrier bar; bar.bar = (unsigned*)(F.ctl + CW_BAR); bar.x = 0; bar.st = nullptr;
    if (N_LAUNCHES != PER_PHASE) bar = xcd_barrier_post((unsigned*)(F.ctl + CW_BAR), F.MISC + 8);

    const int lo = args.ph_lo, hi = args.ph_hi;
#ifndef PH_MASK
#define PH_MASK 0xFFF
#endif
#define IN(k) (((PH_MASK >> (k)) & 1) && lo <= (k) && (k) < hi)
#define SEAM(k) do { if (IN(k) && IN((k) + 1)) xcd_barrier(bar); } while (0)

    if (IN(0)) { p0_prologue(F); SEAM(0); }
    if (IN(1)) { pg8::Gemm g{F.XN, F.Wgu1, M, FF2, D}; pg8::StaticOrder S; S.init(M, FF2, F.G, (int)blockIdx.x);
        pg8::EpiSwiglu E{F.ACT, FF};
        pg8::gemm_phase<pg8::EpiSwiglu, pg8::StaticOrder, PG8_ALIGN, PG8_SP2>(F.lds + RING_OFF, g, S, E); SEAM(1); }
    if (IN(2)) { pg8::Gemm g{F.ACT, F.Wd1, M, D, FF}; pg8::StaticOrder S; S.init(M, D, F.G, (int)blockIdx.x);
        pg8::EpiRes E{F.in[I_X], F.out, D, 0.5f};
        pg8::gemm_phase<pg8::EpiRes, pg8::StaticOrder, PG8_ALIGN, PG8_SP2>(F.lds + RING_OFF, g, S, E); SEAM(2); }
    if (IN(3)) { norm_phase(F, F.out, F.in[I_NMIX]); SEAM(3); }
    if (IN(4)) { pg8::Gemm g{F.XN, F.Win, M, NPROJ, D}; pg8::StaticOrder S; S.init(M, NPROJ, F.G, (int)blockIdx.x);
        pg8::EpiBf16<0> E{F.PROJ, NPROJ, nullptr, 0, 0, 1.f};
        pg8::gemm_phase<pg8::EpiBf16<0>, pg8::StaticOrder, PG8_ALIGN, PG8_SP2>(F.lds + RING_OFF, g, S, E); SEAM(4); }
    if (IN(5)) { prep_phase(F); SEAM(5); }
    if (IN(6)) { naive_attn_phase(F); SEAM(6); }
    if (IN(7)) { pg8::Gemm g{F.MIX, F.Wout, M, D, D}; pg8::StaticOrder S; S.init(M, D, F.G, (int)blockIdx.x);
        pg8::EpiRes E{F.out, F.out, D, 1.0f};
        pg8::gemm_phase<pg8::EpiRes, pg8::StaticOrder, PG8_ALIGN, PG8_SP2>(F.lds + RING_OFF, g, S, E); SEAM(7); }
    if (IN(8)) { norm_phase(F, F.out, F.in[I_N2]); SEAM(8); }
    if (IN(9)) { pg8::Gemm g{F.XN, F.Wgu2, M, FF2, D}; pg8::StaticOrder S; S.init(M, FF2, F.G, (int)blockIdx.x);
        pg8::EpiSwiglu E{F.ACT, FF};
        pg8::gemm_phase<pg8::EpiSwiglu, pg8::StaticOrder, PG8_ALIGN, PG8_SP2>(F.lds + RING_OFF, g, S, E); SEAM(9); }
    if (IN(10)) { pg8::Gemm g{F.ACT, F.Wd2, M, D, FF}; pg8::StaticOrder S; S.init(M, D, F.G, (int)blockIdx.x);
        pg8::EpiRes E{F.out, F.out, D, 0.5f};
        pg8::gemm_phase<pg8::EpiRes, pg8::StaticOrder, PG8_ALIGN, PG8_SP2>(F.lds + RING_OFF, g, S, E); SEAM(10); }
    if (IN(11)) { const bool poison = __hip_atomic_load((gu32*)(F.ctl + CW_BAR + XB_TMO), RLX_AGENT) != 0u;
        const int gw = F.vcu * NWAVES + F.wave, NGW = F.G * NWAVES;
        for (int m = gw; m < M; m += NGW) rms_row_to_f32(F.lane, F.out + (size_t)m * D, F.in[I_NF], F.out + (size_t)m * D, poison); }
#undef IN
#undef SEAM
}

extern "C" void kernel_launch(void* const* d_in, const int* in_sizes, int n_in, void* d_out, int out_size, void* d_ws, size_t ws_size, hipStream_t stream) {
    static int grid = 0;
    if (grid == 0) {
        if (n_in != 20 || in_sizes[0] != M * D || out_size != M * D || ws_size < WS_END) { fprintf(stderr, "kernel_launch: shape mismatch (n_in %d, in0 %d, out %d, ws %zu); nothing launched\n", n_in, n_in > 0 ? in_sizes[0] : -1, out_size, ws_size); grid = -1; return; }
        int dev = 0, cus = 0, per_cu = 0;
        if (hipGetDevice(&dev) != hipSuccess || hipDeviceGetAttribute(&cus, hipDeviceAttributeMultiprocessorCount, dev) != hipSuccess) { fprintf(stderr, "kernel_launch: hipGetDevice / hipDeviceGetAttribute failed\n"); grid = -1; return; }
        if (hipFuncSetAttribute((const void*)mk_fwd, hipFuncAttributeMaxDynamicSharedMemorySize, LDS_BYTES) != hipSuccess) { fprintf(stderr, "kernel_launch: hipFuncSetAttribute failed\n"); grid = -1; return; }
        if (hipOccupancyMaxActiveBlocksPerMultiprocessor(&per_cu, (const void*)mk_fwd, NWAVES * 64, LDS_BYTES) != hipSuccess || per_cu < 1)
            fprintf(stderr, "kernel_launch: note: occupancy query reports %d workgroups per CU\n", per_cu);
        (void)hipGetLastError();
        grid = cus;
    }
    if (grid < 0) return;
    if (hipMemsetAsync((char*)d_ws + WS_CTL, 0, CTL_ZERO_BYTES, stream) != hipSuccess) { fprintf(stderr, "kernel_launch: hipMemsetAsync failed\n"); return; }
    Args a{};
    for (int i = 0; i < 20; ++i) a.in[i] = (const float*)d_in[i];
    a.out = (float*)d_out; a.ws = (unsigned char*)d_ws;
    for (int li = 0; li < N_LAUNCHES; ++li) {
        a.ph_lo = (N_LAUNCHES == PER_PHASE) ? li : 0; a.ph_hi = (N_LAUNCHES == PER_PHASE) ? li + 1 : PER_PHASE; a.li = li;
        hipLaunchKernelGGL(mk_fwd, dim3(grid), dim3(NWAVES * 64), LDS_BYTES, stream, a);
        const hipError_t le = hipPeekAtLastError();
        if (le != hipSuccess) { fprintf(stderr, "kernel_launch: launch %d failed: %s\n", li, hipGetErrorName(le)); break; }
    }
}
```

```cpp
#include <hip/hip_runtime.h>
#include <cstdio>
#include <cstdint>
namespace pg8 {
#define PG8_LAS __attribute__((address_space(3)))
typedef unsigned short bf16_t;
typedef short bf16x8 __attribute__((ext_vector_type(8)));
typedef float f32x4 __attribute__((ext_vector_type(4)));
typedef unsigned u32x4 __attribute__((ext_vector_type(4)));
constexpr int BM = 256, BK = 64, HALF = 128, HTB = HALF * BK * 2  , STAGE_BYTES = 8 * HTB, NXCD = 8, WGM = 8;

__host__ __device__ __forceinline__ int lds_byte(int r, int c) { const int st = (r >> 4) * 2 + (c >> 5), rr = r & 15, cc = c & 31, ob = rr * 64 + cc * 2; return st * 1024 + (ob ^ (((ob >> 9) & 1) << 5)); }
__host__ __device__ __forceinline__ void stage_rc(int b, int& R, int& C) { const int st = b / 1024, sb = b % 1024, swz = sb ^ (((sb >> 9) & 1) << 5); R = (st >> 1) * 16 + swz / 64; C = (st & 1) * 32 + (swz % 64) / 2; }
__host__ __device__ __forceinline__ int perm32(int rho) { const int n = rho >> 4, i = rho & 15; return 8 * (i >> 2) + 4 * n + (i & 3); }

struct Unit { int pm, pn; };
struct Gemm { const bf16_t* A; const bf16_t* Bt; int M, N, K; };

struct StaticOrder {
    int nM, nN, nwg, G, c;
    __host__ __device__ void init(int M, int N, int G_, int c_) { nM = M / BM; nN = N / BM; nwg = nM * nN; G = G_; c = c_; }
    __host__ __device__ bool next(int i, Unit& u) const {
        const long L = (long)i * G + c; if (L >= nwg) return false;
        int wgid = (int)L; { const int q = nwg / NXCD, r = nwg % NXCD, xcd = wgid % NXCD, off = wgid / NXCD; wgid = (xcd < r ? xcd * (q + 1) : r * (q + 1) + (xcd - r) * q) + off; }
        const int nig = WGM * nN, gid = wgid / nig, fm = gid * WGM, gsz = (nM - fm) < WGM ? (nM - fm) : WGM;
        u.pm = fm + ((wgid % nig) % gsz); u.pn = (wgid % nig) / gsz; return true;
    }
    __device__ __forceinline__ void a_ready(const Unit&) const {}
    __device__ __forceinline__ void done(const Unit&) const {}
};

__device__ __forceinline__ unsigned cvt_pk_bf16(float lo, float hi) { unsigned r; asm volatile("v_cvt_pk_bf16_f32 %0, %1, %2" : "=v"(r) : "v"(lo), "v"(hi)); return r; }
typedef float f32x2 __attribute__((ext_vector_type(2)));
__device__ __forceinline__ f32x2 gelu_pk(f32x2 v) {
    const f32x2 av = __builtin_elementwise_abs(v), d = av * 0.2316418882f + 1.0f;
    f32x2 t; t.x = __builtin_amdgcn_rcpf(d.x); t.y = __builtin_amdgcn_rcpf(d.y);
    f32x2 q = t * 0.5307027145f + (-0.7265760135f); q = q * t + 0.7107068705f; q = q * t + (-0.142248368f); q = q * t + 0.127414796f; q = q * t;
    const f32x2 s = (v * v) * (-0.72134752044f);
    f32x2 e; e.x = __builtin_amdgcn_exp2f(s.x); e.y = __builtin_amdgcn_exp2f(s.y);
    const f32x2 m = v * (q * e), r = v - m;
    f32x2 o; o.x = v.x < 0.f ? m.x : r.x; o.y = v.y < 0.f ? m.y : r.y; return o;
}

template <int ACT  > struct EpiBf16 {
    static constexpr bool PERM = true, AFTER_DRAIN = false; static_assert(ACT == 0 || ACT == 1, "EpiBf16: ACT is 0 (none) or 1 (gelu_pk)");
    bf16_t* O; int ldc; const float* bias; int split_cols; size_t split_stride; float scale0;
    __device__ __forceinline__ void operator()(const f32x4 (&acc)[2][2][4][2], const Unit& u, int wr, int wc, int fr, int fq) const {
        const int row0 = u.pm * BM + wr * 64 + fr; int colt = u.pn * BM; bf16_t* base = O;
        float sc = 1.f; if (split_cols) { const int t = colt / split_cols; base += (size_t)t * split_stride; colt -= t * split_cols; if (t == 0) sc = scale0; }
        const int col0 = colt + wc * 32 + 8 * fq, bcol0 = u.pn * BM + wc * 32 + 8 * fq;
        f32x4 bv[2][2];
#pragma unroll
        for (int bj = 0; bj < 2; ++bj)
#pragma unroll
            for (int n = 0; n < 2; ++n) bv[bj][n] = bias ? *(const f32x4*)(bias + bcol0 + bj * HALF + 4 * n) : (f32x4){0.f, 0.f, 0.f, 0.f};
#pragma unroll
        for (int ai = 0; ai < 2; ++ai)
#pragma unroll
            for (int m = 0; m < 4; ++m) { bf16_t* rowp = base + (size_t)(row0 + ai * HALF + m * 16) * ldc + col0;
#pragma unroll
                for (int bj = 0; bj < 2; ++bj) { f32x4 v0 = acc[ai][bj][m][0] + bv[bj][0], v1 = acc[ai][bj][m][1] + bv[bj][1];
                    if (ACT == 1) { f32x2 a = gelu_pk((f32x2){v0[0], v0[1]}), b = gelu_pk((f32x2){v0[2], v0[3]}), c = gelu_pk((f32x2){v1[0], v1[1]}), d = gelu_pk((f32x2){v1[2], v1[3]});
                        v0 = (f32x4){a.x, a.y, b.x, b.y}; v1 = (f32x4){c.x, c.y, d.x, d.y}; }
                    v0 = v0 * sc; v1 = v1 * sc; u32x4 w; w.x = cvt_pk_bf16(v0[0], v0[1]); w.y = cvt_pk_bf16(v0[2], v0[3]); w.z = cvt_pk_bf16(v1[0], v1[1]); w.w = cvt_pk_bf16(v1[2], v1[3]);
                    *(u32x4*)(rowp + bj * HALF) = w; } }
    }
};


__device__ __forceinline__ float silu_mul(float g, float u) { const float e = __builtin_amdgcn_exp2f(g * -1.4426950408889634f); return g * __builtin_amdgcn_rcpf(1.0f + e) * u; }
struct EpiSwiglu {
    static constexpr bool PERM = true, AFTER_DRAIN = false;
    bf16_t* O; int ldc;
    __device__ __forceinline__ void operator()(const f32x4 (&acc)[2][2][4][2], const Unit& u, int wr, int wc, int fr, int fq) const {
        const int row0 = u.pm * BM + wr * 64 + fr, col0 = u.pn * HALF + wc * 32 + 8 * fq;
#pragma unroll
        for (int ai = 0; ai < 2; ++ai)
#pragma unroll
            for (int m = 0; m < 4; ++m) { bf16_t* rowp = O + (size_t)(row0 + ai * HALF + m * 16) * ldc + col0;
                const f32x4 g0 = acc[ai][0][m][0], g1 = acc[ai][0][m][1], u0 = acc[ai][1][m][0], u1 = acc[ai][1][m][1];
                u32x4 w; w.x = cvt_pk_bf16(silu_mul(g0[0], u0[0]), silu_mul(g0[1], u0[1])); w.y = cvt_pk_bf16(silu_mul(g0[2], u0[2]), silu_mul(g0[3], u0[3]));
                w.z = cvt_pk_bf16(silu_mul(g1[0], u1[0]), silu_mul(g1[1], u1[1])); w.w = cvt_pk_bf16(silu_mul(g1[2], u1[2]), silu_mul(g1[3], u1[3]));
                *(u32x4*)rowp = w; }
    }
};
struct EpiRes {
    static constexpr bool PERM = false, AFTER_DRAIN = false;
    const float* base; float* out; int ldc; float scale;
    __device__ __forceinline__ void operator()(const f32x4 (&acc)[2][2][4][2], const Unit& u, int wr, int wc, int fr, int fq) const {
        const int row0 = u.pm * BM + wr * 64 + fr, col0 = u.pn * BM + wc * 32 + 4 * fq;
#pragma unroll
        for (int ai = 0; ai < 2; ++ai) {
            f32x4 pre[4][2][2];
#pragma unroll
            for (int m = 0; m < 4; ++m) { const size_t off = (size_t)(row0 + ai * HALF + m * 16) * ldc + col0;
#pragma unroll
                for (int bj = 0; bj < 2; ++bj)
#pragma unroll
                    for (int n = 0; n < 2; ++n) pre[m][bj][n] = *(const f32x4*)(base + off + bj * HALF + n * 16); }
#pragma unroll
            for (int m = 0; m < 4; ++m) { const size_t off = (size_t)(row0 + ai * HALF + m * 16) * ldc + col0;
#pragma unroll
                for (int bj = 0; bj < 2; ++bj)
#pragma unroll
                    for (int n = 0; n < 2; ++n) *(f32x4*)(out + off + bj * HALF + n * 16) = pre[m][bj][n] + acc[ai][bj][m][n] * scale; }
        }
    }
};

template <class Epi, class Sched, bool ALIGN_EPI = false, bool SP2 = false>
__device__ __forceinline__ void gemm_phase(PG8_LAS unsigned char* lds, const Gemm g, const Sched& S, const Epi& E) {
    const int tid = threadIdx.x, wid = __builtin_amdgcn_readfirstlane(tid >> 6), lane = tid & 63, wr = wid >> 2, wc = wid & 3, fr = lane & 15, fq = lane >> 4;
    const int K = g.K, nt = K / BK;
    unsigned voffA[2], voffB[2];
#pragma unroll
    for (int i = 0; i < 2; ++i) { int R, C; stage_rc(tid * 16 + i * 8192, R, C); const int Rb = Epi::PERM ? ((R & ~31) + perm32(R & 31)) : R;
        voffA[i] = (unsigned)(R * K + C) * 2u; voffB[i] = (unsigned)(Rb * K + C) * 2u; }
    const size_t kstep = (size_t)(BK * 2);
    const size_t hstep = (size_t)HALF * K * 2;
    const size_t tstep = 2 * hstep;
    const unsigned ldsw = (unsigned)wid * 1024u;
    const int aoff = lds_byte(wr * 64 + fr, fq * 8), boff = lds_byte(wc * 32 + fr, fq * 8);
#define PG8_SA(b, h) (((b) * 2 + (h)) * HTB)
#define PG8_SB(b, h) ((4 + (b) * 2 + (h)) * HTB)
#define PG8_STAGE(bufoff, gbase, voff) do { _Pragma("unroll") for (int _i = 0; _i < 2; ++_i) \
        __builtin_amdgcn_global_load_lds((const unsigned*)((const char*)(gbase) + (voff)[_i]), (PG8_LAS unsigned*)(lds + (bufoff) + ldsw + _i * 8192), 16, 0, 0); } while (0)
#define PG8_LDA(dst, b, h) do { _Pragma("unroll") for (int m = 0; m < 4; ++m) _Pragma("unroll") for (int k = 0; k < 2; ++k) dst[m][k] = *(const PG8_LAS bf16x8*)(lds + PG8_SA(b, h) + aoff + m * 2048 + k * 1024); } while (0)
#define PG8_LDB(dst, b, h) do { _Pragma("unroll") for (int n = 0; n < 2; ++n) _Pragma("unroll") for (int k = 0; k < 2; ++k) dst[n][k] = *(const PG8_LAS bf16x8*)(lds + PG8_SB(b, h) + boff + n * 2048 + k * 1024); } while (0)
#define PG8_MMA(ai, bj, At, Bt) do { __builtin_amdgcn_s_setprio(1); _Pragma("unroll") for (int m = 0; m < 4; ++m) _Pragma("unroll") for (int n = 0; n < 2; ++n) _Pragma("unroll") for (int k = 0; k < 2; ++k) \
        acc[ai][bj][m][n] = __builtin_amdgcn_mfma_f32_16x16x32_bf16(Bt[n][k], At[m][k], acc[ai][bj][m][n], 0, 0, 0); __builtin_amdgcn_s_setprio(0); } while (0)
#define PG8_WAIT_V(n) asm volatile("s_waitcnt vmcnt(" #n ")" ::: "memory")
#define PG8_WAIT_L(n) asm volatile("s_waitcnt lgkmcnt(" #n ")" ::: "memory")
#define PG8_BAR __builtin_amdgcn_s_barrier()
#define PG8_SCHED __builtin_amdgcn_sched_barrier(0)
    Unit cur, nxt; int ui = 0;
    if (!S.next(0, cur)) return;
    f32x4 acc[2][2][4][2];
#pragma unroll
    for (int a = 0; a < 2; ++a)
#pragma unroll
        for (int b = 0; b < 2; ++b)
#pragma unroll
            for (int m = 0; m < 4; ++m)
#pragma unroll
                for (int n = 0; n < 2; ++n) acc[a][b][m][n] = (f32x4){0.f, 0.f, 0.f, 0.f};
    bf16x8 At[4][2], B0[2][2], B1[2][2];
    const char* cA = (const char*)g.A + (size_t)cur.pm * tstep; const char* cB = (const char*)g.Bt + (size_t)cur.pn * tstep;
    S.a_ready(cur);
    if constexpr (SP2) {
        PG8_STAGE(PG8_SB(0, 0), cB, voffB); PG8_STAGE(PG8_SB(0, 1), cB + hstep, voffB); PG8_STAGE(PG8_SA(0, 0), cA, voffA); PG8_STAGE(PG8_SA(0, 1), cA + hstep, voffA);
        if (wr == 1) PG8_BAR;
        PG8_WAIT_V(2); PG8_BAR;
        PG8_STAGE(PG8_SB(1, 0), cB + kstep, voffB); PG8_STAGE(PG8_SA(1, 0), cA + kstep, voffA); PG8_STAGE(PG8_SB(1, 1), cB + hstep + kstep, voffB);
        PG8_WAIT_V(6); PG8_BAR;
    } else {
        PG8_STAGE(PG8_SB(0, 0), cB, voffB); PG8_STAGE(PG8_SA(0, 0), cA, voffA); PG8_STAGE(PG8_SB(0, 1), cB + hstep, voffB); PG8_STAGE(PG8_SA(0, 1), cA + hstep, voffA);
        if (wr == 1) PG8_BAR;
        PG8_WAIT_V(4); PG8_BAR;
        PG8_STAGE(PG8_SB(1, 0), cB + kstep, voffB); PG8_STAGE(PG8_SA(1, 0), cA + kstep, voffA); PG8_STAGE(PG8_SB(1, 1), cB + hstep + kstep, voffB);
        PG8_WAIT_V(6); PG8_BAR;
    }
    for (;;) {
        const bool has_next = S.next(ui + 1, nxt);
        const char* nA = has_next ? (const char*)g.A + (size_t)nxt.pm * tstep : cA; const char* nB = has_next ? (const char*)g.Bt + (size_t)nxt.pn * tstep : cB;
        for (int t = 0; t < nt; t += 2) {
            const bool last = (t == nt - 2);
            const char* a1 = cA + (size_t)(t + 1) * kstep;
            const char* a2 = last ? nA : cA + (size_t)(t + 2) * kstep; const char* b2 = last ? nB : cB + (size_t)(t + 2) * kstep;
            const char* a3 = a2 + kstep; const char* b3 = b2 + kstep;
            if (last && has_next) S.a_ready(nxt);
            if constexpr (SP2) {
            PG8_LDB(B0, 0, 0); PG8_LDB(B1, 0, 1); PG8_SCHED; PG8_LDA(At, 0, 0); PG8_STAGE(PG8_SA(1, 1), a1 + hstep, voffA);
            PG8_WAIT_V(8); PG8_WAIT_L(0); PG8_BAR; PG8_MMA(0, 0, At, B0); PG8_MMA(0, 1, At, B1); PG8_BAR; PG8_SCHED;
            PG8_LDA(At, 0, 1); PG8_STAGE(PG8_SB(0, 0), b2, voffB); PG8_STAGE(PG8_SB(0, 1), b2 + hstep, voffB); PG8_STAGE(PG8_SA(0, 0), a2, voffA);
            PG8_WAIT_V(8); PG8_WAIT_L(0); PG8_BAR; PG8_MMA(1, 0, At, B0); PG8_MMA(1, 1, At, B1); PG8_BAR; PG8_SCHED;
            PG8_LDB(B0, 1, 0); PG8_LDB(B1, 1, 1); PG8_SCHED; PG8_LDA(At, 1, 0); PG8_STAGE(PG8_SA(0, 1), a2 + hstep, voffA);
            PG8_WAIT_V(8); PG8_WAIT_L(0); PG8_BAR; PG8_MMA(0, 0, At, B0); PG8_MMA(0, 1, At, B1); PG8_BAR; PG8_SCHED;
            PG8_LDA(At, 1, 1); PG8_STAGE(PG8_SB(1, 0), b3, voffB); PG8_STAGE(PG8_SB(1, 1), b3 + hstep, voffB); PG8_STAGE(PG8_SA(1, 0), a3, voffA);
            PG8_WAIT_V(8); PG8_WAIT_L(0); PG8_BAR; PG8_MMA(1, 0, At, B0); PG8_MMA(1, 1, At, B1); PG8_BAR; PG8_SCHED;
            } else {
            PG8_LDB(B0, 0, 0); PG8_SCHED; PG8_LDA(At, 0, 0); PG8_STAGE(PG8_SA(1, 1), a1 + hstep, voffA);
            PG8_WAIT_L(8); PG8_BAR; PG8_WAIT_L(0); PG8_MMA(0, 0, At, B0); PG8_BAR; PG8_SCHED;
            PG8_LDB(B1, 0, 1); PG8_STAGE(PG8_SB(0, 0), b2, voffB);
            PG8_BAR; PG8_WAIT_L(0); PG8_MMA(0, 1, At, B1); PG8_BAR;
            PG8_LDA(At, 0, 1); PG8_STAGE(PG8_SA(0, 0), a2, voffA);
            PG8_BAR; PG8_WAIT_L(0); PG8_MMA(1, 0, At, B0); PG8_BAR; PG8_SCHED;
            PG8_STAGE(PG8_SB(0, 1), b2 + hstep, voffB);
            PG8_WAIT_V(6); PG8_BAR; PG8_MMA(1, 1, At, B1); PG8_BAR;
            PG8_LDB(B0, 1, 0); PG8_SCHED; PG8_LDA(At, 1, 0); PG8_STAGE(PG8_SA(0, 1), a2 + hstep, voffA);
            PG8_WAIT_L(8); PG8_BAR; PG8_WAIT_L(0); PG8_MMA(0, 0, At, B0); PG8_BAR; PG8_SCHED;
            PG8_LDB(B1, 1, 1); PG8_STAGE(PG8_SB(1, 0), b3, voffB);
            PG8_BAR; PG8_WAIT_L(0); PG8_MMA(0, 1, At, B1); PG8_BAR;
            PG8_LDA(At, 1, 1); PG8_STAGE(PG8_SA(1, 0), a3, voffA);
            PG8_BAR; PG8_WAIT_L(0); PG8_MMA(1, 0, At, B0); PG8_BAR; PG8_SCHED;
            PG8_STAGE(PG8_SB(1, 1), b3 + hstep, voffB);
            PG8_WAIT_V(6); PG8_BAR; PG8_MMA(1, 1, At, B1); PG8_BAR;
            }
        }
        if constexpr (ALIGN_EPI) { if (wr == 0) PG8_BAR; }
        if constexpr (!Epi::AFTER_DRAIN) { E(acc, cur, wr, wc, fr, fq); S.done(cur); }
        if (!has_next) break;
#pragma unroll
        for (int a = 0; a < 2; ++a)
#pragma unroll
            for (int b = 0; b < 2; ++b)
#pragma unroll
                for (int m = 0; m < 4; ++m)
#pragma unroll
                    for (int n = 0; n < 2; ++n) acc[a][b][m][n] = (f32x4){0.f, 0.f, 0.f, 0.f};
        cur = nxt; cA = nA; cB = nB; ++ui;
        if constexpr (ALIGN_EPI) { if (wr == 1) PG8_BAR; }
    }
    PG8_WAIT_V(0);
    if constexpr (!ALIGN_EPI) { if (wr == 0) PG8_BAR; }
    PG8_BAR;
    if constexpr (Epi::AFTER_DRAIN) { E.fused(acc, cur, wr, wc, fr, fq, lds, wid, lane); S.done(cur); }
#undef PG8_SA
#undef PG8_SB
#undef PG8_STAGE
#undef PG8_LDA
#undef PG8_LDB
#undef PG8_MMA
#undef PG8_WAIT_V
#undef PG8_WAIT_L
#undef PG8_BAR
#undef PG8_SCHED
}
}

#ifndef PG8_SP2
#define PG8_SP2 true
#endif
#ifndef PG8_ALIGN
#define PG8_ALIGN true
#endif

constexpr int NWAVES = 8;
#ifndef MK_N_LAUNCHES
#define MK_N_LAUNCHES 1
#endif
constexpr int PER_PHASE = 12;
constexpr int N_LAUNCHES = MK_N_LAUNCHES;
static_assert(N_LAUNCHES == 1 || N_LAUNCHES == PER_PHASE, "MK_N_LAUNCHES is 1 or 12");

constexpr int BATCH = 8, SEQ = 2048, D = 1024, M = BATCH * SEQ;
constexpr int FF = 2816, FF2 = 2 * FF;
constexpr int NH = 8, HD = 64, CL = 128, TOPK = 256;
constexpr int NPROJ = 2816;
constexpr int PQ = 0, PQI = 512, PCKV = 1024, PKI = 1152, PWI = 1216, PGB = 1280, PGC = 1792, PXIN = 2304;
constexpr int WIN_N = 2760;
constexpr float EPS = 1e-6f;
constexpr float IDX_SCALE = 0.044194173824159216f;

constexpr size_t MiB = 1u << 20;
constexpr size_t WS_CTL = 0, CTL_ZERO_BYTES = 1 * MiB;
constexpr size_t WS_WUK = 1 * MiB, WS_WUV = 1 * MiB + 256 * 1024;
constexpr size_t WS_WGU1 = 2 * MiB, WS_WD1 = 14 * MiB, WS_WIN = 20 * MiB, WS_WOUT = 26 * MiB, WS_WGU2 = 28 * MiB, WS_WD2 = 40 * MiB;
constexpr size_t WS_XN = 48 * MiB;
constexpr size_t WS_MIX = 80 * MiB;
constexpr size_t WS_KV = 112 * MiB;
constexpr size_t WS_MASK = 116 * MiB;
constexpr size_t WS_ACT = 128 * MiB;
constexpr size_t WS_END = 216 * MiB;
static_assert(WS_WGU1 + (size_t)FF2 * D * 2 <= WS_WD1 && WS_WD1 + (size_t)D * FF * 2 <= WS_WIN && WS_WIN + (size_t)NPROJ * D * 2 <= WS_WOUT && WS_WOUT + (size_t)D * D * 2 <= WS_WGU2 &&
              WS_WGU2 + (size_t)FF2 * D * 2 <= WS_WD2 && WS_WD2 + (size_t)D * FF * 2 <= WS_XN && WS_ACT + (size_t)M * FF * 2 <= WS_END, "d_ws map");
constexpr int CW_BAR = 4096;

constexpr int RING_OFF = 0, RING_BYTES = 131072;
constexpr int LDSCTL_OFF = RING_BYTES, MISC_OFF = LDSCTL_OFF + 320;
constexpr int LDS_BYTES = 147456;
static_assert(MISC_OFF + 128 <= LDS_BYTES, "LDS map");
#define GAS __attribute__((address_space(1)))
#define LAS __attribute__((address_space(3)))
typedef unsigned short bf16;
typedef unsigned v4u __attribute__((ext_vector_type(4)));
typedef float f32x4 __attribute__((ext_vector_type(4)));
typedef short bf16x8 __attribute__((ext_vector_type(8)));
typedef GAS unsigned gu32;
typedef GAS unsigned long long gu64;
#define RLX_AGENT __ATOMIC_RELAXED, __HIP_MEMORY_SCOPE_AGENT
#define LDS_WAIT() asm volatile("s_waitcnt lgkmcnt(0)" ::: "memory")
#define VM_WAIT() asm volatile("s_waitcnt vmcnt(0)" ::: "memory")
__device__ __forceinline__ unsigned long long rt() { return __builtin_amdgcn_s_memrealtime(); }
__device__ __forceinline__ unsigned f2bf(float f) { unsigned u = __builtin_bit_cast(unsigned, f); return (u + 0x7fffu + ((u >> 16) & 1u)) >> 16; }
__device__ __forceinline__ unsigned pk2(float lo, float hi) { return f2bf(lo) | (f2bf(hi) << 16); }

#define XB_TMO      128
#define XB_XCNT(j)  (256  + 64 * (j))
#define XB_XSUB(j)  (1280 + 64 * (j))
#define XB_XGEN(j)  (2304 + 64 * (j))
#define XB_TOP      3328
#define XB_TOPGEN   3392
#define XCD_BAR_WORDS 3456
#define XB_SPIN_CAP (1u << 18)

__device__ __forceinline__ unsigned xb_ld(unsigned* p)              { return __hip_atomic_load(p, __ATOMIC_RELAXED, __HIP_MEMORY_SCOPE_AGENT); }
__device__ __forceinline__ unsigned xb_add(unsigned* p, unsigned v) { return __hip_atomic_fetch_add(p, v, __ATOMIC_RELAXED, __HIP_MEMORY_SCOPE_AGENT); }
__device__ __forceinline__ unsigned xb_xcc_id() { return (unsigned)__builtin_amdgcn_s_getreg((3 << 11) | 20) & 0xFu; }
#define XB_SPIN(cond, bar) do { unsigned _sp = 0; while (cond) { __builtin_amdgcn_s_sleep(1); \
    if ((++_sp & 255u) == 0u) { if (xb_ld(&(bar)[XB_TMO])) break; if (_sp > XB_SPIN_CAP) { atomicAdd(&(bar)[XB_TMO], 1u); break; } } } } while (0)

struct XcdBarrier {
    unsigned* bar; unsigned x;
    volatile LAS unsigned* st;
};

__device__ __forceinline__ XcdBarrier xcd_barrier_post(unsigned* bar, volatile LAS unsigned* st) {
    XcdBarrier b; b.bar = bar; b.x = xb_xcc_id(); b.st = st;
    if (threadIdx.x == 0) (void)xb_add(&bar[XB_XCNT(b.x)], 1u);
    return b;
}
__device__ __forceinline__ void xcd_barrier_complete(unsigned* bar, unsigned x, unsigned& nloc, unsigned& nx) {
    const unsigned G = gridDim.x * gridDim.y * gridDim.z;
    unsigned sum, cnt, mine, sp = 0u;
    for (;;) {
        sum = 0u; cnt = 0u; mine = 0u;
#pragma unroll
        for (unsigned j = 0; j < 16; ++j) { const unsigned c = xb_ld(&bar[XB_XCNT(j)]); sum += c; cnt += (c > 0u) ? 1u : 0u; mine = (j == x) ? c : mine; }
        if (sum == G) break;
        __builtin_amdgcn_s_sleep(1);
        if ((++sp & 255u) == 0u) { if (xb_ld(&bar[XB_TMO])) break; if (sp > XB_SPIN_CAP) { atomicAdd(&bar[XB_TMO], 1u); break; } }
    }
    nloc = mine > 0u ? mine : 1u; nx = cnt > 0u ? cnt : 1u;
}

__device__ __forceinline__ void xcd_barrier(const XcdBarrier& b) {
    asm volatile("s_waitcnt vmcnt(0)" ::: "memory");
    __syncthreads();
    if (threadIdx.x == 0) {
        unsigned* bar = b.bar;
        __builtin_amdgcn_s_waitcnt(0);
        unsigned nloc = b.st[0], nx = b.st[1];
        if (nloc == 0u) { xcd_barrier_complete(bar, b.x, nloc, nx); b.st[0] = nloc; b.st[1] = nx; }
        const unsigned old = xb_add(&bar[XB_XSUB(b.x)], 1u);
        const unsigned gen = old / nloc;
        if (old + 1u == (gen + 1u) * nloc) {
            __builtin_amdgcn_fence(__ATOMIC_RELEASE, "agent");
            asm volatile("s_waitcnt vmcnt(0)" ::: "memory");
            const unsigned og = xb_add(&bar[XB_TOP], 1u);
            const unsigned tg = og / nx;
            if (og + 1u == (tg + 1u) * nx) xb_add(&bar[XB_TOPGEN], 1u);
            else XB_SPIN(xb_ld(&bar[XB_TOPGEN]) == tg, bar);
            __builtin_amdgcn_fence(__ATOMIC_ACQUIRE, "agent");
            xb_add(&bar[XB_XGEN(b.x)], 1u);
            asm volatile("s_waitcnt vmcnt(0)" ::: "memory");
        } else {
            XB_SPIN(xb_ld(&bar[XB_XGEN(b.x)]) == gen, bar);
            __builtin_amdgcn_fence(__ATOMIC_ACQUIRE, "agent");
            asm volatile("s_waitcnt vmcnt(0)" ::: "memory");
        }
    }
    __syncthreads();
}


struct Frame {
    LAS unsigned char* lds;
    volatile LAS unsigned* MISC;
    gu32* ctl;
    int tid, lane, wave;
    int vcu, G;
    const float* in[20]; float* out;
    bf16 *Wgu1, *Wd1, *Win, *Wout, *Wgu2, *Wd2, *Wuk, *WuvT;
    bf16 *XN, *MIX, *KV, *ACT, *PROJ; unsigned* MASK;
};
enum { I_X = 0, I_N1, I_G1, I_U1, I_D1, I_NMIX, I_WIN, I_NKV, I_WUK, I_WUV, I_RELB, I_CONVW, I_NATT, I_NCONV, I_WOUT, I_N2, I_G2, I_U2, I_D2, I_NF };

__device__ __forceinline__ float wave_sum(float v) {
#pragma unroll
    for (int o = 1; o < 64; o <<= 1) v += __shfl_xor(v, o);
    return v;
}
__device__ __forceinline__ float wave_max(float v) {
#pragma unroll
    for (int o = 1; o < 64; o <<= 1) v = fmaxf(v, __shfl_xor(v, o));
    return v;
}
__device__ __forceinline__ float bflo(unsigned w) { return __uint_as_float(w << 16); }
__device__ __forceinline__ float bfhi(unsigned w) { return __uint_as_float(w & 0xffff0000u); }

struct Src { const float* W; int N; int col; };
struct MapPlain { const float* W; int N; __device__ __forceinline__ Src operator()(int d) const { return Src{W, N, d}; } };
struct MapGU { const float* W; __device__ __forceinline__ Src operator()(int d) const { return Src{W, FF, (d >> 8) * 128 + (d & 127)}; } };
struct MapWin { const float* W; __device__ __forceinline__ Src operator()(int d) const { int c;
    if (d < 512) c = d;
    else if (d < 1024) c = 640 + (d - 512);
    else if (d < 1152) c = 512 + (d - 1024);
    else if (d < 1224) c = d;
    else if (d < 1280) c = -1;
    else if (d < 1792) c = 1224 + (d - 1280);
    else if (d < 2304) c = 1736 + (d - 1792);
    else c = 2248 + (d - 2304);
    return Src{W, WIN_N, c}; } };
template <class MAP>
__device__ __forceinline__ void p0_transpose_item(const MAP& map, int K, int ndg, bf16* WT, LAS float* scr, int item, int lane) {
    const int kb = item / ndg, dg = item % ndg, k0 = 64 * kb, d0 = 32 * dg;
    const Src src = map(d0 + (lane & 31)); const int sc = src.col; const float* wp = src.W + (size_t)(k0 + (lane >> 5)) * src.N + (sc >= 0 ? sc : 0);
#pragma unroll 8
    for (int i = 0; i < 32; ++i) { const int kk = 2 * i + (lane >> 5); scr[kk * 33 + (lane & 31)] = sc >= 0 ? wp[(size_t)(2 * i) * src.N] : 0.f; }
    LDS_WAIT(); asm volatile("" ::: "memory");
    const int c = lane & 7;
#pragma unroll
    for (int j = 0; j < 4; ++j) { const int n = (lane >> 3) + 8 * j; const LAS float* s = scr + (8 * c) * 33 + n;
        v4u o; o.x = pk2(s[0 * 33], s[1 * 33]); o.y = pk2(s[2 * 33], s[3 * 33]); o.z = pk2(s[4 * 33], s[5 * 33]); o.w = pk2(s[6 * 33], s[7 * 33]);
        *(GAS v4u*)(WT + (size_t)(d0 + n) * K + k0 + 8 * c) = o; }
    LDS_WAIT(); asm volatile("" ::: "memory");
}
__device__ __forceinline__ void rms_row_to_bf16(int lane, const float* xrow, const float* gain, bf16* orow) {
    const GAS f32x4* xr = (const GAS f32x4*)xrow + lane; const GAS f32x4* gr = (const GAS f32x4*)gain + lane;
    f32x4 v[4]; float s = 0.f;
#pragma unroll
    for (int j = 0; j < 4; ++j) { v[j] = xr[64 * j]; s += (v[j].x * v[j].x + v[j].y * v[j].y) + (v[j].z * v[j].z + v[j].w * v[j].w); }
    const float rstd = 1.f / sqrtf(wave_sum(s) * (1.f / D) + EPS);
    GAS unsigned long long* o8 = (GAS unsigned long long*)orow + lane;
#pragma unroll
    for (int j = 0; j < 4; ++j) { const f32x4 g = gr[64 * j]; o8[64 * j] = (unsigned long long)pk2(v[j].x * rstd * g.x, v[j].y * rstd * g.y) | ((unsigned long long)pk2(v[j].z * rstd * g.z, v[j].w * rstd * g.w) << 32); }
}
__device__ __forceinline__ void rms_row_to_f32(int lane, const float* xrow, const float* gain, float* orow, bool poison) {
    const GAS f32x4* xr = (const GAS f32x4*)xrow + lane; const GAS f32x4* gr = (const GAS f32x4*)gain + lane;
    f32x4 v[4]; float s = 0.f;
#pragma unroll
    for (int j = 0; j < 4; ++j) { v[j] = xr[64 * j]; s += (v[j].x * v[j].x + v[j].y * v[j].y) + (v[j].z * v[j].z + v[j].w * v[j].w); }
    float rstd = 1.f / sqrtf(wave_sum(s) * (1.f / D) + EPS); if (poison) rstd = __builtin_nanf("");
    GAS f32x4* o = (GAS f32x4*)orow + lane;
#pragma unroll
    for (int j = 0; j < 4; ++j) { const f32x4 g = gr[64 * j]; o[64 * j] = v[j] * rstd * g; }
}
__device__ __forceinline__ void p0_prologue(Frame& F) {
    LAS float* scr = (LAS float*)(F.lds + RING_OFF + F.wave * 16384);
    const int gw = F.vcu * NWAVES + F.wave, NGW = F.G * NWAVES;
    constexpr int I_GU = (D / 64) * (FF2 / 32), I_DN = (FF / 64) * (D / 32), I_IN = (D / 64) * (NPROJ / 32), I_OUT = (D / 64) * (D / 32);
    constexpr int NITEMS = 2 * I_GU + 2 * I_DN + I_IN + I_OUT;
    for (int it = gw; it < NITEMS; it += NGW) {
        int r = it;
        if (r < I_GU) { if (((r % (FF2 / 32)) & 7) < 4) p0_transpose_item(MapGU{F.in[I_G1]}, D, FF2 / 32, F.Wgu1, scr, r, F.lane); else p0_transpose_item(MapGU{F.in[I_U1]}, D, FF2 / 32, F.Wgu1, scr, r, F.lane); continue; } r -= I_GU;
        if (r < I_GU) { if (((r % (FF2 / 32)) & 7) < 4) p0_transpose_item(MapGU{F.in[I_G2]}, D, FF2 / 32, F.Wgu2, scr, r, F.lane); else p0_transpose_item(MapGU{F.in[I_U2]}, D, FF2 / 32, F.Wgu2, scr, r, F.lane); continue; } r -= I_GU;
        if (r < I_DN) { p0_transpose_item(MapPlain{F.in[I_D1], D}, FF, D / 32, F.Wd1, scr, r, F.lane); continue; } r -= I_DN;
        if (r < I_DN) { p0_transpose_item(MapPlain{F.in[I_D2], D}, FF, D / 32, F.Wd2, scr, r, F.lane); continue; } r -= I_DN;
        if (r < I_IN) { p0_transpose_item(MapWin{F.in[I_WIN]}, D, NPROJ / 32, F.Win, scr, r, F.lane); continue; } r -= I_IN;
        p0_transpose_item(MapPlain{F.in[I_WOUT], D}, D, D / 32, F.Wout, scr, r, F.lane);
    }
    for (int m = gw; m < M; m += NGW) rms_row_to_bf16(F.lane, F.in[I_X] + (size_t)m * D, F.in[I_N1], F.XN + (size_t)m * D);
}
__device__ __forceinline__ void norm_phase(Frame& F, const float* src, const float* gain) {
    const int gw = F.vcu * NWAVES + F.wave, NGW = F.G * NWAVES;
    for (int m = gw; m < M; m += NGW) rms_row_to_bf16(F.lane, src + (size_t)m * D, gain, F.XN + (size_t)m * D);
}

__device__ __forceinline__ void ld8bf(const bf16* p, float (&f)[8]) { const v4u w = *(const GAS v4u*)p; f[0] = bflo(w.x); f[1] = bfhi(w.x); f[2] = bflo(w.y); f[3] = bfhi(w.y); f[4] = bflo(w.z); f[5] = bfhi(w.z); f[6] = bflo(w.w); f[7] = bfhi(w.w); }
__device__ __forceinline__ void prep_phase(Frame& F) {
    const int gw = F.vcu * NWAVES + F.wave, NGW = F.G * NWAVES, lane = F.lane;
    const float* cw = F.in[I_CONVW];
    for (int m = gw; m < M; m += NGW) {
        const bf16* prow = F.PROJ + (size_t)m * NPROJ; const int t = m & (SEQ - 1);
        {
            const unsigned w = *(const GAS unsigned*)(prow + PCKV + 2 * lane); const float a = bflo(w), b = bfhi(w);
            const float rstd = 1.f / sqrtf(wave_sum(a * a + b * b) * (1.f / CL) + EPS);
            const float g0 = F.in[I_NKV][2 * lane], g1 = F.in[I_NKV][2 * lane + 1];
            *(GAS unsigned*)(F.KV + (size_t)m * CL + 2 * lane) = pk2(a * rstd * g0, b * rstd * g1);
        }
        {
            const int c0 = 8 * lane; float gb[8], gc[8], xi[8], y[8];
            ld8bf(prow + PGB + c0, gb); ld8bf(prow + PGC + c0, gc); ld8bf(prow + PXIN + c0, xi);
#pragma unroll
            for (int e = 0; e < 8; ++e) y[e] = cw[2 * 512 + c0 + e] * (gc[e] * xi[e]);
            if (t >= 1) { ld8bf(prow - NPROJ + PGC + c0, gc); ld8bf(prow - NPROJ + PXIN + c0, xi);
#pragma unroll
                for (int e = 0; e < 8; ++e) y[e] += cw[1 * 512 + c0 + e] * (gc[e] * xi[e]); }
            if (t >= 2) { ld8bf(prow - 2 * NPROJ + PGC + c0, gc); ld8bf(prow - 2 * NPROJ + PXIN + c0, xi);
#pragma unroll
                for (int e = 0; e < 8; ++e) y[e] += cw[0 * 512 + c0 + e] * (gc[e] * xi[e]); }
            float ss = 0.f;
#pragma unroll
            for (int e = 0; e < 8; ++e) { y[e] *= gb[e]; ss += y[e] * y[e]; }
            const float rstd = 1.f / sqrtf(wave_sum(ss) * (1.f / 512.f) + EPS);
            const float* g = F.in[I_NCONV] + c0;
            v4u o; o.x = pk2(y[0] * rstd * g[0], y[1] * rstd * g[1]); o.y = pk2(y[2] * rstd * g[2], y[3] * rstd * g[3]); o.z = pk2(y[4] * rstd * g[4], y[5] * rstd * g[5]); o.w = pk2(y[6] * rstd * g[6], y[7] * rstd * g[7]);
            *(GAS v4u*)(F.MIX + (size_t)m * D + 512 + c0) = o;
        }
    }
}

__device__ __forceinline__ int wave_sum_i(int v) {
#pragma unroll
    for (int o = 1; o < 64; o <<= 1) v += __shfl_xor(v, o);
    return v;
}
__device__ __forceinline__ int rel_bucket(int d) {
    if (d < 16) return d;
    return 16 + (d >= 19) + (d >= 21) + (d >= 24) + (d >= 27) + (d >= 31) + (d >= 35) + (d >= 40) + (d >= 46) + (d >= 52) + (d >= 59) + (d >= 67) + (d >= 77) + (d >= 87) + (d >= 99) + (d >= 113);
}
__device__ __forceinline__ void naive_attn_query(Frame& F, int m, LAS float* L) {
    const int lane = F.lane, b = m >> 11, t = m & (SEQ - 1);
    LAS float* qi_s = L;
    LAS float* qa_s = L + 512;
    LAS int* sel_s = (LAS int*)(L + 1536);
    LAS unsigned* sc_s = (LAS unsigned*)(L + 1792);
    LAS float* p_s = L + 1792;
    const bf16* prow = F.PROJ + (size_t)m * NPROJ;
    const bf16* pb = F.PROJ + (size_t)(b * SEQ) * NPROJ;
    float f8[8];
    ld8bf(prow + PQI + 8 * lane, f8);
#pragma unroll
    for (int e = 0; e < 8; ++e) qi_s[8 * lane + e] = f8[e];
    float wv[8]; ld8bf(prow + PWI, wv);
#pragma unroll
    for (int h = 0; h < 8; ++h) wv[h] *= IDX_SCALE;
    LDS_WAIT();
    for (int s = lane; s <= t; s += 64) {
        const bf16* kr = pb + (size_t)s * NPROJ + PKI; float dot[8];
#pragma unroll
        for (int h = 0; h < 8; ++h) dot[h] = 0.f;
#pragma unroll 1
        for (int ch = 0; ch < 8; ++ch) { float k[8]; ld8bf(kr + 8 * ch, k);
#pragma unroll
            for (int h = 0; h < 8; ++h)
#pragma unroll
                for (int e = 0; e < 8; ++e) dot[h] += qi_s[h * 64 + ch * 8 + e] * k[e]; }
        float score = 0.f;
#pragma unroll
        for (int h = 0; h < 8; ++h) score += wv[h] * fmaxf(dot[h], 0.f);
        unsigned u = __float_as_uint(score); u = (u & 0x80000000u) ? ~u : (u | 0x80000000u);
        sc_s[s] = u;
    }
    LDS_WAIT();
    int nsel;
    if (t < TOPK) { nsel = t + 1; for (int i = lane; i < nsel; i += 64) sel_s[i] = i; }
    else {
        unsigned T = 0u;
        for (int bit = 31; bit >= 0; --bit) { const unsigned cand = T | (1u << bit); int cnt = 0;
            for (int s = lane; s <= t; s += 64) cnt += (sc_s[s] >= cand) ? 1 : 0;
            cnt = wave_sum_i(cnt); if (cnt >= TOPK) T = cand; }
        int cgt = 0; for (int s = lane; s <= t; s += 64) cgt += (sc_s[s] > T) ? 1 : 0;
        cgt = wave_sum_i(cgt);
        const int need = TOPK - cgt; int base = 0, taken = 0; const unsigned long long lt = (1ull << lane) - 1ull;
        for (int s0 = 0; s0 <= t; s0 += 64) { const int s = s0 + lane; const bool valid = s <= t; const unsigned key = valid ? sc_s[s] : 0u;
            const bool gt = valid && key > T, eq = valid && key == T;
            const unsigned long long eqm = __ballot(eq); const int eqrank = taken + __popcll(eqm & lt);
            const bool selb = gt || (eq && eqrank < need);
            const unsigned long long sm = __ballot(selb); const int pos = base + __popcll(sm & lt);
            if (selb) sel_s[pos] = s;
            base += __popcll(sm); taken += __popcll(eqm); }
        nsel = TOPK;
    }
    ld8bf(prow + PQ + 8 * lane, f8);
#pragma unroll
    for (int e = 0; e < 8; ++e) qi_s[8 * lane + e] = f8[e];
    LDS_WAIT();
    for (int i = 0; i < 16; ++i) { const int o = lane + 64 * i, h = o >> 7, c = o & 127; const GAS f32x4* w = (const GAS f32x4*)(F.in[I_WUK] + ((size_t)c * 8 + h) * 64); float a = 0.f;
#pragma unroll
        for (int d4 = 0; d4 < 16; ++d4) { const f32x4 wv4 = w[d4]; a += qi_s[h * 64 + 4 * d4] * wv4.x + qi_s[h * 64 + 4 * d4 + 1] * wv4.y + qi_s[h * 64 + 4 * d4 + 2] * wv4.z + qi_s[h * 64 + 4 * d4 + 3] * wv4.w; }
        qa_s[o] = a * 0.125f; }
    LDS_WAIT();
    for (int i = 0; i < 4; ++i) { const int kidx = lane + 64 * i; float lg[8];
        if (kidx < nsel) { const int s = sel_s[kidx]; const bf16* kr = F.KV + (size_t)(b * SEQ + s) * CL;
#pragma unroll
            for (int h = 0; h < 8; ++h) lg[h] = 0.f;
#pragma unroll 1
            for (int ch = 0; ch < 16; ++ch) { float k[8]; ld8bf(kr + 8 * ch, k);
#pragma unroll
                for (int h = 0; h < 8; ++h)
#pragma unroll
                    for (int e = 0; e < 8; ++e) lg[h] += qa_s[h * 128 + ch * 8 + e] * k[e]; }
            const float* rb = F.in[I_RELB] + rel_bucket(t - s) * 8;
#pragma unroll
            for (int h = 0; h < 8; ++h) lg[h] += rb[h];
        } else {
#pragma unroll
            for (int h = 0; h < 8; ++h) lg[h] = -INFINITY; }
#pragma unroll
        for (int h = 0; h < 8; ++h) p_s[h * 256 + kidx] = lg[h]; }
    LDS_WAIT();
    for (int h = 0; h < 8; ++h) { float v[4], mx = -INFINITY;
#pragma unroll
        for (int i = 0; i < 4; ++i) { v[i] = p_s[h * 256 + lane + 64 * i]; mx = fmaxf(mx, v[i]); }
        mx = wave_max(mx); float sm = 0.f;
#pragma unroll
        for (int i = 0; i < 4; ++i) { v[i] = __expf(v[i] - mx); sm += v[i]; }
        sm = wave_sum(sm); const float inv = 1.f / sm;
#pragma unroll
        for (int i = 0; i < 4; ++i) p_s[h * 256 + lane + 64 * i] = v[i] * inv; }
    LDS_WAIT();
    float cx[8][2];
#pragma unroll
    for (int h = 0; h < 8; ++h) { cx[h][0] = 0.f; cx[h][1] = 0.f; }
    for (int k = 0; k < nsel; ++k) { const int s = sel_s[k]; const unsigned w = *(const GAS unsigned*)(F.KV + (size_t)(b * SEQ + s) * CL + 2 * lane); const float k0 = bflo(w), k1 = bfhi(w);
#pragma unroll
        for (int h = 0; h < 8; ++h) { const float p = p_s[h * 256 + k]; cx[h][0] += p * k0; cx[h][1] += p * k1; } }
#pragma unroll
    for (int h = 0; h < 8; ++h) { qa_s[h * 128 + 2 * lane] = cx[h][0]; qa_s[h * 128 + 2 * lane + 1] = cx[h][1]; }
    LDS_WAIT();
    float o8[8]; float ss = 0.f;
#pragma unroll
    for (int h = 0; h < 8; ++h) { float a = 0.f; const float* w = F.in[I_WUV] + h * 64 + lane;
        for (int c = 0; c < 128; ++c) a += qa_s[h * 128 + c] * w[(size_t)c * 512];
        o8[h] = a; ss += a * a; }
    const float rstd = 1.f / sqrtf(wave_sum(ss) * (1.f / 512.f) + EPS);
#pragma unroll
    for (int h = 0; h < 8; ++h) F.MIX[(size_t)m * D + h * 64 + lane] = (bf16)f2bf(o8[h] * rstd * F.in[I_NATT][h * 64 + lane]);
    LDS_WAIT();
}
__device__ __forceinline__ void naive_attn_phase(Frame& F) {
    LAS float* L = (LAS float*)(F.lds + RING_OFF + F.wave * 16384);
    const int gw = F.vcu * NWAVES + F.wave, NGW = F.G * NWAVES;
    for (int idx = gw; idx < M; idx += NGW) { const int b = idx >> 11, tt = idx & (SEQ - 1), t = (b & 1) ? (SEQ - 1 - tt) : tt; naive_attn_query(F, b * SEQ + t, L); }
}

struct Args { const float* in[20]; float* out; unsigned char* ws; int ph_lo, ph_hi, li, pad; };
__global__ void __launch_bounds__(NWAVES * 64, 2) mk_fwd(Args args) {
    extern __shared__ __attribute__((aligned(16))) unsigned char lds[];
    Frame F;
    F.lds = (LAS unsigned char*)lds;
    F.MISC = (volatile LAS unsigned*)(F.lds + MISC_OFF);
    F.tid = threadIdx.x; F.lane = F.tid & 63; F.wave = __builtin_amdgcn_readfirstlane(F.tid >> 6);
    F.G = gridDim.x; { const int bx = blockIdx.x; F.vcu = (F.G % 8 == 0) ? (bx % 8) * (F.G / 8) + bx / 8 : bx; }
    unsigned char* ws = args.ws;
    F.ctl = (gu32*)(ws + WS_CTL);
#pragma unroll
    for (int i = 0; i < 20; ++i) F.in[i] = args.in[i];
    F.out = args.out;
    F.Wgu1 = (bf16*)(ws + WS_WGU1); F.Wd1 = (bf16*)(ws + WS_WD1); F.Win = (bf16*)(ws + WS_WIN); F.Wout = (bf16*)(ws + WS_WOUT); F.Wgu2 = (bf16*)(ws + WS_WGU2); F.Wd2 = (bf16*)(ws + WS_WD2);
    F.Wuk = (bf16*)(ws + WS_WUK); F.WuvT = (bf16*)(ws + WS_WUV);
    F.XN = (bf16*)(ws + WS_XN); F.MIX = (bf16*)(ws + WS_MIX); F.KV = (bf16*)(ws + WS_KV); F.ACT = (bf16*)(ws + WS_ACT); F.PROJ = (bf16*)(ws + WS_ACT); F.MASK = (unsigned*)(ws + WS_MASK);
    for (int u = F.tid; u < (LDS_BYTES - LDSCTL_OFF) / 4; u += NWAVES * 64) ((LAS unsigned*)(F.lds + LDSCTL_OFF))[u] = 0u;
    __syncthreads();
    XcdBarrier bar; bar.bar = (unsigned*)(F.ctl + CW_BAR); bar.x = 0; bar.st = nullptr;
    if (N_LAUNCHES != PER_PHASE) bar = xcd_barrier_post((unsigned*)(F.ctl + CW_BAR), F.MISC + 8);

    const int lo = args.ph_lo, hi = args.ph_hi;
#ifndef PH_MASK
#define PH_MASK 0xFFF
#endif
#define IN(k) (((PH_MASK >> (k)) & 1) && lo <= (k) && (k) < hi)
#define SEAM(k) do { if (IN(k) && IN((k) + 1)) xcd_barrier(bar); } while (0)

    if (IN(0)) { p0_prologue(F); SEAM(0); }
    if (IN(1)) { pg8::Gemm g{F.XN, F.Wgu1, M, FF2, D}; pg8::StaticOrder S; S.init(M, FF2, F.G, (int)blockIdx.x);
        pg8::EpiSwiglu E{F.ACT, FF};
        pg8::gemm_phase<pg8::EpiSwiglu, pg8::StaticOrder, PG8_ALIGN, PG8_SP2>(F.lds + RING_OFF, g, S, E); SEAM(1); }
    if (IN(2)) { pg8::Gemm g{F.ACT, F.Wd1, M, D, FF}; pg8::StaticOrder S; S.init(M, D, F.G, (int)blockIdx.x);
        pg8::EpiRes E{F.in[I_X], F.out, D, 0.5f};
        pg8::gemm_phase<pg8::EpiRes, pg8::StaticOrder, PG8_ALIGN, PG8_SP2>(F.lds + RING_OFF, g, S, E); SEAM(2); }
    if (IN(3)) { norm_phase(F, F.out, F.in[I_NMIX]); SEAM(3); }
    if (IN(4)) { pg8::Gemm g{F.XN, F.Win, M, NPROJ, D}; pg8::StaticOrder S; S.init(M, NPROJ, F.G, (int)blockIdx.x);
        pg8::EpiBf16<0> E{F.PROJ, NPROJ, nullptr, 0, 0, 1.f};
        pg8::gemm_phase<pg8::EpiBf16<0>, pg8::StaticOrder, PG8_ALIGN, PG8_SP2>(F.lds + RING_OFF, g, S, E); SEAM(4); }
    if (IN(5)) { prep_phase(F); SEAM(5); }
    if (IN(6)) { naive_attn_phase(F); SEAM(6); }
    if (IN(7)) { pg8::Gemm g{F.MIX, F.Wout, M, D, D}; pg8::StaticOrder S; S.init(M, D, F.G, (int)blockIdx.x);
        pg8::EpiRes E{F.out, F.out, D, 1.0f};
        pg8::gemm_phase<pg8::EpiRes, pg8::StaticOrder, PG8_ALIGN, PG8_SP2>(F.lds + RING_OFF, g, S, E); SEAM(7); }
    if (IN(8)) { norm_phase(F, F.out, F.in[I_N2]); SEAM(8); }
    if (IN(9)) { pg8::Gemm g{F.XN, F.Wgu2, M, FF2, D}; pg8::StaticOrder S; S.init(M, FF2, F.G, (int)blockIdx.x);
        pg8::EpiSwiglu E{F.ACT, FF};
        pg8::gemm_phase<pg8::EpiSwiglu, pg8::StaticOrder, PG8_ALIGN, PG8_SP2>(F.lds + RING_OFF, g, S, E); SEAM(9); }
    if (IN(10)) { pg8::Gemm g{F.ACT, F.Wd2, M, D, FF}; pg8::StaticOrder S; S.init(M, D, F.G, (int)blockIdx.x);
        pg8::EpiRes E{F.out, F.out, D, 0.5f};
        pg8::gemm_phase<pg8::EpiRes, pg8::StaticOrder, PG8_ALIGN, PG8_SP2>(F.lds + RING_OFF, g, S, E); SEAM(10); }
    if (IN(11)) { const bool poison = __hip_atomic_load((gu32*)(F.ctl + CW_BAR + XB_TMO), RLX_AGENT) != 0u;
        const int gw = F.vcu * NWAVES + F.wave, NGW = F.G * NWAVES;
        for (int m = gw; m < M; m += NGW) rms_row_to_f32(F.lane, F.out + (size_t)m * D, F.in[I_NF], F.out + (size_t)m * D, poison); }
#undef IN
#undef SEAM
}

extern "C" void kernel_launch(void* const* d_in, const int* in_sizes, int n_in, void* d_out, int out_size, void* d_ws, size_t ws_size, hipStream_t stream) {
    static int grid = 0;
    if (grid == 0) {
        if (n_in != 20 || in_sizes[0] != M * D || out_size != M * D || ws_size < WS_END) { fprintf(stderr, "kernel_launch: shape mismatch (n_in %d, in0 %d, out %d, ws %zu); nothing launched\n", n_in, n_in > 0 ? in_sizes[0] : -1, out_size, ws_size); grid = -1; return; }
        int dev = 0, cus = 0, per_cu = 0;
        if (hipGetDevice(&dev) != hipSuccess || hipDeviceGetAttribute(&cus, hipDeviceAttributeMultiprocessorCount, dev) != hipSuccess) { fprintf(stderr, "kernel_launch: hipGetDevice / hipDeviceGetAttribute failed\n"); grid = -1; return; }
        if (hipFuncSetAttribute((const void*)mk_fwd, hipFuncAttributeMaxDynamicSharedMemorySize, LDS_BYTES) != hipSuccess) { fprintf(stderr, "kernel_launch: hipFuncSetAttribute failed\n"); grid = -1; return; }
        if (hipOccupancyMaxActiveBlocksPerMultiprocessor(&per_cu, (const void*)mk_fwd, NWAVES * 64, LDS_BYTES) != hipSuccess || per_cu < 1)
            fprintf(stderr, "kernel_launch: note: occupancy query reports %d workgroups per CU\n", per_cu);
        (void)hipGetLastError();
        grid = cus;
    }
    if (grid < 0) return;
    if (hipMemsetAsync((char*)d_ws + WS_CTL, 0, CTL_ZERO_BYTES, stream) != hipSuccess) { fprintf(stderr, "kernel_launch: hipMemsetAsync failed\n"); return; }
    Args a{};
    for (int i = 0; i < 20; ++i) a.in[i] = (const float*)d_in[i];
    a.out = (float*)d_out; a.ws = (unsigned char*)d_ws;
    for (int li = 0; li < N_LAUNCHES; ++li) {
        a.ph_lo = (N_LAUNCHES == PER_PHASE) ? li : 0; a.ph_hi = (N_LAUNCHES == PER_PHASE) ? li + 1 : PER_PHASE; a.li = li;
        hipLaunchKernelGGL(mk_fwd, dim3(grid), dim3(NWAVES * 64), LDS_BYTES, stream, a);
        const hipError_t le = hipPeekAtLastError();
        if (le != hipSuccess) { fprintf(stderr, "kernel_launch: launch %d failed: %s\n", li, hipGetErrorName(le)); break; }
    }
}
```

```cpp
#include <hip/hip_runtime.h>
#include <cstdio>
#include <cstdint>
namespace pg8 {
#define PG8_LAS __attribute__((address_space(3)))
typedef unsigned short bf16_t;
typedef short bf16x8 __attribute__((ext_vector_type(8)));
typedef float f32x4 __attribute__((ext_vector_type(4)));
typedef unsigned u32x4 __attribute__((ext_vector_type(4)));
constexpr int BM = 256, BK = 64, HALF = 128, HTB = HALF * BK * 2  , STAGE_BYTES = 8 * HTB, NXCD = 8, WGM = 8;

__host__ __device__ __forceinline__ int lds_byte(int r, int c) { const int st = (r >> 4) * 2 + (c >> 5), rr = r & 15, cc = c & 31, ob = rr * 64 + cc * 2; return st * 1024 + (ob ^ (((ob >> 9) & 1) << 5)); }
__host__ __device__ __forceinline__ void stage_rc(int b, int& R, int& C) { const int st = b / 1024, sb = b % 1024, swz = sb ^ (((sb >> 9) & 1) << 5); R = (st >> 1) * 16 + swz / 64; C = (st & 1) * 32 + (swz % 64) / 2; }
__host__ __device__ __forceinline__ int perm32(int rho) { const int n = rho >> 4, i = rho & 15; return 8 * (i >> 2) + 4 * n + (i & 3); }

struct Unit { int pm, pn; };
struct Gemm { const bf16_t* A; const bf16_t* Bt; int M, N, K; };

struct StaticOrder {
    int nM, nN, nwg, G, c;
    __host__ __device__ void init(int M, int N, int G_, int c_) { nM = M / BM; nN = N / BM; nwg = nM * nN; G = G_; c = c_; }
    __host__ __device__ bool next(int i, Unit& u) const {
        const long L = (long)i * G + c; if (L >= nwg) return false;
        int wgid = (int)L; { const int q = nwg / NXCD, r = nwg % NXCD, xcd = wgid % NXCD, off = wgid / NXCD; wgid = (xcd < r ? xcd * (q + 1) : r * (q + 1) + (xcd - r) * q) + off; }
        const int nig = WGM * nN, gid = wgid / nig, fm = gid * WGM, gsz = (nM - fm) < WGM ? (nM - fm) : WGM;
        u.pm = fm + ((wgid % nig) % gsz); u.pn = (wgid % nig) / gsz; return true;
    }
    __device__ __forceinline__ void a_ready(const Unit&) const {}
    __device__ __forceinline__ void done(const Unit&) const {}
};

__device__ __forceinline__ unsigned cvt_pk_bf16(float lo, float hi) { unsigned r; asm volatile("v_cvt_pk_bf16_f32 %0, %1, %2" : "=v"(r) : "v"(lo), "v"(hi)); return r; }
typedef float f32x2 __attribute__((ext_vector_type(2)));
__device__ __forceinline__ f32x2 gelu_pk(f32x2 v) {
    const f32x2 av = __builtin_elementwise_abs(v), d = av * 0.2316418882f + 1.0f;
    f32x2 t; t.x = __builtin_amdgcn_rcpf(d.x); t.y = __builtin_amdgcn_rcpf(d.y);
    f32x2 q = t * 0.5307027145f + (-0.7265760135f); q = q * t + 0.7107068705f; q = q * t + (-0.142248368f); q = q * t + 0.127414796f; q = q * t;
    const f32x2 s = (v * v) * (-0.72134752044f);
    f32x2 e; e.x = __builtin_amdgcn_exp2f(s.x); e.y = __builtin_amdgcn_exp2f(s.y);
    const f32x2 m = v * (q * e), r = v - m;
    f32x2 o; o.x = v.x < 0.f ? m.x : r.x; o.y = v.y < 0.f ? m.y : r.y; return o;
}

template <int ACT  > struct EpiBf16 {
    static constexpr bool PERM = true, AFTER_DRAIN = false; static_assert(ACT == 0 || ACT == 1, "EpiBf16: ACT is 0 (none) or 1 (gelu_pk)");
    bf16_t* O; int ldc; const float* bias; int split_cols; size_t split_stride; float scale0;
    __device__ __forceinline__ void operator()(const f32x4 (&acc)[2][2][4][2], const Unit& u, int wr, int wc, int fr, int fq) const {
        const int row0 = u.pm * BM + wr * 64 + fr; int colt = u.pn * BM; bf16_t* base = O;
        float sc = 1.f; if (split_cols) { const int t = colt / split_cols; base += (size_t)t * split_stride; colt -= t * split_cols; if (t == 0) sc = scale0; }
        const int col0 = colt + wc * 32 + 8 * fq, bcol0 = u.pn * BM + wc * 32 + 8 * fq;
        f32x4 bv[2][2];
#pragma unroll
        for (int bj = 0; bj < 2; ++bj)
#pragma unroll
            for (int n = 0; n < 2; ++n) bv[bj][n] = bias ? *(const f32x4*)(bias + bcol0 + bj * HALF + 4 * n) : (f32x4){0.f, 0.f, 0.f, 0.f};
#pragma unroll
        for (int ai = 0; ai < 2; ++ai)
#pragma unroll
            for (int m = 0; m < 4; ++m) { bf16_t* rowp = base + (size_t)(row0 + ai * HALF + m * 16) * ldc + col0;
#pragma unroll
                for (int bj = 0; bj < 2; ++bj) { f32x4 v0 = acc[ai][bj][m][0] + bv[bj][0], v1 = acc[ai][bj][m][1] + bv[bj][1];
                    if (ACT == 1) { f32x2 a = gelu_pk((f32x2){v0[0], v0[1]}), b = gelu_pk((f32x2){v0[2], v0[3]}), c = gelu_pk((f32x2){v1[0], v1[1]}), d = gelu_pk((f32x2){v1[2], v1[3]});
                        v0 = (f32x4){a.x, a.y, b.x, b.y}; v1 = (f32x4){c.x, c.y, d.x, d.y}; }
                    v0 = v0 * sc; v1 = v1 * sc; u32x4 w; w.x = cvt_pk_bf16(v0[0], v0[1]); w.y = cvt_pk_bf16(v0[2], v0[3]); w.z = cvt_pk_bf16(v1[0], v1[1]); w.w = cvt_pk_bf16(v1[2], v1[3]);
                    *(u32x4*)(rowp + bj * HALF) = w; } }
    }
};


__device__ __forceinline__ float silu_mul(float g, float u) { const float e = __builtin_amdgcn_exp2f(g * -1.4426950408889634f); return g * __builtin_amdgcn_rcpf(1.0f + e) * u; }
struct EpiSwiglu {
    static constexpr bool PERM = true, AFTER_DRAIN = false;
    bf16_t* O; int ldc;
    __device__ __forceinline__ void operator()(const f32x4 (&acc)[2][2][4][2], const Unit& u, int wr, int wc, int fr, int fq) const {
        const int row0 = u.pm * BM + wr * 64 + fr, col0 = u.pn * HALF + wc * 32 + 8 * fq;
#pragma unroll
        for (int ai = 0; ai < 2; ++ai)
#pragma unroll
            for (int m = 0; m < 4; ++m) { bf16_t* rowp = O + (size_t)(row0 + ai * HALF + m * 16) * ldc + col0;
                const f32x4 g0 = acc[ai][0][m][0], g1 = acc[ai][0][m][1], u0 = acc[ai][1][m][0], u1 = acc[ai][1][m][1];
                u32x4 w; w.x = cvt_pk_bf16(silu_mul(g0[0], u0[0]), silu_mul(g0[1], u0[1])); w.y = cvt_pk_bf16(silu_mul(g0[2], u0[2]), silu_mul(g0[3], u0[3]));
                w.z = cvt_pk_bf16(silu_mul(g1[0], u1[0]), silu_mul(g1[1], u1[1])); w.w = cvt_pk_bf16(silu_mul(g1[2], u1[2]), silu_mul(g1[3], u1[3]));
                *(u32x4*)rowp = w; }
    }
};
struct EpiRes {
    static constexpr bool PERM = false, AFTER_DRAIN = false;
    const float* base; float* out; int ldc; float scale;
    __device__ __forceinline__ void operator()(const f32x4 (&acc)[2][2][4][2], const Unit& u, int wr, int wc, int fr, int fq) const {
        const int row0 = u.pm * BM + wr * 64 + fr, col0 = u.pn * BM + wc * 32 + 4 * fq;
#pragma unroll
        for (int ai = 0; ai < 2; ++ai) {
            f32x4 pre[4][2][2];
#pragma unroll
            for (int m = 0; m < 4; ++m) { const size_t off = (size_t)(row0 + ai * HALF + m * 16) * ldc + col0;
#pragma unroll
                for (int bj = 0; bj < 2; ++bj)
#pragma unroll
                    for (int n = 0; n < 2; ++n) pre[m][bj][n] = *(const f32x4*)(base + off + bj * HALF + n * 16); }
#pragma unroll
            for (int m = 0; m < 4; ++m) { const size_t off = (size_t)(row0 + ai * HALF + m * 16) * ldc + col0;
#pragma unroll
                for (int bj = 0; bj < 2; ++bj)
#pragma unroll
                    for (int n = 0; n < 2; ++n) *(f32x4*)(out + off + bj * HALF + n * 16) = pre[m][bj][n] + acc[ai][bj][m][n] * scale; }
        }
    }
};

template <class Epi, class Sched, bool ALIGN_EPI = false, bool SP2 = false>
__device__ __forceinline__ void gemm_phase(PG8_LAS unsigned char* lds, const Gemm g, const Sched& S, const Epi& E) {
    const int tid = threadIdx.x, wid = __builtin_amdgcn_readfirstlane(tid >> 6), lane = tid & 63, wr = wid >> 2, wc = wid & 3, fr = lane & 15, fq = lane >> 4;
    const int K = g.K, nt = K / BK;
    unsigned voffA[2], voffB[2];
#pragma unroll
    for (int i = 0; i < 2; ++i) { int R, C; stage_rc(tid * 16 + i * 8192, R, C); const int Rb = Epi::PERM ? ((R & ~31) + perm32(R & 31)) : R;
        voffA[i] = (unsigned)(R * K + C) * 2u; voffB[i] = (unsigned)(Rb * K + C) * 2u; }
    const size_t kstep = (size_t)(BK * 2);
    const size_t hstep = (size_t)HALF * K * 2;
    const size_t tstep = 2 * hstep;
    const unsigned ldsw = (unsigned)wid * 1024u;
    const int aoff = lds_byte(wr * 64 + fr, fq * 8), boff = lds_byte(wc * 32 + fr, fq * 8);
#define PG8_SA(b, h) (((b) * 2 + (h)) * HTB)
#define PG8_SB(b, h) ((4 + (b) * 2 + (h)) * HTB)
#define PG8_STAGE(bufoff, gbase, voff) do { _Pragma("unroll") for (int _i = 0; _i < 2; ++_i) \
        __builtin_amdgcn_global_load_lds((const unsigned*)((const char*)(gbase) + (voff)[_i]), (PG8_LAS unsigned*)(lds + (bufoff) + ldsw + _i * 8192), 16, 0, 0); } while (0)
#define PG8_LDA(dst, b, h) do { _Pragma("unroll") for (int m = 0; m < 4; ++m) _Pragma("unroll") for (int k = 0; k < 2; ++k) dst[m][k] = *(const PG8_LAS bf16x8*)(lds + PG8_SA(b, h) + aoff + m * 2048 + k * 1024); } while (0)
#define PG8_LDB(dst, b, h) do { _Pragma("unroll") for (int n = 0; n < 2; ++n) _Pragma("unroll") for (int k = 0; k < 2; ++k) dst[n][k] = *(const PG8_LAS bf16x8*)(lds + PG8_SB(b, h) + boff + n * 2048 + k * 1024); } while (0)
#define PG8_MMA(ai, bj, At, Bt) do { __builtin_amdgcn_s_setprio(1); _Pragma("unroll") for (int m = 0; m < 4; ++m) _Pragma("unroll") for (int n = 0; n < 2; ++n) _Pragma("unroll") for (int k = 0; k < 2; ++k) \
        acc[ai][bj][m][n] = __builtin_amdgcn_mfma_f32_16x16x32_bf16(Bt[n][k], At[m][k], acc[ai][bj][m][n], 0, 0, 0); __builtin_amdgcn_s_setprio(0); } while (0)
#define PG8_WAIT_V(n) asm volatile("s_waitcnt vmcnt(" #n ")" ::: "memory")
#define PG8_WAIT_L(n) asm volatile("s_waitcnt lgkmcnt(" #n ")" ::: "memory")
#define PG8_BAR __builtin_amdgcn_s_barrier()
#define PG8_SCHED __builtin_amdgcn_sched_barrier(0)
    Unit cur, nxt; int ui = 0;
    if (!S.next(0, cur)) return;
    f32x4 acc[2][2][4][2];
#pragma unroll
    for (int a = 0; a < 2; ++a)
#pragma unroll
        for (int b = 0; b < 2; ++b)
#pragma unroll
            for (int m = 0; m < 4; ++m)
#pragma unroll
                for (int n = 0; n < 2; ++n) acc[a][b][m][n] = (f32x4){0.f, 0.f, 0.f, 0.f};
    bf16x8 At[4][2], B0[2][2], B1[2][2];
    const char* cA = (const char*)g.A + (size_t)cur.pm * tstep; const char* cB = (const char*)g.Bt + (size_t)cur.pn * tstep;
    S.a_ready(cur);
    if constexpr (SP2) {
        PG8_STAGE(PG8_SB(0, 0), cB, voffB); PG8_STAGE(PG8_SB(0, 1), cB + hstep, voffB); PG8_STAGE(PG8_SA(0, 0), cA, voffA); PG8_STAGE(PG8_SA(0, 1), cA + hstep, voffA);
        if (wr == 1) PG8_BAR;
        PG8_WAIT_V(2); PG8_BAR;
        PG8_STAGE(PG8_SB(1, 0), cB + kstep, voffB); PG8_STAGE(PG8_SA(1, 0), cA + kstep, voffA); PG8_STAGE(PG8_SB(1, 1), cB + hstep + kstep, voffB);
        PG8_WAIT_V(6); PG8_BAR;
    } else {
        PG8_STAGE(PG8_SB(0, 0), cB, voffB); PG8_STAGE(PG8_SA(0, 0), cA, voffA); PG8_STAGE(PG8_SB(0, 1), cB + hstep, voffB); PG8_STAGE(PG8_SA(0, 1), cA + hstep, voffA);
        if (wr == 1) PG8_BAR;
        PG8_WAIT_V(4); PG8_BAR;
        PG8_STAGE(PG8_SB(1, 0), cB + kstep, voffB); PG8_STAGE(PG8_SA(1, 0), cA + kstep, voffA); PG8_STAGE(PG8_SB(1, 1), cB + hstep + kstep, voffB);
        PG8_WAIT_V(6); PG8_BAR;
    }
    for (;;) {
        const bool has_next = S.next(ui + 1, nxt);
        const char* nA = has_next ? (const char*)g.A + (size_t)nxt.pm * tstep : cA; const char* nB = has_next ? (const char*)g.Bt + (size_t)nxt.pn * tstep : cB;
        for (int t = 0; t < nt; t += 2) {
            const bool last = (t == nt - 2);
            const char* a1 = cA + (size_t)(t + 1) * kstep;
            const char* a2 = last ? nA : cA + (size_t)(t + 2) * kstep; const char* b2 = last ? nB : cB + (size_t)(t + 2) * kstep;
            const char* a3 = a2 + kstep; const char* b3 = b2 + kstep;
            if (last && has_next) S.a_ready(nxt);
            if constexpr (SP2) {
            PG8_LDB(B0, 0, 0); PG8_LDB(B1, 0, 1); PG8_SCHED; PG8_LDA(At, 0, 0); PG8_STAGE(PG8_SA(1, 1), a1 + hstep, voffA);
            PG8_WAIT_V(8); PG8_WAIT_L(0); PG8_BAR; PG8_MMA(0, 0, At, B0); PG8_MMA(0, 1, At, B1); PG8_BAR; PG8_SCHED;
            PG8_LDA(At, 0, 1); PG8_STAGE(PG8_SB(0, 0), b2, voffB); PG8_STAGE(PG8_SB(0, 1), b2 + hstep, voffB); PG8_STAGE(PG8_SA(0, 0), a2, voffA);
            PG8_WAIT_V(8); PG8_WAIT_L(0); PG8_BAR; PG8_MMA(1, 0, At, B0); PG8_MMA(1, 1, At, B1); PG8_BAR; PG8_SCHED;
            PG8_LDB(B0, 1, 0); PG8_LDB(B1, 1, 1); PG8_SCHED; PG8_LDA(At, 1, 0); PG8_STAGE(PG8_SA(0, 1), a2 + hstep, voffA);
            PG8_WAIT_V(8); PG8_WAIT_L(0); PG8_BAR; PG8_MMA(0, 0, At, B0); PG8_MMA(0, 1, At, B1); PG8_BAR; PG8_SCHED;
            PG8_LDA(At, 1, 1); PG8_STAGE(PG8_SB(1, 0), b3, voffB); PG8_STAGE(PG8_SB(1, 1), b3 + hstep, voffB); PG8_STAGE(PG8_SA(1, 0), a3, voffA);
            PG8_WAIT_V(8); PG8_WAIT_L(0); PG8_BAR; PG8_MMA(1, 0, At, B0); PG8_MMA(1, 1, At, B1); PG8_BAR; PG8_SCHED;
            } else {
            PG8_LDB(B0, 0, 0); PG8_SCHED; PG8_LDA(At, 0, 0); PG8_STAGE(PG8_SA(1, 1), a1 + hstep, voffA);
            PG8_WAIT_L(8); PG8_BAR; PG8_WAIT_L(0); PG8_MMA(0, 0, At, B0); PG8_BAR; PG8_SCHED;
            PG8_LDB(B1, 0, 1); PG8_STAGE(PG8_SB(0, 0), b2, voffB);
            PG8_BAR; PG8_WAIT_L(0); PG8_MMA(0, 1, At, B1); PG8_BAR;
            PG8_LDA(At, 0, 1); PG8_STAGE(PG8_SA(0, 0), a2, voffA);
            PG8_BAR; PG8_WAIT_L(0); PG8_MMA(1, 0, At, B0); PG8_BAR; PG8_SCHED;
            PG8_STAGE(PG8_SB(0, 1), b2 + hstep, voffB);
            PG8_WAIT_V(6); PG8_BAR; PG8_MMA(1, 1, At, B1); PG8_BAR;
            PG8_LDB(B0, 1, 0); PG8_SCHED; PG8_LDA(At, 1, 0); PG8_STAGE(PG8_SA(0, 1), a2 + hstep, voffA);
            PG8_WAIT_L(8); PG8_BAR; PG8_WAIT_L(0); PG8_MMA(0, 0, At, B0); PG8_BAR; PG8_SCHED;
            PG8_LDB(B1, 1, 1); PG8_STAGE(PG8_SB(1, 0), b3, voffB);
            PG8_BAR; PG8_WAIT_L(0); PG8_MMA(0, 1, At, B1); PG8_BAR;
            PG8_LDA(At, 1, 1); PG8_STAGE(PG8_SA(1, 0), a3, voffA);
            PG8_BAR; PG8_WAIT_L(0); PG8_MMA(1, 0, At, B0); PG8_BAR; PG8_SCHED;
            PG8_STAGE(PG8_SB(1, 1), b3 + hstep, voffB);
            PG8_WAIT_V(6); PG8_BAR; PG8_MMA(1, 1, At, B1); PG8_BAR;
            }
        }
        if constexpr (ALIGN_EPI) { if (wr == 0) PG8_BAR; }
        if constexpr (!Epi::AFTER_DRAIN) { E(acc, cur, wr, wc, fr, fq); S.done(cur); }
        if (!has_next) break;
#pragma unroll
        for (int a = 0; a < 2; ++a)
#pragma unroll
            for (int b = 0; b < 2; ++b)
#pragma unroll
                for (int m = 0; m < 4; ++m)
#pragma unroll
                    for (int n = 0; n < 2; ++n) acc[a][b][m][n] = (f32x4){0.f, 0.f, 0.f, 0.f};
        cur = nxt; cA = nA; cB = nB; ++ui;
        if constexpr (ALIGN_EPI) { if (wr == 1) PG8_BAR; }
    }
    PG8_WAIT_V(0);
    if constexpr (!ALIGN_EPI) { if (wr == 0) PG8_BAR; }
    PG8_BAR;
    if constexpr (Epi::AFTER_DRAIN) { E.fused(acc, cur, wr, wc, fr, fq, lds, wid, lane); S.done(cur); }
#undef PG8_SA
#undef PG8_SB
#undef PG8_STAGE
#undef PG8_LDA
#undef PG8_LDB
#undef PG8_MMA
#undef PG8_WAIT_V
#undef PG8_WAIT_L
#undef PG8_BAR
#undef PG8_SCHED
}
}

#ifndef PG8_SP2
#define PG8_SP2 true
#endif
#ifndef PG8_ALIGN
#define PG8_ALIGN true
#endif

constexpr int NWAVES = 8;
#ifndef MK_N_LAUNCHES
#define MK_N_LAUNCHES 1
#endif
constexpr int PER_PHASE = 12;
constexpr int N_LAUNCHES = MK_N_LAUNCHES;
static_assert(N_LAUNCHES == 1 || N_LAUNCHES == PER_PHASE, "MK_N_LAUNCHES is 1 or 12");

constexpr int BATCH = 8, SEQ = 2048, D = 1024, M = BATCH * SEQ;
constexpr int FF = 2816, FF2 = 2 * FF;
constexpr int NH = 8, HD = 64, CL = 128, TOPK = 256;
constexpr int NPROJ = 2816;
constexpr int PQ = 0, PQI = 512, PCKV = 1024, PKI = 1152, PWI = 1216, PGB = 1280, PGC = 1792, PXIN = 2304;
constexpr int WIN_N = 2760;
constexpr float EPS = 1e-6f;
constexpr float IDX_SCALE = 0.044194173824159216f;

constexpr size_t MiB = 1u << 20;
constexpr size_t WS_CTL = 0, CTL_ZERO_BYTES = 1 * MiB;
constexpr size_t WS_WUK = 1 * MiB, WS_WUV = 1 * MiB + 256 * 1024;
constexpr size_t WS_WGU1 = 2 * MiB, WS_WD1 = 14 * MiB, WS_WIN = 20 * MiB, WS_WOUT = 26 * MiB, WS_WGU2 = 28 * MiB, WS_WD2 = 40 * MiB;
constexpr size_t WS_XN = 48 * MiB;
constexpr size_t WS_MIX = 80 * MiB;
constexpr size_t WS_KV = 112 * MiB;
constexpr size_t WS_MASK = 116 * MiB;
constexpr size_t WS_ACT = 128 * MiB;
constexpr size_t WS_END = 216 * MiB;
static_assert(WS_WGU1 + (size_t)FF2 * D * 2 <= WS_WD1 && WS_WD1 + (size_t)D * FF * 2 <= WS_WIN && WS_WIN + (size_t)NPROJ * D * 2 <= WS_WOUT && WS_WOUT + (size_t)D * D * 2 <= WS_WGU2 &&
              WS_WGU2 + (size_t)FF2 * D * 2 <= WS_WD2 && WS_WD2 + (size_t)D * FF * 2 <= WS_XN && WS_ACT + (size_t)M * FF * 2 <= WS_END, "d_ws map");
constexpr int CW_BAR = 4096;

constexpr int RING_OFF = 0, RING_BYTES = 131072;
constexpr int LDSCTL_OFF = RING_BYTES, MISC_OFF = LDSCTL_OFF + 320;
constexpr int LDS_BYTES = 147456;
static_assert(MISC_OFF + 128 <= LDS_BYTES, "LDS map");
#define GAS __attribute__((address_space(1)))
#define LAS __attribute__((address_space(3)))
typedef unsigned short bf16;
typedef unsigned v4u __attribute__((ext_vector_type(4)));
typedef float f32x4 __attribute__((ext_vector_type(4)));
typedef short bf16x8 __attribute__((ext_vector_type(8)));
typedef GAS unsigned gu32;
typedef GAS unsigned long long gu64;
#define RLX_AGENT __ATOMIC_RELAXED, __HIP_MEMORY_SCOPE_AGENT
#define LDS_WAIT() asm volatile("s_waitcnt lgkmcnt(0)" ::: "memory")
#define VM_WAIT() asm volatile("s_waitcnt vmcnt(0)" ::: "memory")
__device__ __forceinline__ unsigned long long rt() { return __builtin_amdgcn_s_memrealtime(); }
__device__ __forceinline__ unsigned f2bf(float f) { unsigned u = __builtin_bit_cast(unsigned, f); return (u + 0x7fffu + ((u >> 16) & 1u)) >> 16; }
__device__ __forceinline__ unsigned pk2(float lo, float hi) { return f2bf(lo) | (f2bf(hi) << 16); }

#define XB_TMO      128
#define XB_XCNT(j)  (256  + 64 * (j))
#define XB_XSUB(j)  (1280 + 64 * (j))
#define XB_XGEN(j)  (2304 + 64 * (j))
#define XB_TOP      3328
#define XB_TOPGEN   3392
#define XCD_BAR_WORDS 3456
#define XB_SPIN_CAP (1u << 18)

__device__ __forceinline__ unsigned xb_ld(unsigned* p)              { return __hip_atomic_load(p, __ATOMIC_RELAXED, __HIP_MEMORY_SCOPE_AGENT); }
__device__ __forceinline__ unsigned xb_add(unsigned* p, unsigned v) { return __hip_atomic_fetch_add(p, v, __ATOMIC_RELAXED, __HIP_MEMORY_SCOPE_AGENT); }
__device__ __forceinline__ unsigned xb_xcc_id() { return (unsigned)__builtin_amdgcn_s_getreg((3 << 11) | 20) & 0xFu; }
#define XB_SPIN(cond, bar) do { unsigned _sp = 0; while (cond) { __builtin_amdgcn_s_sleep(1); \
    if ((++_sp & 255u) == 0u) { if (xb_ld(&(bar)[XB_TMO])) break; if (_sp > XB_SPIN_CAP) { atomicAdd(&(bar)[XB_TMO], 1u); break; } } } } while (0)

struct XcdBarrier {
    unsigned* bar; unsigned x;
    volatile LAS unsigned* st;
};

__device__ __forceinline__ XcdBarrier xcd_barrier_post(unsigned* bar, volatile LAS unsigned* st) {
    XcdBarrier b; b.bar = bar; b.x = xb_xcc_id(); b.st = st;
    if (threadIdx.x == 0) (void)xb_add(&bar[XB_XCNT(b.x)], 1u);
    return b;
}
__device__ __forceinline__ void xcd_barrier_complete(unsigned* bar, unsigned x, unsigned& nloc, unsigned& nx) {
    const unsigned G = gridDim.x * gridDim.y * gridDim.z;
    unsigned sum, cnt, mine, sp = 0u;
    for (;;) {
        sum = 0u; cnt = 0u; mine = 0u;
#pragma unroll
        for (unsigned j = 0; j < 16; ++j) { const unsigned c = xb_ld(&bar[XB_XCNT(j)]); sum += c; cnt += (c > 0u) ? 1u : 0u; mine = (j == x) ? c : mine; }
        if (sum == G) break;
        __builtin_amdgcn_s_sleep(1);
        if ((++sp & 255u) == 0u) { if (xb_ld(&bar[XB_TMO])) break; if (sp > XB_SPIN_CAP) { atomicAdd(&bar[XB_TMO], 1u); break; } }
    }
    nloc = mine > 0u ? mine : 1u; nx = cnt > 0u ? cnt : 1u;
}

__device__ __forceinline__ void xcd_barrier(const XcdBarrier& b) {
    asm volatile("s_waitcnt vmcnt(0)" ::: "memory");
    __syncthreads();
    if (threadIdx.x == 0) {
        unsigned* bar = b.bar;
        __builtin_amdgcn_s_waitcnt(0);
        unsigned nloc = b.st[0], nx = b.st[1];
        if (nloc == 0u) { xcd_barrier_complete(bar, b.x, nloc, nx); b.st[0] = nloc; b.st[1] = nx; }
        const unsigned old = xb_add(&bar[XB_XSUB(b.x)], 1u);
        const unsigned gen = old / nloc;
        if (old + 1u == (gen + 1u) * nloc) {
            __builtin_amdgcn_fence(__ATOMIC_RELEASE, "agent");
            asm volatile("s_waitcnt vmcnt(0)" ::: "memory");
            const unsigned og = xb_add(&bar[XB_TOP], 1u);
            const unsigned tg = og / nx;
            if (og + 1u == (tg + 1u) * nx) xb_add(&bar[XB_TOPGEN], 1u);
            else XB_SPIN(xb_ld(&bar[XB_TOPGEN]) == tg, bar);
            __builtin_amdgcn_fence(__ATOMIC_ACQUIRE, "agent");
            xb_add(&bar[XB_XGEN(b.x)], 1u);
            asm volatile("s_waitcnt vmcnt(0)" ::: "memory");
        } else {
            XB_SPIN(xb_ld(&bar[XB_XGEN(b.x)]) == gen, bar);
            __builtin_amdgcn_fence(__ATOMIC_ACQUIRE, "agent");
            asm volatile("s_waitcnt vmcnt(0)" ::: "memory");
        }
    }
    __syncthreads();
}


struct Frame {
    LAS unsigned char* lds;
    volatile LAS unsigned* MISC;
    gu32* ctl;
    int tid, lane, wave;
    int vcu, G;
    const float* in[20]; float* out;
    bf16 *Wgu1, *Wd1, *Win, *Wout, *Wgu2, *Wd2, *Wuk, *WuvT;
    bf16 *XN, *MIX, *KV, *ACT, *PROJ; unsigned* MASK;
};
enum { I_X = 0, I_N1, I_G1, I_U1, I_D1, I_NMIX, I_WIN, I_NKV, I_WUK, I_WUV, I_RELB, I_CONVW, I_NATT, I_NCONV, I_WOUT, I_N2, I_G2, I_U2, I_D2, I_NF };

__device__ __forceinline__ float wave_sum(float v) {
#pragma unroll
    for (int o = 1; o < 64; o <<= 1) v += __shfl_xor(v, o);
    return v;
}
__device__ __forceinline__ float wave_max(float v) {
#pragma unroll
    for (int o = 1; o < 64; o <<= 1) v = fmaxf(v, __shfl_xor(v, o));
    return v;
}
__device__ __forceinline__ float bflo(unsigned w) { return __uint_as_float(w << 16); }
__device__ __forceinline__ float bfhi(unsigned w) { return __uint_as_float(w & 0xffff0000u); }

struct Src { const float* W; int N; int col; };
struct MapPlain { const float* W; int N; __device__ __forceinline__ Src operator()(int d) const { return Src{W, N, d}; } };
struct MapGU { const float* W; __device__ __forceinline__ Src operator()(int d) const { return Src{W, FF, (d >> 8) * 128 + (d & 127)}; } };
struct MapWin { const float* W; __device__ __forceinline__ Src operator()(int d) const { int c;
    if (d < 512) c = d;
    else if (d < 1024) c = 640 + (d - 512);
    else if (d < 1152) c = 512 + (d - 1024);
    else if (d < 1224) c = d;
    else if (d < 1280) c = -1;
    else if (d < 1792) c = 1224 + (d - 1280);
    else if (d < 2304) c = 1736 + (d - 1792);
    else c = 2248 + (d - 2304);
    return Src{W, WIN_N, c}; } };
template <class MAP>
__device__ __forceinline__ void p0_transpose_item(const MAP& map, int K, int ndg, bf16* WT, LAS float* scr, int item, int lane) {
    const int kb = item / ndg, dg = item % ndg, k0 = 64 * kb, d0 = 32 * dg;
    const Src src = map(d0 + (lane & 31)); const int sc = src.col; const float* wp = src.W + (size_t)(k0 + (lane >> 5)) * src.N + (sc >= 0 ? sc : 0);
#pragma unroll 8
    for (int i = 0; i < 32; ++i) { const int kk = 2 * i + (lane >> 5); scr[kk * 33 + (lane & 31)] = sc >= 0 ? wp[(size_t)(2 * i) * src.N] : 0.f; }
    LDS_WAIT(); asm volatile("" ::: "memory");
    const int c = lane & 7;
#pragma unroll
    for (int j = 0; j < 4; ++j) { const int n = (lane >> 3) + 8 * j; const LAS float* s = scr + (8 * c) * 33 + n;
        v4u o; o.x = pk2(s[0 * 33], s[1 * 33]); o.y = pk2(s[2 * 33], s[3 * 33]); o.z = pk2(s[4 * 33], s[5 * 33]); o.w = pk2(s[6 * 33], s[7 * 33]);
        *(GAS v4u*)(WT + (size_t)(d0 + n) * K + k0 + 8 * c) = o; }
    LDS_WAIT(); asm volatile("" ::: "memory");
}
__device__ __forceinline__ void rms_row_to_bf16(int lane, const float* xrow, const float* gain, bf16* orow) {
    const GAS f32x4* xr = (const GAS f32x4*)xrow + lane; const GAS f32x4* gr = (const GAS f32x4*)gain + lane;
    f32x4 v[4]; float s = 0.f;
#pragma unroll
    for (int j = 0; j < 4; ++j) { v[j] = xr[64 * j]; s += (v[j].x * v[j].x + v[j].y * v[j].y) + (v[j].z * v[j].z + v[j].w * v[j].w); }
    const float rstd = 1.f / sqrtf(wave_sum(s) * (1.f / D) + EPS);
    GAS unsigned long long* o8 = (GAS unsigned long long*)orow + lane;
#pragma unroll
    for (int j = 0; j < 4; ++j) { const f32x4 g = gr[64 * j]; o8[64 * j] = (unsigned long long)pk2(v[j].x * rstd * g.x, v[j].y * rstd * g.y) | ((unsigned long long)pk2(v[j].z * rstd * g.z, v[j].w * rstd * g.w) << 32); }
}
__device__ __forceinline__ void rms_row_to_f32(int lane, const float* xrow, const float* gain, float* orow, bool poison) {
    const GAS f32x4* xr = (const GAS f32x4*)xrow + lane; const GAS f32x4* gr = (const GAS f32x4*)gain + lane;
    f32x4 v[4]; float s = 0.f;
#pragma unroll
    for (int j = 0; j < 4; ++j) { v[j] = xr[64 * j]; s += (v[j].x * v[j].x + v[j].y * v[j].y) + (v[j].z * v[j].z + v[j].w * v[j].w); }
    float rstd = 1.f / sqrtf(wave_sum(s) * (1.f / D) + EPS); if (poison) rstd = __builtin_nanf("");
    GAS f32x4* o = (GAS f32x4*)orow + lane;
#pragma unroll
    for (int j = 0; j < 4; ++j) { const f32x4 g = gr[64 * j]; o[64 * j] = v[j] * rstd * g; }
}
__device__ __forceinline__ void p0_prologue(Frame& F) {
    LAS float* scr = (LAS float*)(F.lds + RING_OFF + F.wave * 16384);
    const int gw = F.vcu * NWAVES + F.wave, NGW = F.G * NWAVES;
    constexpr int I_GU = (D / 64) * (FF2 / 32), I_DN = (FF / 64) * (D / 32), I_IN = (D / 64) * (NPROJ / 32), I_OUT = (D / 64) * (D / 32);
    constexpr int NITEMS = 2 * I_GU + 2 * I_DN + I_IN + I_OUT;
    for (int it = gw; it < NITEMS; it += NGW) {
        int r = it;
        if (r < I_GU) { if (((r % (FF2 / 32)) & 7) < 4) p0_transpose_item(MapGU{F.in[I_G1]}, D, FF2 / 32, F.Wgu1, scr, r, F.lane); else p0_transpose_item(MapGU{F.in[I_U1]}, D, FF2 / 32, F.Wgu1, scr, r, F.lane); continue; } r -= I_GU;
        if (r < I_GU) { if (((r % (FF2 / 32)) & 7) < 4) p0_transpose_item(MapGU{F.in[I_G2]}, D, FF2 / 32, F.Wgu2, scr, r, F.lane); else p0_transpose_item(MapGU{F.in[I_U2]}, D, FF2 / 32, F.Wgu2, scr, r, F.lane); continue; } r -= I_GU;
        if (r < I_DN) { p0_transpose_item(MapPlain{F.in[I_D1], D}, FF, D / 32, F.Wd1, scr, r, F.lane); continue; } r -= I_DN;
        if (r < I_DN) { p0_transpose_item(MapPlain{F.in[I_D2], D}, FF, D / 32, F.Wd2, scr, r, F.lane); continue; } r -= I_DN;
        if (r < I_IN) { p0_transpose_item(MapWin{F.in[I_WIN]}, D, NPROJ / 32, F.Win, scr, r, F.lane); continue; } r -= I_IN;
        p0_transpose_item(MapPlain{F.in[I_WOUT], D}, D, D / 32, F.Wout, scr, r, F.lane);
    }
    for (int i = F.vcu * NWAVES * 64 + F.tid; i < CL * NH * HD; i += F.G * NWAVES * 64) {
        F.Wuk[i] = (bf16)f2bf(F.in[I_WUK][i]); const int h = i >> 13, d = (i >> 7) & 63, c = i & 127; F.WuvT[i] = (bf16)f2bf(F.in[I_WUV][((size_t)c * NH + h) * HD + d]); }
    for (int m = gw; m < M; m += NGW) rms_row_to_bf16(F.lane, F.in[I_X] + (size_t)m * D, F.in[I_N1], F.XN + (size_t)m * D);
}
__device__ __forceinline__ void norm_phase(Frame& F, const float* src, const float* gain) {
    const int gw = F.vcu * NWAVES + F.wave, NGW = F.G * NWAVES;
    for (int m = gw; m < M; m += NGW) rms_row_to_bf16(F.lane, src + (size_t)m * D, gain, F.XN + (size_t)m * D);
}

__device__ __forceinline__ void ld8bf(const bf16* p, float (&f)[8]) { const v4u w = *(const GAS v4u*)p; f[0] = bflo(w.x); f[1] = bfhi(w.x); f[2] = bflo(w.y); f[3] = bfhi(w.y); f[4] = bflo(w.z); f[5] = bfhi(w.z); f[6] = bflo(w.w); f[7] = bfhi(w.w); }
__device__ __forceinline__ void prep_phase(Frame& F) {
    const int gw = F.vcu * NWAVES + F.wave, NGW = F.G * NWAVES, lane = F.lane;
    const float* cw = F.in[I_CONVW];
    for (int m = gw; m < M; m += NGW) {
        const bf16* prow = F.PROJ + (size_t)m * NPROJ; const int t = m & (SEQ - 1);
        {
            const unsigned w = *(const GAS unsigned*)(prow + PCKV + 2 * lane); const float a = bflo(w), b = bfhi(w);
            const float rstd = 1.f / sqrtf(wave_sum(a * a + b * b) * (1.f / CL) + EPS);
            const float g0 = F.in[I_NKV][2 * lane], g1 = F.in[I_NKV][2 * lane + 1];
            *(GAS unsigned*)(F.KV + (size_t)m * CL + 2 * lane) = pk2(a * rstd * g0, b * rstd * g1);
        }
        {
            const int c0 = 8 * lane; float gb[8], gc[8], xi[8], y[8];
            ld8bf(prow + PGB + c0, gb); ld8bf(prow + PGC + c0, gc); ld8bf(prow + PXIN + c0, xi);
#pragma unroll
            for (int e = 0; e < 8; ++e) y[e] = cw[2 * 512 + c0 + e] * (gc[e] * xi[e]);
            if (t >= 1) { ld8bf(prow - NPROJ + PGC + c0, gc); ld8bf(prow - NPROJ + PXIN + c0, xi);
#pragma unroll
                for (int e = 0; e < 8; ++e) y[e] += cw[1 * 512 + c0 + e] * (gc[e] * xi[e]); }
            if (t >= 2) { ld8bf(prow - 2 * NPROJ + PGC + c0, gc); ld8bf(prow - 2 * NPROJ + PXIN + c0, xi);
#pragma unroll
                for (int e = 0; e < 8; ++e) y[e] += cw[0 * 512 + c0 + e] * (gc[e] * xi[e]); }
            float ss = 0.f;
#pragma unroll
            for (int e = 0; e < 8; ++e) { y[e] *= gb[e]; ss += y[e] * y[e]; }
            const float rstd = 1.f / sqrtf(wave_sum(ss) * (1.f / 512.f) + EPS);
            const float* g = F.in[I_NCONV] + c0;
            v4u o; o.x = pk2(y[0] * rstd * g[0], y[1] * rstd * g[1]); o.y = pk2(y[2] * rstd * g[2], y[3] * rstd * g[3]); o.z = pk2(y[4] * rstd * g[4], y[5] * rstd * g[5]); o.w = pk2(y[6] * rstd * g[6], y[7] * rstd * g[7]);
            *(GAS v4u*)(F.MIX + (size_t)m * D + 512 + c0) = o;
        }
    }
}

__device__ __forceinline__ int wave_sum_i(int v) {
#pragma unroll
    for (int o = 1; o < 64; o <<= 1) v += __shfl_xor(v, o);
    return v;
}
__device__ __forceinline__ int rel_bucket(int d) {
    if (d < 16) return d;
    return 16 + (d >= 19) + (d >= 21) + (d >= 24) + (d >= 27) + (d >= 31) + (d >= 35) + (d >= 40) + (d >= 46) + (d >= 52) + (d >= 59) + (d >= 67) + (d >= 77) + (d >= 87) + (d >= 99) + (d >= 113);
}
__device__ __forceinline__ void naive_attn_query(Frame& F, int m, LAS float* L) {
    const int lane = F.lane, b = m >> 11, t = m & (SEQ - 1);
    LAS float* qi_s = L;
    LAS float* qa_s = L + 512;
    LAS int* sel_s = (LAS int*)(L + 1536);
    LAS unsigned* sc_s = (LAS unsigned*)(L + 1792);
    LAS float* p_s = L + 1792;
    const bf16* prow = F.PROJ + (size_t)m * NPROJ;
    const bf16* pb = F.PROJ + (size_t)(b * SEQ) * NPROJ;
    float f8[8];
    ld8bf(prow + PQI + 8 * lane, f8);
#pragma unroll
    for (int e = 0; e < 8; ++e) qi_s[8 * lane + e] = f8[e];
    float wv[8]; ld8bf(prow + PWI, wv);
#pragma unroll
    for (int h = 0; h < 8; ++h) wv[h] *= IDX_SCALE;
    LDS_WAIT();
    for (int s = lane; s <= t; s += 64) {
        const bf16* kr = pb + (size_t)s * NPROJ + PKI; float dot[8];
#pragma unroll
        for (int h = 0; h < 8; ++h) dot[h] = 0.f;
#pragma unroll 1
        for (int ch = 0; ch < 8; ++ch) { float k[8]; ld8bf(kr + 8 * ch, k);
#pragma unroll
            for (int h = 0; h < 8; ++h)
#pragma unroll
                for (int e = 0; e < 8; ++e) dot[h] += qi_s[h * 64 + ch * 8 + e] * k[e]; }
        float score = 0.f;
#pragma unroll
        for (int h = 0; h < 8; ++h) score += wv[h] * fmaxf(dot[h], 0.f);
        unsigned u = __float_as_uint(score); u = (u & 0x80000000u) ? ~u : (u | 0x80000000u);
        sc_s[s] = u;
    }
    LDS_WAIT();
    int nsel;
    if (t < TOPK) { nsel = t + 1; for (int i = lane; i < nsel; i += 64) sel_s[i] = i; }
    else {
        unsigned T = 0u;
        for (int bit = 31; bit >= 0; --bit) { const unsigned cand = T | (1u << bit); int cnt = 0;
            for (int s = lane; s <= t; s += 64) cnt += (sc_s[s] >= cand) ? 1 : 0;
            cnt = wave_sum_i(cnt); if (cnt >= TOPK) T = cand; }
        int cgt = 0; for (int s = lane; s <= t; s += 64) cgt += (sc_s[s] > T) ? 1 : 0;
        cgt = wave_sum_i(cgt);
        const int need = TOPK - cgt; int base = 0, taken = 0; const unsigned long long lt = (1ull << lane) - 1ull;
        for (int s0 = 0; s0 <= t; s0 += 64) { const int s = s0 + lane; const bool valid = s <= t; const unsigned key = valid ? sc_s[s] : 0u;
            const bool gt = valid && key > T, eq = valid && key == T;
            const unsigned long long eqm = __ballot(eq); const int eqrank = taken + __popcll(eqm & lt);
            const bool selb = gt || (eq && eqrank < need);
            const unsigned long long sm = __ballot(selb); const int pos = base + __popcll(sm & lt);
            if (selb) sel_s[pos] = s;
            base += __popcll(sm); taken += __popcll(eqm); }
        nsel = TOPK;
    }
    ld8bf(prow + PQ + 8 * lane, f8);
#pragma unroll
    for (int e = 0; e < 8; ++e) qi_s[8 * lane + e] = f8[e];
    LDS_WAIT();
    for (int i = 0; i < 16; ++i) { const int o = lane + 64 * i, h = o >> 7, c = o & 127; const GAS f32x4* w = (const GAS f32x4*)(F.in[I_WUK] + ((size_t)c * 8 + h) * 64); float a = 0.f;
#pragma unroll
        for (int d4 = 0; d4 < 16; ++d4) { const f32x4 wv4 = w[d4]; a += qi_s[h * 64 + 4 * d4] * wv4.x + qi_s[h * 64 + 4 * d4 + 1] * wv4.y + qi_s[h * 64 + 4 * d4 + 2] * wv4.z + qi_s[h * 64 + 4 * d4 + 3] * wv4.w; }
        qa_s[o] = a * 0.125f; }
    LDS_WAIT();
    for (int i = 0; i < 4; ++i) { const int kidx = lane + 64 * i; float lg[8];
        if (kidx < nsel) { const int s = sel_s[kidx]; const bf16* kr = F.KV + (size_t)(b * SEQ + s) * CL;
#pragma unroll
            for (int h = 0; h < 8; ++h) lg[h] = 0.f;
#pragma unroll 1
            for (int ch = 0; ch < 16; ++ch) { float k[8]; ld8bf(kr + 8 * ch, k);
#pragma unroll
                for (int h = 0; h < 8; ++h)
#pragma unroll
                    for (int e = 0; e < 8; ++e) lg[h] += qa_s[h * 128 + ch * 8 + e] * k[e]; }
            const float* rb = F.in[I_RELB] + rel_bucket(t - s) * 8;
#pragma unroll
            for (int h = 0; h < 8; ++h) lg[h] += rb[h];
        } else {
#pragma unroll
            for (int h = 0; h < 8; ++h) lg[h] = -INFINITY; }
#pragma unroll
        for (int h = 0; h < 8; ++h) p_s[h * 256 + kidx] = lg[h]; }
    LDS_WAIT();
    for (int h = 0; h < 8; ++h) { float v[4], mx = -INFINITY;
#pragma unroll
        for (int i = 0; i < 4; ++i) { v[i] = p_s[h * 256 + lane + 64 * i]; mx = fmaxf(mx, v[i]); }
        mx = wave_max(mx); float sm = 0.f;
#pragma unroll
        for (int i = 0; i < 4; ++i) { v[i] = __expf(v[i] - mx); sm += v[i]; }
        sm = wave_sum(sm); const float inv = 1.f / sm;
#pragma unroll
        for (int i = 0; i < 4; ++i) p_s[h * 256 + lane + 64 * i] = v[i] * inv; }
    LDS_WAIT();
    float cx[8][2];
#pragma unroll
    for (int h = 0; h < 8; ++h) { cx[h][0] = 0.f; cx[h][1] = 0.f; }
    for (int k = 0; k < nsel; ++k) { const int s = sel_s[k]; const unsigned w = *(const GAS unsigned*)(F.KV + (size_t)(b * SEQ + s) * CL + 2 * lane); const float k0 = bflo(w), k1 = bfhi(w);
#pragma unroll
        for (int h = 0; h < 8; ++h) { const float p = p_s[h * 256 + k]; cx[h][0] += p * k0; cx[h][1] += p * k1; } }
#pragma unroll
    for (int h = 0; h < 8; ++h) { qa_s[h * 128 + 2 * lane] = cx[h][0]; qa_s[h * 128 + 2 * lane + 1] = cx[h][1]; }
    LDS_WAIT();
    float o8[8]; float ss = 0.f;
#pragma unroll
    for (int h = 0; h < 8; ++h) { float a = 0.f; const float* w = F.in[I_WUV] + h * 64 + lane;
        for (int c = 0; c < 128; ++c) a += qa_s[h * 128 + c] * w[(size_t)c * 512];
        o8[h] = a; ss += a * a; }
    const float rstd = 1.f / sqrtf(wave_sum(ss) * (1.f / 512.f) + EPS);
#pragma unroll
    for (int h = 0; h < 8; ++h) F.MIX[(size_t)m * D + h * 64 + lane] = (bf16)f2bf(o8[h] * rstd * F.in[I_NATT][h * 64 + lane]);
    LDS_WAIT();
}
__device__ __forceinline__ void naive_attn_phase(Frame& F) {
    LAS float* L = (LAS float*)(F.lds + RING_OFF + F.wave * 16384);
    const int gw = F.vcu * NWAVES + F.wave, NGW = F.G * NWAVES;
    for (int idx = gw; idx < M; idx += NGW) { const int b = idx >> 11, tt = idx & (SEQ - 1), t = (b & 1) ? (SEQ - 1 - tt) : tt; naive_attn_query(F, b * SEQ + t, L); }
}

namespace idx {
typedef short bf16x8 __attribute__((ext_vector_type(8)));
typedef float f32x16 __attribute__((ext_vector_type(16)));
constexpr int CHUNK_KEYS = 256, CHUNK_BYTES = CHUNK_KEYS * 128;
__device__ __forceinline__ unsigned sortable(float s) { const unsigned u = __float_as_uint(s); return (u & 0x80000000u) ? ~u : (u | 0x80000000u); }
__device__ __forceinline__ int half_sum(int v) {
#pragma unroll
    for (int o = 1; o < 32; o <<= 1) v += __shfl_xor(v, o);
    return v;
}
#define IDX_WL(dst, val, ln) asm volatile("v_writelane_b32 %0, %1, %2" : "+v"(dst) : "s"(val), "i"(ln))
#define IDX_FOR_KB(...) _Pragma("unroll") for (int g_ = 0; g_ < 8; ++g_) { if (8 * g_ <= qb) { _Pragma("unroll") for (int k_ = 0; k_ < 8; ++k_) { const int kb = 8 * g_ + k_; __VA_ARGS__ } } }
__device__ __forceinline__ void idx_unit(Frame& F, int b, int qb, LAS unsigned char* lds) {
    const int tid = F.tid, lane = F.lane, w = F.wave, r32 = lane & 31, hi = lane >> 5;
    const int q0 = 32 * qb; const size_t rowbase = (size_t)b * SEQ;
    const int ri = (r32 & 3) + 4 * (r32 >> 3), hii = (r32 >> 2) & 1;
    const bf16* arow = F.PROJ + (rowbase + q0 + 4 * w + 2 * hii + (ri >> 3)) * NPROJ + PQI + (ri & 7) * 64 + 8 * hi;
    bf16x8 A[4];
#pragma unroll
    for (int s = 0; s < 4; ++s) A[s] = *(const GAS bf16x8*)(arow + 16 * s);
    float wv[2][8];
#pragma unroll
    for (int qq = 0; qq < 2; ++qq) { ld8bf(F.PROJ + (rowbase + q0 + 4 * w + 2 * hi + qq) * NPROJ + PWI, wv[qq]);
#pragma unroll
        for (int h = 0; h < 8; ++h) wv[qq][h] *= IDX_SCALE; }
    const int lim0 = 4 * w + 2 * hi;
    unsigned sc[64][2];
#pragma unroll
    for (int kb = 0; kb < 64; ++kb) { sc[kb][0] = 0u; sc[kb][1] = 0u; }
    const bf16* kptr = F.PROJ + rowbase * NPROJ + PKI + (size_t)(tid >> 3) * NPROJ + (tid & 7) * 8;
    v4u stg[4];
#define IDX_SLOAD(c) do { _Pragma("unroll") for (int i_ = 0; i_ < 4; ++i_) stg[i_] = *(const GAS v4u*)(kptr + (size_t)(64 * i_) * NPROJ); kptr += (size_t)CHUNK_KEYS * NPROJ; asm volatile("" : "+v"(kptr)); } while (0)
#define IDX_SWRITE() do { _Pragma("unroll") for (int i_ = 0; i_ < 4; ++i_) { const int key_ = (tid >> 3) + 64 * i_; *(LAS v4u*)(lds + key_ * 128 + ((((tid & 7) ^ ((key_ >> 1) & 7))) << 4)) = stg[i_]; } } while (0)
    unsigned boff[4];
#pragma unroll
    for (int s = 0; s < 4; ++s) boff[s] = (unsigned)(r32 * 128 + (((2 * s + hi) ^ ((r32 >> 1) & 7)) << 4));
    IDX_SLOAD(0);
#pragma unroll
    for (int ch = 0; ch < 8; ++ch) {
        if (8 * ch <= qb) {
            __syncthreads();
            IDX_SWRITE();
            __syncthreads();
            if (8 * (ch + 1) <= qb) IDX_SLOAD(ch + 1);
#pragma unroll
            for (int k = 0; k < 8; ++k) {
                const int kb = 8 * ch + k;
                if (kb <= qb) {
                    f32x16 acc = {};
#pragma unroll
                    for (int s = 0; s < 4; ++s) { const bf16x8 B = *(const LAS bf16x8*)(lds + boff[s] + k * 4096);
                        acc = __builtin_amdgcn_mfma_f32_32x32x16_bf16(A[s], B, acc, 0, 0, 0); }
                    float s0 = 0.f, s1 = 0.f;
#pragma unroll
                    for (int h = 0; h < 8; ++h) { s0 = fmaf(fmaxf(acc[h], 0.f), wv[0][h], s0); s1 = fmaf(fmaxf(acc[8 + h], 0.f), wv[1][h], s1); }
                    unsigned u0 = sortable(s0), u1 = sortable(s1);
                    if (kb == qb) { if (r32 > lim0) u0 = 0u; if (r32 > lim0 + 1) u1 = 0u; }
                    sc[kb][0] = u0; sc[kb][1] = u1;
                }
            }
        }
    }
    __syncthreads();
    unsigned T0 = 1u, T1 = 1u; bool d0 = true, d1 = true;
    if (qb >= 8) {
        T0 = 0u; T1 = 0u; d0 = false; d1 = false;
        for (int bit = 31; bit >= 0; --bit) {
            const unsigned c0 = T0 | (1u << bit), c1 = T1 | (1u << bit); int cnt = 0;
            IDX_FOR_KB( cnt += (sc[kb][0] >= c0 ? 1 : 0) + (sc[kb][1] >= c1 ? 65536 : 0); )
            cnt = half_sum(cnt);
            const int n0 = cnt & 0xffff, n1 = cnt >> 16;
            if (!d0 && n0 >= TOPK) { T0 = c0; d0 = (n0 == TOPK); }
            if (!d1 && n1 >= TOPK) { T1 = c1; d1 = (n1 == TOPK); }
            if (__all(d0 && d1)) break;
        }
    }
    unsigned mw0 = 0u, mw1 = 0u, mw2 = 0u, mw3 = 0u;
    if (__all(d0 && d1)) {
        IDX_FOR_KB( const unsigned long long m0 = __ballot(sc[kb][0] >= T0), m1 = __ballot(sc[kb][1] >= T1);
            IDX_WL(mw0, (unsigned)m0, kb); IDX_WL(mw2, (unsigned)(m0 >> 32), kb);
            IDX_WL(mw1, (unsigned)m1, kb); IDX_WL(mw3, (unsigned)(m1 >> 32), kb); )
    } else {
        int cg = 0;
        IDX_FOR_KB( cg += (sc[kb][0] > T0 ? 1 : 0) + (sc[kb][1] > T1 ? 65536 : 0); )
        cg = half_sum(cg);
        const int need0 = d0 ? (1 << 20) : TOPK - (cg & 0xffff), need1 = d1 ? (1 << 20) : TOPK - (cg >> 16);
        int taken0 = 0, taken1 = 0; const unsigned lt = (1u << r32) - 1u;
        IDX_FOR_KB( const bool e0 = sc[kb][0] == T0, e1 = sc[kb][1] == T1;
            const unsigned long long em0 = __ballot(e0), em1 = __ballot(e1);
            const unsigned h0 = hi ? (unsigned)(em0 >> 32) : (unsigned)em0, h1 = hi ? (unsigned)(em1 >> 32) : (unsigned)em1;
            const bool s0 = sc[kb][0] > T0 || (e0 && taken0 + __popc(h0 & lt) < need0), s1 = sc[kb][1] > T1 || (e1 && taken1 + __popc(h1 & lt) < need1);
            taken0 += __popc(h0); taken1 += __popc(h1);
            const unsigned long long m0 = __ballot(s0), m1 = __ballot(s1);
            IDX_WL(mw0, (unsigned)m0, kb); IDX_WL(mw2, (unsigned)(m0 >> 32), kb);
            IDX_WL(mw1, (unsigned)m1, kb); IDX_WL(mw3, (unsigned)(m1 >> 32), kb); )
    }
    unsigned* mrow = F.MASK + (rowbase + q0 + 4 * w) * 64 + lane;
    mrow[0] = mw0; mrow[64] = mw1; mrow[128] = mw2; mrow[192] = mw3;
#undef IDX_SLOAD
#undef IDX_SWRITE
}
#undef IDX_FOR_KB
#undef IDX_WL
__device__ __forceinline__ void idx_phase(Frame& F) {
    for (int v2 = 2 * F.vcu; v2 < 512; v2 += 2 * F.G)
        for (int u = 0; u < 2; ++u) { const int v = v2 >> 1, b = v >> 5, j = v & 31; idx_unit(F, b, u ? j : 63 - j, F.lds + RING_OFF); }
}
}

namespace att {
typedef short bf16x8 __attribute__((ext_vector_type(8)));
typedef short s16x4 __attribute__((ext_vector_type(4)));
typedef float f32x16 __attribute__((ext_vector_type(16)));
typedef unsigned u32x4 __attribute__((ext_vector_type(4)));
typedef float f32x2_t __attribute__((ext_vector_type(2))); typedef __bf16 bf16x2_t __attribute__((ext_vector_type(2)));
constexpr float LOG2E = 1.4426950408889634f;
constexpr int L_K = 0, L_V = 32768, L_TBL = 65536, TBL_N = 320, L_MASK = L_TBL + 8 * TBL_N * 4, MROW = 66, L_RMS = L_MASK + 32 * MROW * 4, L_END = L_RMS + 8 * 32 * 4;
static_assert(L_END <= RING_BYTES, "attention LDS map");
#define ATT_KSWZ(row, colB) ((row) * 256 + ((colB) ^ (((row) & 7) << 4)))
#define ATT_SBAR() __builtin_amdgcn_sched_barrier(0)
__device__ __forceinline__ unsigned cvtpk(float lo, float hi) { f32x2_t v = {lo, hi}; bf16x2_t b = __builtin_convertvector(v, bf16x2_t); return __builtin_bit_cast(unsigned, b); }
__device__ __forceinline__ int v_st(int k, int c) { const int kk = (k & ~0xC) | ((k & 4) << 1) | ((k & 8) >> 1); return ((kk >> 3) * 4 + (c >> 5)) * 512 + ((kk & 7) * 32 + (c & 31)) * 2; }
__device__ __forceinline__ int v_rd_base(int lane) { return ((lane & 3) << 3) | (((lane >> 2) & 3) << 6) | (((lane >> 4) & 1) << 5) | (((lane >> 5) & 1) << 8); }
constexpr int v_rd_off(int d0, int ks, int half) { return d0 * 512 + ks * 4096 + half * 2048; }
template <int OFF> __device__ __forceinline__ s16x4 tr_read(int vb) { s16x4 r; asm volatile("ds_read_b64_tr_b16 %0, %1 offset:%2" : "=&v"(r) : "v"(vb), "i"(OFF) : "memory"); return r; }
template <int D0> __device__ __forceinline__ void pv_one(f32x16& od, int vb, bf16x8 pa0, bf16x8 pa1, bf16x8 pa2, bf16x8 pa3) {
    const s16x4 l0 = tr_read<v_rd_off(D0, 0, 0)>(vb), h0 = tr_read<v_rd_off(D0, 0, 1)>(vb), l1 = tr_read<v_rd_off(D0, 1, 0)>(vb), h1 = tr_read<v_rd_off(D0, 1, 1)>(vb);
    const s16x4 l2 = tr_read<v_rd_off(D0, 2, 0)>(vb), h2 = tr_read<v_rd_off(D0, 2, 1)>(vb), l3 = tr_read<v_rd_off(D0, 3, 0)>(vb), h3 = tr_read<v_rd_off(D0, 3, 1)>(vb);
    asm volatile("s_waitcnt lgkmcnt(0)" ::: "memory"); ATT_SBAR();
#define ATT_PK(L, H) (bf16x8){L[0], L[1], L[2], L[3], H[0], H[1], H[2], H[3]}
    od = __builtin_amdgcn_mfma_f32_32x32x16_bf16(ATT_PK(l0, h0), pa0, od, 0, 0, 0);
    od = __builtin_amdgcn_mfma_f32_32x32x16_bf16(ATT_PK(l1, h1), pa1, od, 0, 0, 0);
    od = __builtin_amdgcn_mfma_f32_32x32x16_bf16(ATT_PK(l2, h2), pa2, od, 0, 0, 0);
    od = __builtin_amdgcn_mfma_f32_32x32x16_bf16(ATT_PK(l3, h3), pa3, od, 0, 0, 0);
#undef ATT_PK
}
__device__ __forceinline__ bf16x8 pack8(const f32x16& x, int s, float sc) {
    u32x4 w = {cvtpk(x[8 * s] * sc, x[8 * s + 1] * sc), cvtpk(x[8 * s + 2] * sc, x[8 * s + 3] * sc), cvtpk(x[8 * s + 4] * sc, x[8 * s + 5] * sc), cvtpk(x[8 * s + 6] * sc, x[8 * s + 7] * sc)};
    return __builtin_bit_cast(bf16x8, w);
}
__device__ __forceinline__ void attn_tables(Frame& F, LAS unsigned char* lds) {
    LAS float* tbl = (LAS float*)(lds + L_TBL);
    for (int i = F.tid; i < 8 * TBL_N; i += NWAVES * 64) { const int h = i / TBL_N, dist = 255 - (i % TBL_N); tbl[i] = dist >= 0 ? F.in[I_RELB][rel_bucket(dist) * 8 + h] * LOG2E : 0.f; }
    __syncthreads();
}
__device__ __forceinline__ void attn_unit(Frame& F, int b, int qb, LAS unsigned char* lds) {
    const int tid = F.tid, lane = F.lane, h = F.wave, r32 = lane & 31, hi = lane >> 5;
    const int q0 = 32 * qb, NT = (qb >> 1) + 1; const size_t rowbase = (size_t)b * SEQ;
    LAS unsigned* msk = (LAS unsigned*)(lds + L_MASK); const LAS float* tbl = (const LAS float*)(lds + L_TBL); LAS float* rms = (LAS float*)(lds + L_RMS);
#pragma unroll
    for (int i = 0; i < 4; ++i) { const int wd = tid + 512 * i; msk[(wd >> 6) * MROW + (wd & 63)] = F.MASK[(rowbase + q0 + (wd >> 6)) * 64 + (wd & 63)]; }
    bf16x8 qr[8];
    {
        bf16x8 Bq[4];
        const bf16* qrow = F.PROJ + (rowbase + q0 + r32) * NPROJ + PQ + h * 64 + 8 * hi;
#pragma unroll
        for (int s = 0; s < 4; ++s) Bq[s] = *(const GAS bf16x8*)(qrow + 16 * s);
        const int ri = (r32 & 3) + 4 * (r32 >> 3), hii = (r32 >> 2) & 1;
#pragma unroll
        for (int cb = 0; cb < 4; ++cb) { const int c = 32 * cb + 16 * (ri >> 3) + 8 * hii + (ri & 7); const bf16* wrow = F.Wuk + ((size_t)c * 8 + h) * 64 + 8 * hi;
            f32x16 acc = {};
#pragma unroll
            for (int s = 0; s < 4; ++s) acc = __builtin_amdgcn_mfma_f32_32x32x16_bf16(*(const GAS bf16x8*)(wrow + 16 * s), Bq[s], acc, 0, 0, 0);
            qr[2 * cb] = pack8(acc, 0, 0.125f * LOG2E); qr[2 * cb + 1] = pack8(acc, 1, 0.125f * LOG2E); }
    }
    const float b31 = F.in[I_RELB][31 * 8 + h] * LOG2E;
    const int sr = tid >> 4, scol = (tid & 15) * 8, vst0 = v_st(sr, scol), vst1 = v_st(32 + sr, scol);
    const int vb0 = (int)(unsigned)(uintptr_t)(lds + L_V) + v_rd_base(lane);
    const bf16* kvb = F.KV + rowbase * CL + (size_t)sr * CL + scol;
    v4u st0, st1;
#define ATT_SLOAD(k0) do { st0 = *(const GAS v4u*)(kvb + (size_t)(k0) * CL); st1 = *(const GAS v4u*)(kvb + (size_t)((k0) + 32) * CL); } while (0)
#define ATT_SWRITE(bf) do { *(LAS v4u*)(lds + L_V + (bf) * 16384 + vst0) = st0; *(LAS v4u*)(lds + L_V + (bf) * 16384 + vst1) = st1; \
        *(LAS v4u*)(lds + L_K + (bf) * 16384 + ATT_KSWZ(sr, scol * 2)) = st0; *(LAS v4u*)(lds + L_K + (bf) * 16384 + ATT_KSWZ(32 + sr, scol * 2)) = st1; } while (0)
    float m_run = -INFINITY, l_run = 0.f; f32x16 o[4] = {};
    ATT_SLOAD(0); ATT_SWRITE(0); __syncthreads();
    for (int j = 0; j < NT; ++j) {
        const int buf = j & 1, k0 = 64 * j;
        if (j + 1 < NT) ATT_SLOAD(k0 + 64);
        f32x16 p0 = {}, p1 = {};
        { const LAS unsigned char* Ks = lds + L_K + buf * 16384;
#pragma unroll
          for (int d0 = 0; d0 < 8; ++d0) { const int cbyte = (d0 * 16 + hi * 8) * 2;
              const bf16x8 k0f = *(const LAS bf16x8*)(Ks + ATT_KSWZ(r32, cbyte)), k1f = *(const LAS bf16x8*)(Ks + ATT_KSWZ(32 + r32, cbyte));
              p0 = __builtin_amdgcn_mfma_f32_32x32x16_bf16(k0f, qr[d0], p0, 0, 0, 0); p1 = __builtin_amdgcn_mfma_f32_32x32x16_bf16(k1f, qr[d0], p1, 0, 0, 0); } }
        const unsigned long long mwd = *(const LAS unsigned long long*)(msk + r32 * MROW + 2 * j);
        const unsigned w0 = (unsigned)mwd >> (4 * hi), w1 = (unsigned)(mwd >> 32) >> (4 * hi);
        const bool far = (k0 + 176 <= q0);
        if (!far) { const LAS float* tb = tbl + h * TBL_N + (255 - (q0 + r32) + k0 + 4 * hi);
#pragma unroll
            for (int r = 0; r < 16; ++r) { p0[r] += tb[(r & 3) + 8 * (r >> 2)]; p1[r] += tb[32 + (r & 3) + 8 * (r >> 2)]; } }
        float rm = fmaxf(p0[0], p1[0]);
#pragma unroll
        for (int r = 1; r < 16; ++r) rm = fmaxf(rm, fmaxf(p0[r], p1[r]));
        { auto rr = __builtin_amdgcn_permlane32_swap(__float_as_uint(rm), __float_as_uint(rm), false, false); rm = fmaxf(__uint_as_float(rr[0]), __uint_as_float(rr[1])); }
        const float boff = far ? b31 : 0.f, mnew = fmaxf(m_run, rm + boff), alpha = __builtin_amdgcn_exp2f(m_run - mnew), off = mnew - boff;
        m_run = mnew;
        float ps = 0.f;
#pragma unroll
        for (int r = 0; r < 16; ++r) { const int pos = (r & 3) + 8 * (r >> 2);
            const unsigned e0 = __float_as_uint(__builtin_amdgcn_exp2f(p0[r] - off)) & (unsigned)(((int)(w0 << (31 - pos))) >> 31);
            const unsigned e1 = __float_as_uint(__builtin_amdgcn_exp2f(p1[r] - off)) & (unsigned)(((int)(w1 << (31 - pos))) >> 31);
            p0[r] = __uint_as_float(e0); p1[r] = __uint_as_float(e1); ps += p0[r] + p1[r]; }
        { auto rr = __builtin_amdgcn_permlane32_swap(__float_as_uint(ps), __float_as_uint(ps), false, false); ps = __uint_as_float(rr[0]) + __uint_as_float(rr[1]); }
        l_run = l_run * alpha + ps;
        if (__any(alpha < 1.f)) {
#pragma unroll
            for (int d = 0; d < 4; ++d)
#pragma unroll
                for (int r = 0; r < 16; ++r) o[d][r] *= alpha; }
        bf16x8 pa0, pa1, pa2, pa3;
#define ATT_PK4(P, BASE, OUT) do { unsigned a0 = cvtpk(P[BASE + 0], P[BASE + 1]), a1 = cvtpk(P[BASE + 2], P[BASE + 3]);   \
        unsigned b0 = cvtpk(P[BASE + 4], P[BASE + 5]), b1 = cvtpk(P[BASE + 6], P[BASE + 7]);                              \
        auto r0 = __builtin_amdgcn_permlane32_swap(a0, b0, false, false); auto r1 = __builtin_amdgcn_permlane32_swap(a1, b1, false, false); \
        u32x4 w_ = {r0[0], r1[0], r0[1], r1[1]}; OUT = __builtin_bit_cast(bf16x8, w_); } while (0)
        ATT_PK4(p0, 0, pa0); ATT_PK4(p0, 8, pa1); ATT_PK4(p1, 0, pa2); ATT_PK4(p1, 8, pa3);
#undef ATT_PK4
        ATT_SBAR();
        { const int vb = vb0 + buf * 16384;
          pv_one<0>(o[0], vb, pa0, pa1, pa2, pa3); pv_one<1>(o[1], vb, pa0, pa1, pa2, pa3); pv_one<2>(o[2], vb, pa0, pa1, pa2, pa3); pv_one<3>(o[3], vb, pa0, pa1, pa2, pa3); }
        if (j + 1 < NT) ATT_SWRITE(buf ^ 1);
        __syncthreads();
    }
    const float inv = 1.f / l_run;
    f32x16 ot[2] = {};
#pragma unroll
    for (int cb = 0; cb < 4; ++cb)
#pragma unroll
        for (int s = 0; s < 2; ++s) { const bf16x8 Bo = pack8(o[cb], s, inv);
#pragma unroll
            for (int db = 0; db < 2; ++db) { const bf16* wp = F.WuvT + ((size_t)(h * 64 + 32 * db + r32)) * CL + 32 * cb + 16 * s + 4 * hi;
                const s16x4 lo = *(const GAS s16x4*)wp, hi4 = *(const GAS s16x4*)(wp + 8);
                ot[db] = __builtin_amdgcn_mfma_f32_32x32x16_bf16((bf16x8){lo[0], lo[1], lo[2], lo[3], hi4[0], hi4[1], hi4[2], hi4[3]}, Bo, ot[db], 0, 0, 0); } }
    float ss = 0.f;
#pragma unroll
    for (int r = 0; r < 16; ++r) ss += ot[0][r] * ot[0][r] + ot[1][r] * ot[1][r];
    { auto rr = __builtin_amdgcn_permlane32_swap(__float_as_uint(ss), __float_as_uint(ss), false, false); ss = __uint_as_float(rr[0]) + __uint_as_float(rr[1]); }
    if (hi == 0) rms[h * 32 + r32] = ss;
    __syncthreads();
    float tot = 0.f;
#pragma unroll
    for (int hh = 0; hh < 8; ++hh) tot += rms[hh * 32 + r32];
    const float rstd = 1.f / sqrtf(tot * (1.f / 512.f) + EPS);
    bf16* orow = F.MIX + (rowbase + q0 + r32) * D + h * 64 + 4 * hi; const float* gn = F.in[I_NATT] + h * 64 + 4 * hi;
#pragma unroll
    for (int db = 0; db < 2; ++db)
#pragma unroll
        for (int g4 = 0; g4 < 4; ++g4) { const int dd = 32 * db + 8 * g4; const f32x4 gv = *(const GAS f32x4*)(gn + dd);
            const unsigned x0 = cvtpk(ot[db][4 * g4] * rstd * gv.x, ot[db][4 * g4 + 1] * rstd * gv.y), x1 = cvtpk(ot[db][4 * g4 + 2] * rstd * gv.z, ot[db][4 * g4 + 3] * rstd * gv.w);
            *(GAS unsigned long long*)(orow + dd) = (unsigned long long)x0 | ((unsigned long long)x1 << 32); }
    __syncthreads();
#undef ATT_SLOAD
#undef ATT_SWRITE
}
__device__ __forceinline__ void attn_phase(Frame& F) {
    attn_tables(F, F.lds + RING_OFF);
    for (int v2 = 2 * F.vcu; v2 < 512; v2 += 2 * F.G)
        for (int u = 0; u < 2; ++u) { const int v = v2 >> 1, b = v >> 5, j = v & 31; attn_unit(F, b, u ? j : 63 - j, F.lds + RING_OFF); }
}
#undef ATT_KSWZ
#undef ATT_SBAR
}

struct Args { const float* in[20]; float* out; unsigned char* ws; int ph_lo, ph_hi, li, pad; };
__global__ void __launch_bounds__(NWAVES * 64, 2) mk_fwd(Args args) {
    extern __shared__ __attribute__((aligned(16))) unsigned char lds[];
    Frame F;
    F.lds = (LAS unsigned char*)lds;
    F.MISC = (volatile LAS unsigned*)(F.lds + MISC_OFF);
    F.tid = threadIdx.x; F.lane = F.tid & 63; F.wave = __builtin_amdgcn_readfirstlane(F.tid >> 6);
    F.G = gridDim.x; { const int bx = blockIdx.x; F.vcu = (F.G % 8 == 0) ? (bx % 8) * (F.G / 8) + bx / 8 : bx; }
    unsigned char* ws = args.ws;
    F.ctl = (gu32*)(ws + WS_CTL);
#pragma unroll
    for (int i = 0; i < 20; ++i) F.in[i] = args.in[i];
    F.out = args.out;
    F.Wgu1 = (bf16*)(ws + WS_WGU1); F.Wd1 = (bf16*)(ws + WS_WD1); F.Win = (bf16*)(ws + WS_WIN); F.Wout = (bf16*)(ws + WS_WOUT); F.Wgu2 = (bf16*)(ws + WS_WGU2); F.Wd2 = (bf16*)(ws + WS_WD2);
    F.Wuk = (bf16*)(ws + WS_WUK); F.WuvT = (bf16*)(ws + WS_WUV);
    F.XN = (bf16*)(ws + WS_XN); F.MIX = (bf16*)(ws + WS_MIX); F.KV = (bf16*)(ws + WS_KV); F.ACT = (bf16*)(ws + WS_ACT); F.PROJ = (bf16*)(ws + WS_ACT); F.MASK = (unsigned*)(ws + WS_MASK);
    for (int u = F.tid; u < (LDS_BYTES - LDSCTL_OFF) / 4; u += NWAVES * 64) ((LAS unsigned*)(F.lds + LDSCTL_OFF))[u] = 0u;
    __syncthreads();
    XcdBarrier bar; bar.bar = (unsigned*)(F.ctl + CW_BAR); bar.x = 0; bar.st = nullptr;
    if (N_LAUNCHES != PER_PHASE) bar = xcd_barrier_post((unsigned*)(F.ctl + CW_BAR), F.MISC + 8);

    const int lo = args.ph_lo, hi = args.ph_hi;
#ifndef PH_MASK
#define PH_MASK 0xFFF
#endif
#define IN(k) (((PH_MASK >> (k)) & 1) && lo <= (k) && (k) < hi)
#define SEAM(k) do { if (IN(k) && IN((k) + 1)) xcd_barrier(bar); } while (0)

    if (IN(0)) { p0_prologue(F); SEAM(0); }
    if (IN(1)) { pg8::Gemm g{F.XN, F.Wgu1, M, FF2, D}; pg8::StaticOrder S; S.init(M, FF2, F.G, (int)blockIdx.x);
        pg8::EpiSwiglu E{F.ACT, FF};
        pg8::gemm_phase<pg8::EpiSwiglu, pg8::StaticOrder, PG8_ALIGN, PG8_SP2>(F.lds + RING_OFF, g, S, E); SEAM(1); }
    if (IN(2)) { pg8::Gemm g{F.ACT, F.Wd1, M, D, FF}; pg8::StaticOrder S; S.init(M, D, F.G, (int)blockIdx.x);
        pg8::EpiRes E{F.in[I_X], F.out, D, 0.5f};
        pg8::gemm_phase<pg8::EpiRes, pg8::StaticOrder, PG8_ALIGN, PG8_SP2>(F.lds + RING_OFF, g, S, E); SEAM(2); }
    if (IN(3)) { norm_phase(F, F.out, F.in[I_NMIX]); SEAM(3); }
    if (IN(4)) { pg8::Gemm g{F.XN, F.Win, M, NPROJ, D}; pg8::StaticOrder S; S.init(M, NPROJ, F.G, (int)blockIdx.x);
        pg8::EpiBf16<0> E{F.PROJ, NPROJ, nullptr, 0, 0, 1.f};
        pg8::gemm_phase<pg8::EpiBf16<0>, pg8::StaticOrder, PG8_ALIGN, PG8_SP2>(F.lds + RING_OFF, g, S, E); SEAM(4); }
#ifndef USE_NAIVE_ATTN
#define USE_NAIVE_ATTN 0
#endif
    if (IN(5)) { prep_phase(F); if (!USE_NAIVE_ATTN) idx::idx_phase(F); SEAM(5); }
    if (IN(6)) { if (USE_NAIVE_ATTN) naive_attn_phase(F); else att::attn_phase(F); SEAM(6); }
    if (IN(7)) { pg8::Gemm g{F.MIX, F.Wout, M, D, D}; pg8::StaticOrder S; S.init(M, D, F.G, (int)blockIdx.x);
        pg8::EpiRes E{F.out, F.out, D, 1.0f};
        pg8::gemm_phase<pg8::EpiRes, pg8::StaticOrder, PG8_ALIGN, PG8_SP2>(F.lds + RING_OFF, g, S, E); SEAM(7); }
    if (IN(8)) { norm_phase(F, F.out, F.in[I_N2]); SEAM(8); }
    if (IN(9)) { pg8::Gemm g{F.XN, F.Wgu2, M, FF2, D}; pg8::StaticOrder S; S.init(M, FF2, F.G, (int)blockIdx.x);
        pg8::EpiSwiglu E{F.ACT, FF};
        pg8::gemm_phase<pg8::EpiSwiglu, pg8::StaticOrder, PG8_ALIGN, PG8_SP2>(F.lds + RING_OFF, g, S, E); SEAM(9); }
    if (IN(10)) { pg8::Gemm g{F.ACT, F.Wd2, M, D, FF}; pg8::StaticOrder S; S.init(M, D, F.G, (int)blockIdx.x);
        pg8::EpiRes E{F.out, F.out, D, 0.5f};
        pg8::gemm_phase<pg8::EpiRes, pg8::StaticOrder, PG8_ALIGN, PG8_SP2>(F.lds + RING_OFF, g, S, E); SEAM(10); }
    if (IN(11)) { const bool poison = __hip_atomic_load((gu32*)(F.ctl + CW_BAR + XB_TMO), RLX_AGENT) != 0u;
        const int gw = F.vcu * NWAVES + F.wave, NGW = F.G * NWAVES;
        for (int m = gw; m < M; m += NGW) rms_row_to_f32(F.lane, F.out + (size_t)m * D, F.in[I_NF], F.out + (size_t)m * D, poison); }
#undef IN
#undef SEAM
}

extern "C" void kernel_launch(void* const* d_in, const int* in_sizes, int n_in, void* d_out, int out_size, void* d_ws, size_t ws_size, hipStream_t stream) {
    static int grid = 0;
    if (grid == 0) {
        if (n_in != 20 || in_sizes[0] != M * D || out_size != M * D || ws_size < WS_END) { fprintf(stderr, "kernel_launch: shape mismatch (n_in %d, in0 %d, out %d, ws %zu); nothing launched\n", n_in, n_in > 0 ? in_sizes[0] : -1, out_size, ws_size); grid = -1; return; }
        int dev = 0, cus = 0, per_cu = 0;
        if (hipGetDevice(&dev) != hipSuccess || hipDeviceGetAttribute(&cus, hipDeviceAttributeMultiprocessorCount, dev) != hipSuccess) { fprintf(stderr, "kernel_launch: hipGetDevice / hipDeviceGetAttribute failed\n"); grid = -1; return; }
        if (hipFuncSetAttribute((const void*)mk_fwd, hipFuncAttributeMaxDynamicSharedMemorySize, LDS_BYTES) != hipSuccess) { fprintf(stderr, "kernel_launch: hipFuncSetAttribute failed\n"); grid = -1; return; }
        if (hipOccupancyMaxActiveBlocksPerMultiprocessor(&per_cu, (const void*)mk_fwd, NWAVES * 64, LDS_BYTES) != hipSuccess || per_cu < 1)
            fprintf(stderr, "kernel_launch: note: occupancy query reports %d workgroups per CU\n", per_cu);
        (void)hipGetLastError();
        grid = cus;
    }
    if (grid < 0) return;
    if (hipMemsetAsync((char*)d_ws + WS_CTL, 0, CTL_ZERO_BYTES, stream) != hipSuccess) { fprintf(stderr, "kernel_launch: hipMemsetAsync failed\n"); return; }
    Args a{};
    for (int i = 0; i < 20; ++i) a.in[i] = (const float*)d_in[i];
    a.out = (float*)d_out; a.ws = (unsigned char*)d_ws;
    for (int li = 0; li < N_LAUNCHES; ++li) {
        a.ph_lo = (N_LAUNCHES == PER_PHASE) ? li : 0; a.ph_hi = (N_LAUNCHES == PER_PHASE) ? li + 1 : PER_PHASE; a.li = li;
        hipLaunchKernelGGL(mk_fwd, dim3(grid), dim3(NWAVES * 64), LDS_BYTES, stream, a);
        const hipError_t le = hipPeekAtLastError();
        if (le != hipSuccess) { fprintf(stderr, "kernel_launch: launch %d failed: %s\n", li, hipGetErrorName(le)); break; }
    }
}
```

```cpp
#include <hip/hip_runtime.h>
#include <cstdio>
#include <cstdint>
namespace pg8 {
#define PG8_LAS __attribute__((address_space(3)))
typedef unsigned short bf16_t;
typedef short bf16x8 __attribute__((ext_vector_type(8)));
typedef float f32x4 __attribute__((ext_vector_type(4)));
typedef unsigned u32x4 __attribute__((ext_vector_type(4)));
constexpr int BM = 256, BK = 64, HALF = 128, HTB = HALF * BK * 2  , STAGE_BYTES = 8 * HTB, NXCD = 8, WGM = 8;

__host__ __device__ __forceinline__ int lds_byte(int r, int c) { const int st = (r >> 4) * 2 + (c >> 5), rr = r & 15, cc = c & 31, ob = rr * 64 + cc * 2; return st * 1024 + (ob ^ (((ob >> 9) & 1) << 5)); }
__host__ __device__ __forceinline__ void stage_rc(int b, int& R, int& C) { const int st = b / 1024, sb = b % 1024, swz = sb ^ (((sb >> 9) & 1) << 5); R = (st >> 1) * 16 + swz / 64; C = (st & 1) * 32 + (swz % 64) / 2; }
__host__ __device__ __forceinline__ int perm32(int rho) { const int n = rho >> 4, i = rho & 15; return 8 * (i >> 2) + 4 * n + (i & 3); }

struct Unit { int pm, pn; };
struct Gemm { const bf16_t* A; const bf16_t* Bt; int M, N, K; };

struct StaticOrder {
    int nM, nN, nwg, G, c, rep;
    __host__ __device__ void init(int M, int N, int G_, int c_, int rep_ = 1) { nM = M / BM; nN = N / BM; nwg = nM * nN; G = G_; c = c_; rep = rep_; }
    __host__ __device__ bool next(int i, Unit& u) const {
        const long L = (long)i * G + c; if (L >= (long)nwg * rep) return false;
        int wgid = (int)(L % nwg); { const int q = nwg / NXCD, r = nwg % NXCD, xcd = wgid % NXCD, off = wgid / NXCD; wgid = (xcd < r ? xcd * (q + 1) : r * (q + 1) + (xcd - r) * q) + off; }
        const int nig = WGM * nN, gid = wgid / nig, fm = gid * WGM, gsz = (nM - fm) < WGM ? (nM - fm) : WGM;
        u.pm = fm + ((wgid % nig) % gsz); u.pn = (wgid % nig) / gsz; return true;
    }
    __device__ __forceinline__ void a_ready(const Unit&) const {}
    __device__ __forceinline__ void done(const Unit&) const {}
};

__device__ __forceinline__ unsigned cvt_pk_bf16(float lo, float hi) { unsigned r; asm volatile("v_cvt_pk_bf16_f32 %0, %1, %2" : "=v"(r) : "v"(lo), "v"(hi)); return r; }
typedef float f32x2 __attribute__((ext_vector_type(2)));
__device__ __forceinline__ f32x2 gelu_pk(f32x2 v) {
    const f32x2 av = __builtin_elementwise_abs(v), d = av * 0.2316418882f + 1.0f;
    f32x2 t; t.x = __builtin_amdgcn_rcpf(d.x); t.y = __builtin_amdgcn_rcpf(d.y);
    f32x2 q = t * 0.5307027145f + (-0.7265760135f); q = q * t + 0.7107068705f; q = q * t + (-0.142248368f); q = q * t + 0.127414796f; q = q * t;
    const f32x2 s = (v * v) * (-0.72134752044f);
    f32x2 e; e.x = __builtin_amdgcn_exp2f(s.x); e.y = __builtin_amdgcn_exp2f(s.y);
    const f32x2 m = v * (q * e), r = v - m;
    f32x2 o; o.x = v.x < 0.f ? m.x : r.x; o.y = v.y < 0.f ? m.y : r.y; return o;
}

template <int ACT  > struct EpiBf16 {
    static constexpr bool PERM = true, AFTER_DRAIN = false; static_assert(ACT == 0 || ACT == 1, "EpiBf16: ACT is 0 (none) or 1 (gelu_pk)");
    bf16_t* O; int ldc; const float* bias; int split_cols; size_t split_stride; float scale0;
    __device__ __forceinline__ void operator()(const f32x4 (&acc)[2][2][4][2], const Unit& u, int wr, int wc, int fr, int fq) const {
        const int row0 = u.pm * BM + wr * 64 + fr; int colt = u.pn * BM; bf16_t* base = O;
        float sc = 1.f; if (split_cols) { const int t = colt / split_cols; base += (size_t)t * split_stride; colt -= t * split_cols; if (t == 0) sc = scale0; }
        const int col0 = colt + wc * 32 + 8 * fq, bcol0 = u.pn * BM + wc * 32 + 8 * fq;
        f32x4 bv[2][2];
#pragma unroll
        for (int bj = 0; bj < 2; ++bj)
#pragma unroll
            for (int n = 0; n < 2; ++n) bv[bj][n] = bias ? *(const f32x4*)(bias + bcol0 + bj * HALF + 4 * n) : (f32x4){0.f, 0.f, 0.f, 0.f};
#pragma unroll
        for (int ai = 0; ai < 2; ++ai)
#pragma unroll
            for (int m = 0; m < 4; ++m) { bf16_t* rowp = base + (size_t)(row0 + ai * HALF + m * 16) * ldc + col0;
#pragma unroll
                for (int bj = 0; bj < 2; ++bj) { f32x4 v0 = acc[ai][bj][m][0] + bv[bj][0], v1 = acc[ai][bj][m][1] + bv[bj][1];
                    if (ACT == 1) { f32x2 a = gelu_pk((f32x2){v0[0], v0[1]}), b = gelu_pk((f32x2){v0[2], v0[3]}), c = gelu_pk((f32x2){v1[0], v1[1]}), d = gelu_pk((f32x2){v1[2], v1[3]});
                        v0 = (f32x4){a.x, a.y, b.x, b.y}; v1 = (f32x4){c.x, c.y, d.x, d.y}; }
                    v0 = v0 * sc; v1 = v1 * sc; u32x4 w; w.x = cvt_pk_bf16(v0[0], v0[1]); w.y = cvt_pk_bf16(v0[2], v0[3]); w.z = cvt_pk_bf16(v1[0], v1[1]); w.w = cvt_pk_bf16(v1[2], v1[3]);
                    *(u32x4*)(rowp + bj * HALF) = w; } }
    }
};


__device__ __forceinline__ unsigned cvt4_fp8(float a, float b, float c, float d) { int w = 0; w = __builtin_amdgcn_cvt_pk_fp8_f32(a, b, w, false); w = __builtin_amdgcn_cvt_pk_fp8_f32(c, d, w, true); return (unsigned)w; }
__device__ __forceinline__ void row_rstd8(const float* ss, int row0, int fq, float inv_n, float eps, float (&rs)[2][4]) {
#pragma unroll
    for (int ai = 0; ai < 2; ++ai)
#pragma unroll
        for (int m = 0; m < 4; ++m) { const f32x4 v = *(const f32x4*)(ss + (size_t)(row0 + ai * HALF + m * 16) * 16 + 4 * fq); float t = (v[0] + v[1]) + (v[2] + v[3]);
            t += __shfl_xor(t, 16); t += __shfl_xor(t, 32); rs[ai][m] = 1.0f / sqrtf(t * inv_n + eps); }
}
__device__ __forceinline__ float silu_mul(float g, float u) { const float e = __builtin_amdgcn_exp2f(g * -1.4426950408889634f); return g * __builtin_amdgcn_rcpf(1.0f + e) * u; }
template <bool OUT8> struct EpiSwiglu {
    static constexpr bool PERM = true, AFTER_DRAIN = false;
    bf16_t* O; int ldc; const float* ss; float inv_n, eps, ascale;
    __device__ __forceinline__ void operator()(const f32x4 (&acc)[2][2][4][2], const Unit& u, int wr, int wc, int fr, int fq) const {
        const int row0 = u.pm * BM + wr * 64 + fr, col0 = u.pn * HALF + wc * 32 + 8 * fq;
        float rs[2][4]; row_rstd8(ss, row0, fq, inv_n, eps, rs);
#pragma unroll
        for (int ai = 0; ai < 2; ++ai)
#pragma unroll
            for (int m = 0; m < 4; ++m) { const float r = rs[ai][m] * ascale;
                const f32x4 g0 = acc[ai][0][m][0] * r, g1 = acc[ai][0][m][1] * r, u0 = acc[ai][1][m][0] * r, u1 = acc[ai][1][m][1] * r;
                if constexpr (OUT8) { typedef unsigned u32x2v __attribute__((ext_vector_type(2))); u32x2v w;
                    w.x = cvt4_fp8(silu_mul(g0[0], u0[0]), silu_mul(g0[1], u0[1]), silu_mul(g0[2], u0[2]), silu_mul(g0[3], u0[3]));
                    w.y = cvt4_fp8(silu_mul(g1[0], u1[0]), silu_mul(g1[1], u1[1]), silu_mul(g1[2], u1[2]), silu_mul(g1[3], u1[3]));
                    *(u32x2v*)((unsigned char*)O + (size_t)(row0 + ai * HALF + m * 16) * ldc + col0) = w; }
                else { bf16_t* rowp = O + (size_t)(row0 + ai * HALF + m * 16) * ldc + col0;
                u32x4 w; w.x = cvt_pk_bf16(silu_mul(g0[0], u0[0]), silu_mul(g0[1], u0[1])); w.y = cvt_pk_bf16(silu_mul(g0[2], u0[2]), silu_mul(g0[3], u0[3]));
                w.z = cvt_pk_bf16(silu_mul(g1[0], u1[0]), silu_mul(g1[1], u1[1])); w.w = cvt_pk_bf16(silu_mul(g1[2], u1[2]), silu_mul(g1[3], u1[3]));
                *(u32x4*)rowp = w; } }
    }
};
struct EpiBf16Rs {
    static constexpr bool PERM = true, AFTER_DRAIN = false;
    bf16_t* O; int ldc; const float* ss; float inv_n, eps;
    __device__ __forceinline__ void operator()(const f32x4 (&acc)[2][2][4][2], const Unit& u, int wr, int wc, int fr, int fq) const {
        const int row0 = u.pm * BM + wr * 64 + fr, col0 = u.pn * BM + wc * 32 + 8 * fq;
        float rs[2][4]; row_rstd8(ss, row0, fq, inv_n, eps, rs);
#pragma unroll
        for (int ai = 0; ai < 2; ++ai)
#pragma unroll
            for (int m = 0; m < 4; ++m) { bf16_t* rowp = O + (size_t)(row0 + ai * HALF + m * 16) * ldc + col0; const float r = rs[ai][m];
#pragma unroll
                for (int bj = 0; bj < 2; ++bj) { const f32x4 v0 = acc[ai][bj][m][0] * r, v1 = acc[ai][bj][m][1] * r;
                    u32x4 w; w.x = cvt_pk_bf16(v0[0], v0[1]); w.y = cvt_pk_bf16(v0[2], v0[3]); w.z = cvt_pk_bf16(v1[0], v1[1]); w.w = cvt_pk_bf16(v1[2], v1[3]);
                    *(u32x4*)(rowp + bj * HALF) = w; } }
    }
};
template <bool XN8> struct EpiResNorm {
    static constexpr bool PERM = false, AFTER_DRAIN = false;
    const float* base; float* out; int ldc; float scale; const float* gain; bf16_t* xn; float* ss;
    __device__ __forceinline__ void operator()(const f32x4 (&acc)[2][2][4][2], const Unit& u, int wr, int wc, int fr, int fq) const {
        const int row0 = u.pm * BM + wr * 64 + fr, col0 = u.pn * BM + wc * 32 + 4 * fq;
        f32x4 gv[2][2];
#pragma unroll
        for (int bj = 0; bj < 2; ++bj)
#pragma unroll
            for (int n = 0; n < 2; ++n) gv[bj][n] = *(const f32x4*)(gain + col0 + bj * HALF + n * 16);
#pragma unroll
        for (int ai = 0; ai < 2; ++ai) {
            f32x4 pre[4][2][2];
#pragma unroll
            for (int m = 0; m < 4; ++m) { const size_t off = (size_t)(row0 + ai * HALF + m * 16) * ldc + col0;
#pragma unroll
                for (int bj = 0; bj < 2; ++bj)
#pragma unroll
                    for (int n = 0; n < 2; ++n) pre[m][bj][n] = *(const f32x4*)(base + off + bj * HALF + n * 16); }
#pragma unroll
            for (int m = 0; m < 4; ++m) { const int row = row0 + ai * HALF + m * 16; const size_t off = (size_t)row * ldc + col0; float q = 0.f;
#pragma unroll
                for (int bj = 0; bj < 2; ++bj)
#pragma unroll
                    for (int n = 0; n < 2; ++n) { const f32x4 o = pre[m][bj][n] + acc[ai][bj][m][n] * scale; *(f32x4*)(out + off + bj * HALF + n * 16) = o;
                        q += (o[0] * o[0] + o[1] * o[1]) + (o[2] * o[2] + o[3] * o[3]); const f32x4 x = o * gv[bj][n];
                        if constexpr (XN8) *(unsigned*)((unsigned char*)xn + off + bj * HALF + n * 16) = cvt4_fp8(x[0], x[1], x[2], x[3]);
                        else { typedef unsigned u32x2v __attribute__((ext_vector_type(2))); u32x2v w; w.x = cvt_pk_bf16(x[0], x[1]); w.y = cvt_pk_bf16(x[2], x[3]); *(u32x2v*)(xn + off + bj * HALF + n * 16) = w; } }
                q += __shfl_xor(q, 16); q += __shfl_xor(q, 32);
                if (fq == 0) ss[(size_t)row * 16 + u.pn * 4 + wc] = q; }
        }
    }
};
struct EpiRes {
    static constexpr bool PERM = false, AFTER_DRAIN = false;
    const float* base; float* out; int ldc; float scale;
    __device__ __forceinline__ void operator()(const f32x4 (&acc)[2][2][4][2], const Unit& u, int wr, int wc, int fr, int fq) const {
        const int row0 = u.pm * BM + wr * 64 + fr, col0 = u.pn * BM + wc * 32 + 4 * fq;
#pragma unroll
        for (int ai = 0; ai < 2; ++ai)
#pragma unroll
            for (int mp = 0; mp < 4; mp += 2) {
                f32x4 pre[2][2][2];
#pragma unroll
                for (int m = 0; m < 2; ++m) { const size_t off = (size_t)(row0 + ai * HALF + (mp + m) * 16) * ldc + col0;
#pragma unroll
                    for (int bj = 0; bj < 2; ++bj)
#pragma unroll
                        for (int n = 0; n < 2; ++n) pre[m][bj][n] = *(const f32x4*)(base + off + bj * HALF + n * 16); }
#pragma unroll
                for (int m = 0; m < 2; ++m) { const size_t off = (size_t)(row0 + ai * HALF + (mp + m) * 16) * ldc + col0;
#pragma unroll
                    for (int bj = 0; bj < 2; ++bj)
#pragma unroll
                        for (int n = 0; n < 2; ++n) *(f32x4*)(out + off + bj * HALF + n * 16) = pre[m][bj][n] + acc[ai][bj][mp + m][n] * scale; }
            }
    }
};

typedef int i32x4 __attribute__((ext_vector_type(4))); typedef int i32x8 __attribute__((ext_vector_type(8)));
template <class Epi, class Sched, bool ALIGN_EPI = false, bool SP2 = false, bool FP8 = false>
__device__ __forceinline__ void gemm_phase(PG8_LAS unsigned char* lds, const Gemm g, const Sched& S, const Epi& E) {
    const int tid = threadIdx.x, wid = __builtin_amdgcn_readfirstlane(tid >> 6), lane = tid & 63, wr = wid >> 2, wc = wid & 3, fr = lane & 15, fq = lane >> 4;
    const int K = g.K, nt = K / BK;
    unsigned voffA[2], voffB[2];
#pragma unroll
    for (int i = 0; i < 2; ++i) { int R, C; stage_rc(tid * 16 + i * 8192, R, C); const int Rb = Epi::PERM ? ((R & ~31) + perm32(R & 31)) : R;
        voffA[i] = (unsigned)(R * K + C) * 2u; voffB[i] = (unsigned)(Rb * K + C) * 2u; }
    const size_t kstep = (size_t)(BK * 2);
    const size_t hstep = (size_t)HALF * K * 2;
    const size_t tstep = 2 * hstep;
    const unsigned ldsw = (unsigned)wid * 1024u;
    const int aoff = lds_byte(wr * 64 + fr, fq * 8), boff = lds_byte(wc * 32 + fr, fq * 8);
#define PG8_SA(b, h) (((b) * 2 + (h)) * HTB)
#define PG8_SB(b, h) ((4 + (b) * 2 + (h)) * HTB)
#define PG8_STAGE(bufoff, gbase, voff) do { _Pragma("unroll") for (int _i = 0; _i < 2; ++_i) \
        __builtin_amdgcn_global_load_lds((const unsigned*)((const char*)(gbase) + (voff)[_i]), (PG8_LAS unsigned*)(lds + (bufoff) + ldsw + _i * 8192), 16, 0, 0); } while (0)
#define PG8_LDA(dst, b, h) do { _Pragma("unroll") for (int m = 0; m < 4; ++m) { dst[m].lo = *(const PG8_LAS i32x4*)(lds + PG8_SA(b, h) + aoff + m * 2048); dst[m].hi = *(const PG8_LAS i32x4*)(lds + PG8_SA(b, h) + aoff + m * 2048 + 1024); } } while (0)
#define PG8_LDB(dst, b, h) do { _Pragma("unroll") for (int n = 0; n < 2; ++n) { dst[n].lo = *(const PG8_LAS i32x4*)(lds + PG8_SB(b, h) + boff + n * 2048); dst[n].hi = *(const PG8_LAS i32x4*)(lds + PG8_SB(b, h) + boff + n * 2048 + 1024); } } while (0)
#define PG8_H(x, k) __builtin_bit_cast(bf16x8, (k) == 0 ? (x).lo : (x).hi)
#define PG8_MMA(ai, bj, At, Bt) do { __builtin_amdgcn_s_setprio(1); \
        if constexpr (FP8) { _Pragma("unroll") for (int m = 0; m < 4; ++m) _Pragma("unroll") for (int n = 0; n < 2; ++n) \
            asm volatile("v_mfma_scale_f32_16x16x128_f8f6f4 %0, %1, %2, %0, %3, %3 op_sel_hi:[0,0,0]" : "+v"(acc[ai][bj][m][n]) : "v"(Bt[n]), "v"(At[m]), "v"(sc8)); } \
        else { _Pragma("unroll") for (int m = 0; m < 4; ++m) _Pragma("unroll") for (int n = 0; n < 2; ++n) _Pragma("unroll") for (int k = 0; k < 2; ++k) \
            acc[ai][bj][m][n] = __builtin_amdgcn_mfma_f32_16x16x32_bf16(PG8_H(Bt[n], k), PG8_H(At[m], k), acc[ai][bj][m][n], 0, 0, 0); } \
        __builtin_amdgcn_s_setprio(0); } while (0)
#define PG8_WAIT_V(n) asm volatile("s_waitcnt vmcnt(" #n ")" ::: "memory")
#define PG8_WAIT_L(n) asm volatile("s_waitcnt lgkmcnt(" #n ")" ::: "memory")
#define PG8_BAR __builtin_amdgcn_s_barrier()
#define PG8_SCHED __builtin_amdgcn_sched_barrier(0)
    Unit cur, nxt; int ui = 0;
    if (!S.next(0, cur)) return;
    f32x4 acc[2][2][4][2];
#pragma unroll
    for (int a = 0; a < 2; ++a)
#pragma unroll
        for (int b = 0; b < 2; ++b)
#pragma unroll
            for (int m = 0; m < 4; ++m)
#pragma unroll
                for (int n = 0; n < 2; ++n) acc[a][b][m][n] = (f32x4){0.f, 0.f, 0.f, 0.f};
    i32x8 At[4], B0[2], B1[2]; int sc8 = 0x7f7f7f7f; asm volatile("" : "+v"(sc8));
    const char* cA = (const char*)g.A + (size_t)cur.pm * tstep; const char* cB = (const char*)g.Bt + (size_t)cur.pn * tstep;
    S.a_ready(cur);
    if constexpr (SP2) {
        PG8_STAGE(PG8_SB(0, 0), cB, voffB); PG8_STAGE(PG8_SB(0, 1), cB + hstep, voffB); PG8_STAGE(PG8_SA(0, 0), cA, voffA); PG8_STAGE(PG8_SA(0, 1), cA + hstep, voffA);
        if (wr == 1) PG8_BAR;
        PG8_WAIT_V(2); PG8_BAR;
        PG8_STAGE(PG8_SB(1, 0), cB + kstep, voffB); PG8_STAGE(PG8_SA(1, 0), cA + kstep, voffA); PG8_STAGE(PG8_SB(1, 1), cB + hstep + kstep, voffB);
        PG8_WAIT_V(6); PG8_BAR;
    } else {
        PG8_STAGE(PG8_SB(0, 0), cB, voffB); PG8_STAGE(PG8_SA(0, 0), cA, voffA); PG8_STAGE(PG8_SB(0, 1), cB + hstep, voffB); PG8_STAGE(PG8_SA(0, 1), cA + hstep, voffA);
        if (wr == 1) PG8_BAR;
        PG8_WAIT_V(4); PG8_BAR;
        PG8_STAGE(PG8_SB(1, 0), cB + kstep, voffB); PG8_STAGE(PG8_SA(1, 0), cA + kstep, voffA); PG8_STAGE(PG8_SB(1, 1), cB + hstep + kstep, voffB);
        PG8_WAIT_V(6); PG8_BAR;
    }
    for (;;) {
        const bool has_next = S.next(ui + 1, nxt);
        const char* nA = has_next ? (const char*)g.A + (size_t)nxt.pm * tstep : cA; const char* nB = has_next ? (const char*)g.Bt + (size_t)nxt.pn * tstep : cB;
#pragma unroll 1
        for (int t = 0; t < nt; t += 2) {
            const bool last = (t == nt - 2);
            const char* a1 = cA + (size_t)(t + 1) * kstep;
            const char* a2 = last ? nA : cA + (size_t)(t + 2) * kstep; const char* b2 = last ? nB : cB + (size_t)(t + 2) * kstep;
            const char* a3 = a2 + kstep; const char* b3 = b2 + kstep;
            if (last && has_next) S.a_ready(nxt);
            if constexpr (SP2) {
            PG8_LDB(B0, 0, 0); PG8_LDB(B1, 0, 1); PG8_SCHED; PG8_LDA(At, 0, 0); PG8_STAGE(PG8_SA(1, 1), a1 + hstep, voffA);
            PG8_WAIT_V(8); PG8_WAIT_L(0); PG8_BAR; PG8_MMA(0, 0, At, B0); PG8_MMA(0, 1, At, B1); PG8_BAR; PG8_SCHED;
            PG8_LDA(At, 0, 1); PG8_STAGE(PG8_SB(0, 0), b2, voffB); PG8_STAGE(PG8_SB(0, 1), b2 + hstep, voffB); PG8_STAGE(PG8_SA(0, 0), a2, voffA);
            PG8_WAIT_V(8); PG8_WAIT_L(0); PG8_BAR; PG8_MMA(1, 0, At, B0); PG8_MMA(1, 1, At, B1); PG8_BAR; PG8_SCHED;
            PG8_LDB(B0, 1, 0); PG8_LDB(B1, 1, 1); PG8_SCHED; PG8_LDA(At, 1, 0); PG8_STAGE(PG8_SA(0, 1), a2 + hstep, voffA);
            PG8_WAIT_V(8); PG8_WAIT_L(0); PG8_BAR; PG8_MMA(0, 0, At, B0); PG8_MMA(0, 1, At, B1); PG8_BAR; PG8_SCHED;
            PG8_LDA(At, 1, 1); PG8_STAGE(PG8_SB(1, 0), b3, voffB); PG8_STAGE(PG8_SB(1, 1), b3 + hstep, voffB); PG8_STAGE(PG8_SA(1, 0), a3, voffA);
            PG8_WAIT_V(8); PG8_WAIT_L(0); PG8_BAR; PG8_MMA(1, 0, At, B0); PG8_MMA(1, 1, At, B1); PG8_BAR; PG8_SCHED;
            } else {
            PG8_LDB(B0, 0, 0); PG8_SCHED; PG8_LDA(At, 0, 0); PG8_STAGE(PG8_SA(1, 1), a1 + hstep, voffA);
            PG8_WAIT_L(8); PG8_BAR; PG8_WAIT_L(0); PG8_MMA(0, 0, At, B0); PG8_BAR; PG8_SCHED;
            PG8_LDB(B1, 0, 1); PG8_STAGE(PG8_SB(0, 0), b2, voffB);
            PG8_BAR; PG8_WAIT_L(0); PG8_MMA(0, 1, At, B1); PG8_BAR;
            PG8_LDA(At, 0, 1); PG8_STAGE(PG8_SA(0, 0), a2, voffA);
            PG8_BAR; PG8_WAIT_L(0); PG8_MMA(1, 0, At, B0); PG8_BAR; PG8_SCHED;
            PG8_STAGE(PG8_SB(0, 1), b2 + hstep, voffB);
            PG8_WAIT_V(6); PG8_BAR; PG8_MMA(1, 1, At, B1); PG8_BAR;
            PG8_LDB(B0, 1, 0); PG8_SCHED; PG8_LDA(At, 1, 0); PG8_STAGE(PG8_SA(0, 1), a2 + hstep, voffA);
            PG8_WAIT_L(8); PG8_BAR; PG8_WAIT_L(0); PG8_MMA(0, 0, At, B0); PG8_BAR; PG8_SCHED;
            PG8_LDB(B1, 1, 1); PG8_STAGE(PG8_SB(1, 0), b3, voffB);
            PG8_BAR; PG8_WAIT_L(0); PG8_MMA(0, 1, At, B1); PG8_BAR;
            PG8_LDA(At, 1, 1); PG8_STAGE(PG8_SA(1, 0), a3, voffA);
            PG8_BAR; PG8_WAIT_L(0); PG8_MMA(1, 0, At, B0); PG8_BAR; PG8_SCHED;
            PG8_STAGE(PG8_SB(1, 1), b3 + hstep, voffB);
            PG8_WAIT_V(6); PG8_BAR; PG8_MMA(1, 1, At, B1); PG8_BAR;
            }
        }
        if constexpr (FP8) asm volatile("s_nop 15\n\ts_nop 15" ::: "memory");
        if constexpr (ALIGN_EPI) { if (wr == 0) PG8_BAR; }
        if constexpr (!Epi::AFTER_DRAIN) { E(acc, cur, wr, wc, fr, fq); S.done(cur); }
        if (!has_next) break;
#pragma unroll
        for (int a = 0; a < 2; ++a)
#pragma unroll
            for (int b = 0; b < 2; ++b)
#pragma unroll
                for (int m = 0; m < 4; ++m)
#pragma unroll
                    for (int n = 0; n < 2; ++n) acc[a][b][m][n] = (f32x4){0.f, 0.f, 0.f, 0.f};
        cur = nxt; cA = nA; cB = nB; ++ui;
        if constexpr (ALIGN_EPI) { if (wr == 1) PG8_BAR; }
    }
    PG8_WAIT_V(0);
    if constexpr (!ALIGN_EPI) { if (wr == 0) PG8_BAR; }
    PG8_BAR;
    if constexpr (Epi::AFTER_DRAIN) { E.fused(acc, cur, wr, wc, fr, fq, lds, wid, lane); S.done(cur); }
#undef PG8_SA
#undef PG8_SB
#undef PG8_STAGE
#undef PG8_LDA
#undef PG8_LDB
#undef PG8_MMA
#undef PG8_H
#undef PG8_WAIT_V
#undef PG8_WAIT_L
#undef PG8_BAR
#undef PG8_SCHED
}
}

#ifndef PG8_SP2
#define PG8_SP2 true
#endif
#ifndef PG8_ALIGN
#define PG8_ALIGN true
#endif

constexpr int NWAVES = 8;
#ifndef MK_N_LAUNCHES
#define MK_N_LAUNCHES 1
#endif
#ifndef REP_MASK
#define REP_MASK 0x2000
#endif
constexpr int PER_PHASE = 12;
constexpr int N_LAUNCHES = MK_N_LAUNCHES;
static_assert(N_LAUNCHES == 1 || N_LAUNCHES == PER_PHASE, "MK_N_LAUNCHES is 1 or 12");

constexpr int BATCH = 8, SEQ = 2048, D = 1024, M = BATCH * SEQ;
constexpr int FF = 2816, FF2 = 2 * FF;
constexpr int NH = 8, HD = 64, CL = 128, TOPK = 256;
constexpr int NPROJ = 2816;
constexpr int PQ = 0, PQI = 512, PCKV = 1024, PKI = 1152, PWI = 1216, PGB = 1280, PGC = 1792, PXIN = 2304;
constexpr int WIN_N = 2760;
constexpr float EPS = 1e-6f;
constexpr float WSC_GU = 32.f, WSC_DN = 64.f;
constexpr float IDX_SCALE = 0.044194173824159216f;

constexpr size_t MiB = 1u << 20;
constexpr size_t WS_CTL = 0, CTL_ZERO_BYTES = 1 * MiB;
constexpr size_t WS_WUK = 1 * MiB, WS_WUV = 1 * MiB + 256 * 1024;
constexpr size_t WS_WGU1 = 2 * MiB, WS_WD1 = 14 * MiB, WS_WIN = 20 * MiB, WS_WOUT = 26 * MiB, WS_WGU2 = 28 * MiB, WS_WD2 = 40 * MiB;
constexpr size_t WS_XN = 48 * MiB;
constexpr size_t WS_MIX = 80 * MiB;
constexpr size_t WS_KV = 112 * MiB;
constexpr size_t WS_MASK = 116 * MiB;
constexpr size_t WS_SS = 120 * MiB;
constexpr size_t WS_ACT = 128 * MiB;
constexpr size_t WS_END = 216 * MiB;
static_assert(WS_WGU1 + (size_t)FF2 * D * 2 <= WS_WD1 && WS_WD1 + (size_t)D * FF * 2 <= WS_WIN && WS_WIN + (size_t)NPROJ * D * 2 <= WS_WOUT && WS_WOUT + (size_t)D * D * 2 <= WS_WGU2 &&
              WS_WGU2 + (size_t)FF2 * D * 2 <= WS_WD2 && WS_WD2 + (size_t)D * FF * 2 <= WS_XN && WS_ACT + (size_t)M * FF * 2 <= WS_END, "d_ws map");
constexpr int CW_BAR = 4096;

constexpr int RING_OFF = 0, RING_BYTES = 131072;
constexpr int LDSCTL_OFF = RING_BYTES, MISC_OFF = LDSCTL_OFF + 320;
constexpr int LDS_BYTES = 147456;
static_assert(MISC_OFF + 128 <= LDS_BYTES, "LDS map");
#define GAS __attribute__((address_space(1)))
#define LAS __attribute__((address_space(3)))
typedef unsigned short bf16;
typedef unsigned v4u __attribute__((ext_vector_type(4)));
typedef float f32x4 __attribute__((ext_vector_type(4)));
typedef short bf16x8 __attribute__((ext_vector_type(8)));
typedef GAS unsigned gu32;
typedef GAS unsigned long long gu64;
#define RLX_AGENT __ATOMIC_RELAXED, __HIP_MEMORY_SCOPE_AGENT
#define LDS_WAIT() asm volatile("s_waitcnt lgkmcnt(0)" ::: "memory")
#define VM_WAIT() asm volatile("s_waitcnt vmcnt(0)" ::: "memory")
__device__ __forceinline__ unsigned long long rt() { return __builtin_amdgcn_s_memrealtime(); }
__device__ __forceinline__ unsigned f2bf(float f) { unsigned u = __builtin_bit_cast(unsigned, f); return (u + 0x7fffu + ((u >> 16) & 1u)) >> 16; }
__device__ __forceinline__ unsigned pk2(float lo, float hi) { return f2bf(lo) | (f2bf(hi) << 16); }

#define XB_TMO      128
#define XB_XCNT(j)  (256  + 64 * (j))
#define XB_XSUB(j)  (1280 + 64 * (j))
#define XB_XGEN(j)  (2304 + 64 * (j))
#define XB_TOP      3328
#define XB_TOPGEN   3392
#define XCD_BAR_WORDS 3456
#define XB_SPIN_CAP (1u << 18)

__device__ __forceinline__ unsigned xb_ld(unsigned* p)              { return __hip_atomic_load(p, __ATOMIC_RELAXED, __HIP_MEMORY_SCOPE_AGENT); }
__device__ __forceinline__ unsigned xb_add(unsigned* p, unsigned v) { return __hip_atomic_fetch_add(p, v, __ATOMIC_RELAXED, __HIP_MEMORY_SCOPE_AGENT); }
__device__ __forceinline__ unsigned xb_xcc_id() { return (unsigned)__builtin_amdgcn_s_getreg((3 << 11) | 20) & 0xFu; }
#define XB_SPIN(cond, bar) do { unsigned _sp = 0; while (cond) { __builtin_amdgcn_s_sleep(1); \
    if ((++_sp & 255u) == 0u) { if (xb_ld(&(bar)[XB_TMO])) break; if (_sp > XB_SPIN_CAP) { atomicAdd(&(bar)[XB_TMO], 1u); break; } } } } while (0)

struct XcdBarrier {
    unsigned* bar; unsigned x;
    volatile LAS unsigned* st;
};

__device__ __forceinline__ XcdBarrier xcd_barrier_post(unsigned* bar, volatile LAS unsigned* st) {
    XcdBarrier b; b.bar = bar; b.x = xb_xcc_id(); b.st = st;
    if (threadIdx.x == 0) (void)xb_add(&bar[XB_XCNT(b.x)], 1u);
    return b;
}
__device__ __forceinline__ void xcd_barrier_complete(unsigned* bar, unsigned x, unsigned& nloc, unsigned& nx) {
    const unsigned G = gridDim.x * gridDim.y * gridDim.z;
    unsigned sum, cnt, mine, sp = 0u;
    for (;;) {
        sum = 0u; cnt = 0u; mine = 0u;
#pragma unroll
        for (unsigned j = 0; j < 16; ++j) { const unsigned c = xb_ld(&bar[XB_XCNT(j)]); sum += c; cnt += (c > 0u) ? 1u : 0u; mine = (j == x) ? c : mine; }
        if (sum == G) break;
        __builtin_amdgcn_s_sleep(1);
        if ((++sp & 255u) == 0u) { if (xb_ld(&bar[XB_TMO])) break; if (sp > XB_SPIN_CAP) { atomicAdd(&bar[XB_TMO], 1u); break; } }
    }
    nloc = mine > 0u ? mine : 1u; nx = cnt > 0u ? cnt : 1u;
}

__device__ __forceinline__ void xcd_barrier(const XcdBarrier& b) {
    asm volatile("s_waitcnt vmcnt(0)" ::: "memory");
    __syncthreads();
    if (threadIdx.x == 0) {
        unsigned* bar = b.bar;
        __builtin_amdgcn_s_waitcnt(0);
        unsigned nloc = b.st[0], nx = b.st[1];
        if (nloc == 0u) { xcd_barrier_complete(bar, b.x, nloc, nx); b.st[0] = nloc; b.st[1] = nx; }
        const unsigned old = xb_add(&bar[XB_XSUB(b.x)], 1u);
        const unsigned gen = old / nloc;
        if (old + 1u == (gen + 1u) * nloc) {
            __builtin_amdgcn_fence(__ATOMIC_RELEASE, "agent");
            asm volatile("s_waitcnt vmcnt(0)" ::: "memory");
            const unsigned og = xb_add(&bar[XB_TOP], 1u);
            const unsigned tg = og / nx;
            if (og + 1u == (tg + 1u) * nx) xb_add(&bar[XB_TOPGEN], 1u);
            else XB_SPIN(xb_ld(&bar[XB_TOPGEN]) == tg, bar);
            __builtin_amdgcn_fence(__ATOMIC_ACQUIRE, "agent");
            xb_add(&bar[XB_XGEN(b.x)], 1u);
            asm volatile("s_waitcnt vmcnt(0)" ::: "memory");
        } else {
            XB_SPIN(xb_ld(&bar[XB_XGEN(b.x)]) == gen, bar);
            __builtin_amdgcn_fence(__ATOMIC_ACQUIRE, "agent");
            asm volatile("s_waitcnt vmcnt(0)" ::: "memory");
        }
    }
    __syncthreads();
}


struct Frame {
    LAS unsigned char* lds;
    volatile LAS unsigned* MISC;
    gu32* ctl;
    int tid, lane, wave;
    int vcu, G;
    const float* in[20]; float* out;
    bf16 *Wgu1, *Wd1, *Win, *Wout, *Wgu2, *Wd2, *Wuk, *WuvT;
    bf16 *XN, *MIX, *KV, *ACT, *PROJ; unsigned* MASK; float* SS;
};
enum { I_X = 0, I_N1, I_G1, I_U1, I_D1, I_NMIX, I_WIN, I_NKV, I_WUK, I_WUV, I_RELB, I_CONVW, I_NATT, I_NCONV, I_WOUT, I_N2, I_G2, I_U2, I_D2, I_NF };

__device__ __forceinline__ float wave_sum(float v) {
#pragma unroll
    for (int o = 1; o < 64; o <<= 1) v += __shfl_xor(v, o);
    return v;
}
__device__ __forceinline__ float wave_max(float v) {
#pragma unroll
    for (int o = 1; o < 64; o <<= 1) v = fmaxf(v, __shfl_xor(v, o));
    return v;
}
__device__ __forceinline__ float bflo(unsigned w) { return __uint_as_float(w << 16); }
__device__ __forceinline__ float bfhi(unsigned w) { return __uint_as_float(w & 0xffff0000u); }

struct Src { const float* W; int N; int col; };
struct MapPlain { const float* W; int N; __device__ __forceinline__ Src operator()(int d) const { return Src{W, N, d}; } };
struct MapGU { const float* W; __device__ __forceinline__ Src operator()(int d) const { return Src{W, FF, (d >> 8) * 128 + (d & 127)}; } };
struct MapWin { const float* W; __device__ __forceinline__ Src operator()(int d) const { int c;
    if (d < 512) c = d;
    else if (d < 1024) c = 640 + (d - 512);
    else if (d < 1152) c = 512 + (d - 1024);
    else if (d < 1224) c = d;
    else if (d < 1280) c = -1;
    else if (d < 1792) c = 1224 + (d - 1280);
    else if (d < 2304) c = 1736 + (d - 1792);
    else c = 2248 + (d - 2304);
    return Src{W, WIN_N, c}; } };
template <class MAP>
__device__ __forceinline__ void p0_transpose_item(const MAP& map, int K, int ndg, bf16* WT, LAS float* scr, int item, int lane) {
    const int kb = item / ndg, dg = item % ndg, k0 = 64 * kb, d0 = 32 * dg;
    const Src src = map(d0 + (lane & 31)); const int sc = src.col; const float* wp = src.W + (size_t)(k0 + (lane >> 5)) * src.N + (sc >= 0 ? sc : 0);
#pragma unroll 8
    for (int i = 0; i < 32; ++i) { const int kk = 2 * i + (lane >> 5); scr[kk * 33 + (lane & 31)] = sc >= 0 ? wp[(size_t)(2 * i) * src.N] : 0.f; }
    LDS_WAIT(); asm volatile("" ::: "memory");
    const int c = lane & 7;
#pragma unroll
    for (int j = 0; j < 4; ++j) { const int n = (lane >> 3) + 8 * j; const LAS float* s = scr + (8 * c) * 33 + n;
        v4u o; o.x = pk2(s[0 * 33], s[1 * 33]); o.y = pk2(s[2 * 33], s[3 * 33]); o.z = pk2(s[4 * 33], s[5 * 33]); o.w = pk2(s[6 * 33], s[7 * 33]);
        *(GAS v4u*)(WT + (size_t)(d0 + n) * K + k0 + 8 * c) = o; }
    LDS_WAIT(); asm volatile("" ::: "memory");
}
template <class MAP>
__device__ __forceinline__ void p0_transpose_item8(const MAP& map, int K, int ndg, unsigned char* WT, LAS float* scr, int item, int lane, float wscale) {
    const int kb = item / ndg, dg = item % ndg, k0 = 64 * kb, d0 = 32 * dg;
    const Src src = map(d0 + (lane & 31)); const int sc = src.col; const float* wp = src.W + (size_t)(k0 + (lane >> 5)) * src.N + (sc >= 0 ? sc : 0);
#pragma unroll 8
    for (int i = 0; i < 32; ++i) { const int kk = 2 * i + (lane >> 5); scr[kk * 33 + (lane & 31)] = sc >= 0 ? wp[(size_t)(2 * i) * src.N] * wscale : 0.f; }
    LDS_WAIT(); asm volatile("" ::: "memory");
    const int c = lane & 7;
#pragma unroll
    for (int j = 0; j < 4; ++j) { const int n = (lane >> 3) + 8 * j; const LAS float* s = scr + (8 * c) * 33 + n;
        typedef unsigned u32x2v __attribute__((ext_vector_type(2))); u32x2v o; o.x = pg8::cvt4_fp8(s[0 * 33], s[1 * 33], s[2 * 33], s[3 * 33]); o.y = pg8::cvt4_fp8(s[4 * 33], s[5 * 33], s[6 * 33], s[7 * 33]);
        *(GAS u32x2v*)(WT + (size_t)(d0 + n) * K + k0 + 8 * c) = o; }
    LDS_WAIT(); asm volatile("" ::: "memory");
}
__device__ __forceinline__ void rms_row_to_bf16(int lane, const float* xrow, const float* gain, bf16* orow) {
    const GAS f32x4* xr = (const GAS f32x4*)xrow + lane; const GAS f32x4* gr = (const GAS f32x4*)gain + lane;
    f32x4 v[4]; float s = 0.f;
#pragma unroll
    for (int j = 0; j < 4; ++j) { v[j] = xr[64 * j]; s += (v[j].x * v[j].x + v[j].y * v[j].y) + (v[j].z * v[j].z + v[j].w * v[j].w); }
    const float rstd = 1.f / sqrtf(wave_sum(s) * (1.f / D) + EPS);
    GAS unsigned long long* o8 = (GAS unsigned long long*)orow + lane;
#pragma unroll
    for (int j = 0; j < 4; ++j) { const f32x4 g = gr[64 * j]; o8[64 * j] = (unsigned long long)pk2(v[j].x * rstd * g.x, v[j].y * rstd * g.y) | ((unsigned long long)pk2(v[j].z * rstd * g.z, v[j].w * rstd * g.w) << 32); }
}
__device__ __forceinline__ void gain_row_to_bf16(int lane, const float* xrow, const float* gain, bf16* orow, float* ssrow) {
    const GAS f32x4* xr = (const GAS f32x4*)xrow + lane; const GAS f32x4* gr = (const GAS f32x4*)gain + lane;
    f32x4 v[4]; float s = 0.f;
#pragma unroll
    for (int j = 0; j < 4; ++j) { v[j] = xr[64 * j]; s += (v[j].x * v[j].x + v[j].y * v[j].y) + (v[j].z * v[j].z + v[j].w * v[j].w); }
    s = wave_sum(s);
    GAS unsigned long long* o8 = (GAS unsigned long long*)orow + lane;
#pragma unroll
    for (int j = 0; j < 4; ++j) { const f32x4 g = gr[64 * j]; o8[64 * j] = (unsigned long long)pk2(v[j].x * g.x, v[j].y * g.y) | ((unsigned long long)pk2(v[j].z * g.z, v[j].w * g.w) << 32); }
    if (lane < 16) ((GAS float*)ssrow)[lane] = lane == 0 ? s : 0.f;
}
__device__ __forceinline__ void rms_row_to_f32(int lane, const float* xrow, const float* gain, float* orow, bool poison) {
    const GAS f32x4* xr = (const GAS f32x4*)xrow + lane; const GAS f32x4* gr = (const GAS f32x4*)gain + lane;
    f32x4 v[4]; float s = 0.f;
#pragma unroll
    for (int j = 0; j < 4; ++j) { v[j] = xr[64 * j]; s += (v[j].x * v[j].x + v[j].y * v[j].y) + (v[j].z * v[j].z + v[j].w * v[j].w); }
    float rstd = 1.f / sqrtf(wave_sum(s) * (1.f / D) + EPS); if (poison) rstd = __builtin_nanf("");
    GAS f32x4* o = (GAS f32x4*)orow + lane;
#pragma unroll
    for (int j = 0; j < 4; ++j) { const f32x4 g = gr[64 * j]; o[64 * j] = v[j] * rstd * g; }
}
__device__ __forceinline__ void p0_prologue(Frame& F) {
    LAS float* scr = (LAS float*)(F.lds + RING_OFF + F.wave * 16384);
    const int gw = F.vcu * NWAVES + F.wave, NGW = F.G * NWAVES;
    constexpr int I_GU = (D / 64) * (FF2 / 32), I_DN = (FF / 64) * (D / 32), I_IN = (D / 64) * (NPROJ / 32), I_OUT = (D / 64) * (D / 32);
    constexpr int NITEMS = 2 * I_GU + 2 * I_DN + I_IN + I_OUT;
    for (int it = gw; it < NITEMS; it += NGW) {
        int r = it;
        if (r < I_GU) { if (((r % (FF2 / 32)) & 7) < 4) p0_transpose_item(MapGU{F.in[I_G1]}, D, FF2 / 32, F.Wgu1, scr, r, F.lane); else p0_transpose_item(MapGU{F.in[I_U1]}, D, FF2 / 32, F.Wgu1, scr, r, F.lane); continue; } r -= I_GU;
        if (r < I_GU) { if (((r % (FF2 / 32)) & 7) < 4) p0_transpose_item8(MapGU{F.in[I_G2]}, D, FF2 / 32, (unsigned char*)F.Wgu2, scr, r, F.lane, WSC_GU); else p0_transpose_item8(MapGU{F.in[I_U2]}, D, FF2 / 32, (unsigned char*)F.Wgu2, scr, r, F.lane, WSC_GU); continue; } r -= I_GU;
        if (r < I_DN) { p0_transpose_item(MapPlain{F.in[I_D1], D}, FF, D / 32, F.Wd1, scr, r, F.lane); continue; } r -= I_DN;
        if (r < I_DN) { p0_transpose_item8(MapPlain{F.in[I_D2], D}, FF, D / 32, (unsigned char*)F.Wd2, scr, r, F.lane, WSC_DN); continue; } r -= I_DN;
        if (r < I_IN) { p0_transpose_item(MapWin{F.in[I_WIN]}, D, NPROJ / 32, F.Win, scr, r, F.lane); continue; } r -= I_IN;
        p0_transpose_item(MapPlain{F.in[I_WOUT], D}, D, D / 32, F.Wout, scr, r, F.lane);
    }
    for (int i = F.vcu * NWAVES * 64 + F.tid; i < CL * NH * HD; i += F.G * NWAVES * 64) {
        F.Wuk[i] = (bf16)f2bf(F.in[I_WUK][i]); const int h = i >> 13, d = (i >> 7) & 63, c = i & 127; F.WuvT[i] = (bf16)f2bf(F.in[I_WUV][((size_t)c * NH + h) * HD + d]); }
    for (int m = gw; m < M; m += NGW) gain_row_to_bf16(F.lane, F.in[I_X] + (size_t)m * D, F.in[I_N1], F.XN + (size_t)m * D, F.SS + (size_t)m * 16);
}
__device__ __forceinline__ void norm_phase(Frame& F, const float* src, const float* gain) {
    const int gw = F.vcu * NWAVES + F.wave, NGW = F.G * NWAVES;
    for (int m = gw; m < M; m += NGW) rms_row_to_bf16(F.lane, src + (size_t)m * D, gain, F.XN + (size_t)m * D);
}

__device__ __forceinline__ void ld8bf(const bf16* p, float (&f)[8]) { const v4u w = *(const GAS v4u*)p; f[0] = bflo(w.x); f[1] = bfhi(w.x); f[2] = bflo(w.y); f[3] = bfhi(w.y); f[4] = bflo(w.z); f[5] = bfhi(w.z); f[6] = bflo(w.w); f[7] = bfhi(w.w); }
__device__ __forceinline__ void prep_phase(Frame& F) {
    const int gw = F.vcu * NWAVES + F.wave, NGW = F.G * NWAVES, lane = F.lane;
    const float* cw = F.in[I_CONVW];
    for (int m = gw; m < M; m += NGW) {
        const bf16* prow = F.PROJ + (size_t)m * NPROJ; const int t = m & (SEQ - 1);
        {
            const unsigned w = *(const GAS unsigned*)(prow + PCKV + 2 * lane); const float a = bflo(w), b = bfhi(w);
            const float rstd = 1.f / sqrtf(wave_sum(a * a + b * b) * (1.f / CL) + EPS);
            const float g0 = F.in[I_NKV][2 * lane], g1 = F.in[I_NKV][2 * lane + 1];
            *(GAS unsigned*)(F.KV + (size_t)m * CL + 2 * lane) = pk2(a * rstd * g0, b * rstd * g1);
        }
        {
            const int c0 = 8 * lane; float gb[8], gc[8], xi[8], y[8];
            ld8bf(prow + PGB + c0, gb); ld8bf(prow + PGC + c0, gc); ld8bf(prow + PXIN + c0, xi);
#pragma unroll
            for (int e = 0; e < 8; ++e) y[e] = cw[2 * 512 + c0 + e] * (gc[e] * xi[e]);
            if (t >= 1) { ld8bf(prow - NPROJ + PGC + c0, gc); ld8bf(prow - NPROJ + PXIN + c0, xi);
#pragma unroll
                for (int e = 0; e < 8; ++e) y[e] += cw[1 * 512 + c0 + e] * (gc[e] * xi[e]); }
            if (t >= 2) { ld8bf(prow - 2 * NPROJ + PGC + c0, gc); ld8bf(prow - 2 * NPROJ + PXIN + c0, xi);
#pragma unroll
                for (int e = 0; e < 8; ++e) y[e] += cw[0 * 512 + c0 + e] * (gc[e] * xi[e]); }
            float ss = 0.f;
#pragma unroll
            for (int e = 0; e < 8; ++e) { y[e] *= gb[e]; ss += y[e] * y[e]; }
            const float rstd = 1.f / sqrtf(wave_sum(ss) * (1.f / 512.f) + EPS);
            const float* g = F.in[I_NCONV] + c0;
            v4u o; o.x = pk2(y[0] * rstd * g[0], y[1] * rstd * g[1]); o.y = pk2(y[2] * rstd * g[2], y[3] * rstd * g[3]); o.z = pk2(y[4] * rstd * g[4], y[5] * rstd * g[5]); o.w = pk2(y[6] * rstd * g[6], y[7] * rstd * g[7]);
            *(GAS v4u*)(F.MIX + (size_t)m * D + 512 + c0) = o;
        }
    }
}

__device__ __forceinline__ int wave_sum_i(int v) {
#pragma unroll
    for (int o = 1; o < 64; o <<= 1) v += __shfl_xor(v, o);
    return v;
}
__device__ __forceinline__ int rel_bucket(int d) {
    if (d < 16) return d;
    return 16 + (d >= 19) + (d >= 21) + (d >= 24) + (d >= 27) + (d >= 31) + (d >= 35) + (d >= 40) + (d >= 46) + (d >= 52) + (d >= 59) + (d >= 67) + (d >= 77) + (d >= 87) + (d >= 99) + (d >= 113);
}
__device__ __forceinline__ void naive_attn_query(Frame& F, int m, LAS float* L) {
    const int lane = F.lane, b = m >> 11, t = m & (SEQ - 1);
    LAS float* qi_s = L;
    LAS float* qa_s = L + 512;
    LAS int* sel_s = (LAS int*)(L + 1536);
    LAS unsigned* sc_s = (LAS unsigned*)(L + 1792);
    LAS float* p_s = L + 1792;
    const bf16* prow = F.PROJ + (size_t)m * NPROJ;
    const bf16* pb = F.PROJ + (size_t)(b * SEQ) * NPROJ;
    float f8[8];
    ld8bf(prow + PQI + 8 * lane, f8);
#pragma unroll
    for (int e = 0; e < 8; ++e) qi_s[8 * lane + e] = f8[e];
    float wv[8]; ld8bf(prow + PWI, wv);
#pragma unroll
    for (int h = 0; h < 8; ++h) wv[h] *= IDX_SCALE;
    LDS_WAIT();
    for (int s = lane; s <= t; s += 64) {
        const bf16* kr = pb + (size_t)s * NPROJ + PKI; float dot[8];
#pragma unroll
        for (int h = 0; h < 8; ++h) dot[h] = 0.f;
#pragma unroll 1
        for (int ch = 0; ch < 8; ++ch) { float k[8]; ld8bf(kr + 8 * ch, k);
#pragma unroll
            for (int h = 0; h < 8; ++h)
#pragma unroll
                for (int e = 0; e < 8; ++e) dot[h] += qi_s[h * 64 + ch * 8 + e] * k[e]; }
        float score = 0.f;
#pragma unroll
        for (int h = 0; h < 8; ++h) score += wv[h] * fmaxf(dot[h], 0.f);
        unsigned u = __float_as_uint(score); u = (u & 0x80000000u) ? ~u : (u | 0x80000000u);
        sc_s[s] = u;
    }
    LDS_WAIT();
    int nsel;
    if (t < TOPK) { nsel = t + 1; for (int i = lane; i < nsel; i += 64) sel_s[i] = i; }
    else {
        unsigned T = 0u;
        for (int bit = 31; bit >= 0; --bit) { const unsigned cand = T | (1u << bit); int cnt = 0;
            for (int s = lane; s <= t; s += 64) cnt += (sc_s[s] >= cand) ? 1 : 0;
            cnt = wave_sum_i(cnt); if (cnt >= TOPK) T = cand; }
        int cgt = 0; for (int s = lane; s <= t; s += 64) cgt += (sc_s[s] > T) ? 1 : 0;
        cgt = wave_sum_i(cgt);
        const int need = TOPK - cgt; int base = 0, taken = 0; const unsigned long long lt = (1ull << lane) - 1ull;
        for (int s0 = 0; s0 <= t; s0 += 64) { const int s = s0 + lane; const bool valid = s <= t; const unsigned key = valid ? sc_s[s] : 0u;
            const bool gt = valid && key > T, eq = valid && key == T;
            const unsigned long long eqm = __ballot(eq); const int eqrank = taken + __popcll(eqm & lt);
            const bool selb = gt || (eq && eqrank < need);
            const unsigned long long sm = __ballot(selb); const int pos = base + __popcll(sm & lt);
            if (selb) sel_s[pos] = s;
            base += __popcll(sm); taken += __popcll(eqm); }
        nsel = TOPK;
    }
    ld8bf(prow + PQ + 8 * lane, f8);
#pragma unroll
    for (int e = 0; e < 8; ++e) qi_s[8 * lane + e] = f8[e];
    LDS_WAIT();
    for (int i = 0; i < 16; ++i) { const int o = lane + 64 * i, h = o >> 7, c = o & 127; const GAS f32x4* w = (const GAS f32x4*)(F.in[I_WUK] + ((size_t)c * 8 + h) * 64); float a = 0.f;
#pragma unroll
        for (int d4 = 0; d4 < 16; ++d4) { const f32x4 wv4 = w[d4]; a += qi_s[h * 64 + 4 * d4] * wv4.x + qi_s[h * 64 + 4 * d4 + 1] * wv4.y + qi_s[h * 64 + 4 * d4 + 2] * wv4.z + qi_s[h * 64 + 4 * d4 + 3] * wv4.w; }
        qa_s[o] = a * 0.125f; }
    LDS_WAIT();
    for (int i = 0; i < 4; ++i) { const int kidx = lane + 64 * i; float lg[8];
        if (kidx < nsel) { const int s = sel_s[kidx]; const bf16* kr = F.KV + (size_t)(b * SEQ + s) * CL;
#pragma unroll
            for (int h = 0; h < 8; ++h) lg[h] = 0.f;
#pragma unroll 1
            for (int ch = 0; ch < 16; ++ch) { float k[8]; ld8bf(kr + 8 * ch, k);
#pragma unroll
                for (int h = 0; h < 8; ++h)
#pragma unroll
                    for (int e = 0; e < 8; ++e) lg[h] += qa_s[h * 128 + ch * 8 + e] * k[e]; }
            const float* rb = F.in[I_RELB] + rel_bucket(t - s) * 8;
#pragma unroll
            for (int h = 0; h < 8; ++h) lg[h] += rb[h];
        } else {
#pragma unroll
            for (int h = 0; h < 8; ++h) lg[h] = -INFINITY; }
#pragma unroll
        for (int h = 0; h < 8; ++h) p_s[h * 256 + kidx] = lg[h]; }
    LDS_WAIT();
    for (int h = 0; h < 8; ++h) { float v[4], mx = -INFINITY;
#pragma unroll
        for (int i = 0; i < 4; ++i) { v[i] = p_s[h * 256 + lane + 64 * i]; mx = fmaxf(mx, v[i]); }
        mx = wave_max(mx); float sm = 0.f;
#pragma unroll
        for (int i = 0; i < 4; ++i) { v[i] = __expf(v[i] - mx); sm += v[i]; }
        sm = wave_sum(sm); const float inv = 1.f / sm;
#pragma unroll
        for (int i = 0; i < 4; ++i) p_s[h * 256 + lane + 64 * i] = v[i] * inv; }
    LDS_WAIT();
    float cx[8][2];
#pragma unroll
    for (int h = 0; h < 8; ++h) { cx[h][0] = 0.f; cx[h][1] = 0.f; }
    for (int k = 0; k < nsel; ++k) { const int s = sel_s[k]; const unsigned w = *(const GAS unsigned*)(F.KV + (size_t)(b * SEQ + s) * CL + 2 * lane); const float k0 = bflo(w), k1 = bfhi(w);
#pragma unroll
        for (int h = 0; h < 8; ++h) { const float p = p_s[h * 256 + k]; cx[h][0] += p * k0; cx[h][1] += p * k1; } }
#pragma unroll
    for (int h = 0; h < 8; ++h) { qa_s[h * 128 + 2 * lane] = cx[h][0]; qa_s[h * 128 + 2 * lane + 1] = cx[h][1]; }
    LDS_WAIT();
    float o8[8]; float ss = 0.f;
#pragma unroll
    for (int h = 0; h < 8; ++h) { float a = 0.f; const float* w = F.in[I_WUV] + h * 64 + lane;
        for (int c = 0; c < 128; ++c) a += qa_s[h * 128 + c] * w[(size_t)c * 512];
        o8[h] = a; ss += a * a; }
    const float rstd = 1.f / sqrtf(wave_sum(ss) * (1.f / 512.f) + EPS);
#pragma unroll
    for (int h = 0; h < 8; ++h) F.MIX[(size_t)m * D + h * 64 + lane] = (bf16)f2bf(o8[h] * rstd * F.in[I_NATT][h * 64 + lane]);
    LDS_WAIT();
}
__device__ __forceinline__ void naive_attn_phase(Frame& F) {
    LAS float* L = (LAS float*)(F.lds + RING_OFF + F.wave * 16384);
    const int gw = F.vcu * NWAVES + F.wave, NGW = F.G * NWAVES;
    for (int idx = gw; idx < M; idx += NGW) { const int b = idx >> 11, tt = idx & (SEQ - 1), t = (b & 1) ? (SEQ - 1 - tt) : tt; naive_attn_query(F, b * SEQ + t, L); }
}

namespace idx {
typedef short bf16x8 __attribute__((ext_vector_type(8)));
typedef float f32x16 __attribute__((ext_vector_type(16)));
constexpr int CHUNK_KEYS = 256, CHUNK_BYTES = CHUNK_KEYS * 128;
__device__ __forceinline__ unsigned sortable(float s) { const unsigned u = __float_as_uint(s); return (u & 0x80000000u) ? ~u : (u | 0x80000000u); }
__device__ __forceinline__ int half_sum(int v) {
#pragma unroll
    for (int o = 1; o < 32; o <<= 1) v += __shfl_xor(v, o);
    return v;
}
#define IDX_WL(dst, val, ln) asm volatile("v_writelane_b32 %0, %1, %2" : "+v"(dst) : "s"(val), "i"(ln))
#define IDX_FOR_KB(...) _Pragma("unroll") for (int g_ = 0; g_ < 8; ++g_) { if (8 * g_ <= qb) { _Pragma("unroll") for (int k_ = 0; k_ < 8; ++k_) { const int kb = 8 * g_ + k_; __VA_ARGS__ } } }
__device__ __forceinline__ void idx_unit(Frame& F, int b, int qb, LAS unsigned char* lds) {
    const int tid = F.tid, lane = F.lane, w = F.wave, r32 = lane & 31, hi = lane >> 5;
    const int q0 = 32 * qb; const size_t rowbase = (size_t)b * SEQ;
    const int ri = (r32 & 3) + 4 * (r32 >> 3), hii = (r32 >> 2) & 1;
    const bf16* arow = F.PROJ + (rowbase + q0 + 4 * w + 2 * hii + (ri >> 3)) * NPROJ + PQI + (ri & 7) * 64 + 8 * hi;
    bf16x8 A[4];
#pragma unroll
    for (int s = 0; s < 4; ++s) A[s] = *(const GAS bf16x8*)(arow + 16 * s);
    float wv[2][8];
#pragma unroll
    for (int qq = 0; qq < 2; ++qq) { ld8bf(F.PROJ + (rowbase + q0 + 4 * w + 2 * hi + qq) * NPROJ + PWI, wv[qq]);
#pragma unroll
        for (int h = 0; h < 8; ++h) wv[qq][h] *= IDX_SCALE; }
    const int lim0 = 4 * w + 2 * hi;
    unsigned sc[64][2];
#pragma unroll
    for (int kb = 0; kb < 64; ++kb) { sc[kb][0] = 0u; sc[kb][1] = 0u; }
    const bf16* kptr = F.PROJ + rowbase * NPROJ + PKI + (size_t)(tid >> 3) * NPROJ + (tid & 7) * 8;
    v4u stg[4];
#define IDX_SLOAD(c) do { _Pragma("unroll") for (int i_ = 0; i_ < 4; ++i_) stg[i_] = *(const GAS v4u*)(kptr + (size_t)(64 * i_) * NPROJ); kptr += (size_t)CHUNK_KEYS * NPROJ; asm volatile("" : "+v"(kptr)); } while (0)
#define IDX_SWRITE() do { _Pragma("unroll") for (int i_ = 0; i_ < 4; ++i_) { const int key_ = (tid >> 3) + 64 * i_; *(LAS v4u*)(lds + key_ * 128 + ((((tid & 7) ^ ((key_ >> 1) & 7))) << 4)) = stg[i_]; } } while (0)
    unsigned boff[4];
#pragma unroll
    for (int s = 0; s < 4; ++s) boff[s] = (unsigned)(r32 * 128 + (((2 * s + hi) ^ ((r32 >> 1) & 7)) << 4));
    IDX_SLOAD(0);
#pragma unroll
    for (int ch = 0; ch < 8; ++ch) {
        if (8 * ch <= qb) {
            __syncthreads();
            IDX_SWRITE();
            __syncthreads();
            if (8 * (ch + 1) <= qb) IDX_SLOAD(ch + 1);
#pragma unroll
            for (int k = 0; k < 8; ++k) {
                const int kb = 8 * ch + k;
                if (kb <= qb) {
                    f32x16 acc = {};
#pragma unroll
                    for (int s = 0; s < 4; ++s) { const bf16x8 B = *(const LAS bf16x8*)(lds + boff[s] + k * 4096);
                        acc = __builtin_amdgcn_mfma_f32_32x32x16_bf16(A[s], B, acc, 0, 0, 0); }
                    float s0 = 0.f, s1 = 0.f;
#pragma unroll
                    for (int h = 0; h < 8; ++h) { s0 = fmaf(fmaxf(acc[h], 0.f), wv[0][h], s0); s1 = fmaf(fmaxf(acc[8 + h], 0.f), wv[1][h], s1); }
                    unsigned u0 = sortable(s0), u1 = sortable(s1);
                    if (kb == qb) { if (r32 > lim0) u0 = 0u; if (r32 > lim0 + 1) u1 = 0u; }
                    sc[kb][0] = u0; sc[kb][1] = u1;
                }
            }
        }
    }
    __syncthreads();
    unsigned T0 = 1u, T1 = 1u; bool d0 = true, d1 = true;
    if (qb >= 8) {
        T0 = 0u; T1 = 0u; d0 = false; d1 = false;
        for (int bit = 31; bit >= 0; --bit) {
            const unsigned c0 = T0 | (1u << bit), c1 = T1 | (1u << bit); int cnt = 0;
            IDX_FOR_KB( cnt += (sc[kb][0] >= c0 ? 1 : 0) + (sc[kb][1] >= c1 ? 65536 : 0); )
            cnt = half_sum(cnt);
            const int n0 = cnt & 0xffff, n1 = cnt >> 16;
            if (!d0 && n0 >= TOPK) { T0 = c0; d0 = (n0 == TOPK); }
            if (!d1 && n1 >= TOPK) { T1 = c1; d1 = (n1 == TOPK); }
            if (__all(d0 && d1)) break;
        }
    }
    unsigned mw0 = 0u, mw1 = 0u, mw2 = 0u, mw3 = 0u;
    if (__all(d0 && d1)) {
        IDX_FOR_KB( const unsigned long long m0 = __ballot(sc[kb][0] >= T0), m1 = __ballot(sc[kb][1] >= T1);
            IDX_WL(mw0, (unsigned)m0, kb); IDX_WL(mw2, (unsigned)(m0 >> 32), kb);
            IDX_WL(mw1, (unsigned)m1, kb); IDX_WL(mw3, (unsigned)(m1 >> 32), kb); )
    } else {
        int cg = 0;
        IDX_FOR_KB( cg += (sc[kb][0] > T0 ? 1 : 0) + (sc[kb][1] > T1 ? 65536 : 0); )
        cg = half_sum(cg);
        const int need0 = d0 ? (1 << 20) : TOPK - (cg & 0xffff), need1 = d1 ? (1 << 20) : TOPK - (cg >> 16);
        int taken0 = 0, taken1 = 0; const unsigned lt = (1u << r32) - 1u;
        IDX_FOR_KB( const bool e0 = sc[kb][0] == T0, e1 = sc[kb][1] == T1;
            const unsigned long long em0 = __ballot(e0), em1 = __ballot(e1);
            const unsigned h0 = hi ? (unsigned)(em0 >> 32) : (unsigned)em0, h1 = hi ? (unsigned)(em1 >> 32) : (unsigned)em1;
            const bool s0 = sc[kb][0] > T0 || (e0 && taken0 + __popc(h0 & lt) < need0), s1 = sc[kb][1] > T1 || (e1 && taken1 + __popc(h1 & lt) < need1);
            taken0 += __popc(h0); taken1 += __popc(h1);
            const unsigned long long m0 = __ballot(s0), m1 = __ballot(s1);
            IDX_WL(mw0, (unsigned)m0, kb); IDX_WL(mw2, (unsigned)(m0 >> 32), kb);
            IDX_WL(mw1, (unsigned)m1, kb); IDX_WL(mw3, (unsigned)(m1 >> 32), kb); )
    }
    unsigned* mrow = F.MASK + (rowbase + q0 + 4 * w) * 64 + lane;
    mrow[0] = mw0; mrow[64] = mw1; mrow[128] = mw2; mrow[192] = mw3;
#undef IDX_SLOAD
#undef IDX_SWRITE
}
#undef IDX_FOR_KB
#undef IDX_WL
__device__ __forceinline__ void idx_phase(Frame& F) {
    for (int v2 = 2 * F.vcu; v2 < 512; v2 += 2 * F.G)
        for (int u = 0; u < 2 * (1 + ((REP_MASK >> 5) & 1)); ++u) { const int v = v2 >> 1, b = v >> 5, j = v & 31; idx_unit(F, b, (u & 1) ? j : 63 - j, F.lds + RING_OFF); }
}
}

namespace att {
typedef short bf16x8 __attribute__((ext_vector_type(8)));
typedef short s16x4 __attribute__((ext_vector_type(4)));
typedef float f32x16 __attribute__((ext_vector_type(16)));
typedef unsigned u32x4 __attribute__((ext_vector_type(4)));
typedef float f32x2_t __attribute__((ext_vector_type(2))); typedef __bf16 bf16x2_t __attribute__((ext_vector_type(2)));
constexpr float LOG2E = 1.4426950408889634f;
constexpr int L_K = 0, L_V = 32768, L_TBL = 65536, TBL_N = 320, L_MASK = L_TBL + 8 * TBL_N * 4, MROW = 66, L_RMS = L_MASK + 32 * MROW * 4, L_END = L_RMS + 8 * 32 * 4;
static_assert(L_END <= RING_BYTES, "attention LDS map");
#define ATT_KSWZ(row, colB) ((row) * 256 + ((colB) ^ (((row) & 7) << 4)))
#define ATT_SBAR() __builtin_amdgcn_sched_barrier(0)
__device__ __forceinline__ unsigned cvtpk(float lo, float hi) { f32x2_t v = {lo, hi}; bf16x2_t b = __builtin_convertvector(v, bf16x2_t); return __builtin_bit_cast(unsigned, b); }
__device__ __forceinline__ int v_st(int k, int c) { const int kk = (k & ~0xC) | ((k & 4) << 1) | ((k & 8) >> 1); return ((kk >> 3) * 4 + (c >> 5)) * 512 + ((kk & 7) * 32 + (c & 31)) * 2; }
__device__ __forceinline__ int v_rd_base(int lane) { return ((lane & 3) << 3) | (((lane >> 2) & 3) << 6) | (((lane >> 4) & 1) << 5) | (((lane >> 5) & 1) << 8); }
constexpr int v_rd_off(int d0, int ks, int half) { return d0 * 512 + ks * 4096 + half * 2048; }
template <int OFF> __device__ __forceinline__ s16x4 tr_read(int vb) { s16x4 r; asm volatile("ds_read_b64_tr_b16 %0, %1 offset:%2" : "=&v"(r) : "v"(vb), "i"(OFF) : "memory"); return r; }
template <int D0> __device__ __forceinline__ void pv_one(f32x16& od, int vb, bf16x8 pa0, bf16x8 pa1, bf16x8 pa2, bf16x8 pa3) {
    const s16x4 l0 = tr_read<v_rd_off(D0, 0, 0)>(vb), h0 = tr_read<v_rd_off(D0, 0, 1)>(vb), l1 = tr_read<v_rd_off(D0, 1, 0)>(vb), h1 = tr_read<v_rd_off(D0, 1, 1)>(vb);
    const s16x4 l2 = tr_read<v_rd_off(D0, 2, 0)>(vb), h2 = tr_read<v_rd_off(D0, 2, 1)>(vb), l3 = tr_read<v_rd_off(D0, 3, 0)>(vb), h3 = tr_read<v_rd_off(D0, 3, 1)>(vb);
    asm volatile("s_waitcnt lgkmcnt(0)" ::: "memory"); ATT_SBAR();
#define ATT_PK(L, H) (bf16x8){L[0], L[1], L[2], L[3], H[0], H[1], H[2], H[3]}
    od = __builtin_amdgcn_mfma_f32_32x32x16_bf16(ATT_PK(l0, h0), pa0, od, 0, 0, 0);
    od = __builtin_amdgcn_mfma_f32_32x32x16_bf16(ATT_PK(l1, h1), pa1, od, 0, 0, 0);
    od = __builtin_amdgcn_mfma_f32_32x32x16_bf16(ATT_PK(l2, h2), pa2, od, 0, 0, 0);
    od = __builtin_amdgcn_mfma_f32_32x32x16_bf16(ATT_PK(l3, h3), pa3, od, 0, 0, 0);
#undef ATT_PK
}
__device__ __forceinline__ bf16x8 pack8(const f32x16& x, int s, float sc) {
    u32x4 w = {cvtpk(x[8 * s] * sc, x[8 * s + 1] * sc), cvtpk(x[8 * s + 2] * sc, x[8 * s + 3] * sc), cvtpk(x[8 * s + 4] * sc, x[8 * s + 5] * sc), cvtpk(x[8 * s + 6] * sc, x[8 * s + 7] * sc)};
    return __builtin_bit_cast(bf16x8, w);
}
__device__ __forceinline__ void attn_tables(Frame& F, LAS unsigned char* lds) {
    LAS float* tbl = (LAS float*)(lds + L_TBL);
    for (int i = F.tid; i < 8 * TBL_N; i += NWAVES * 64) { const int h = i / TBL_N, dist = 255 - (i % TBL_N); tbl[i] = dist >= 0 ? F.in[I_RELB][rel_bucket(dist) * 8 + h] * LOG2E : 0.f; }
    __syncthreads();
}
__device__ __forceinline__ void attn_unit(Frame& F, int b, int qb, LAS unsigned char* lds) {
    const int tid = F.tid, lane = F.lane, h = F.wave, r32 = lane & 31, hi = lane >> 5;
    const int q0 = 32 * qb, NT = (qb >> 1) + 1; const size_t rowbase = (size_t)b * SEQ;
    LAS unsigned* msk = (LAS unsigned*)(lds + L_MASK); const LAS float* tbl = (const LAS float*)(lds + L_TBL); LAS float* rms = (LAS float*)(lds + L_RMS);
#pragma unroll
    for (int i = 0; i < 4; ++i) { const int wd = tid + 512 * i; msk[(wd >> 6) * MROW + (wd & 63)] = F.MASK[(rowbase + q0 + (wd >> 6)) * 64 + (wd & 63)]; }
    bf16x8 qr[8];
    {
        bf16x8 Bq[4];
        const bf16* qrow = F.PROJ + (rowbase + q0 + r32) * NPROJ + PQ + h * 64 + 8 * hi;
#pragma unroll
        for (int s = 0; s < 4; ++s) Bq[s] = *(const GAS bf16x8*)(qrow + 16 * s);
        const int ri = (r32 & 3) + 4 * (r32 >> 3), hii = (r32 >> 2) & 1;
#pragma unroll
        for (int cb = 0; cb < 4; ++cb) { const int c = 32 * cb + 16 * (ri >> 3) + 8 * hii + (ri & 7); const bf16* wrow = F.Wuk + ((size_t)c * 8 + h) * 64 + 8 * hi;
            f32x16 acc = {};
#pragma unroll
            for (int s = 0; s < 4; ++s) acc = __builtin_amdgcn_mfma_f32_32x32x16_bf16(*(const GAS bf16x8*)(wrow + 16 * s), Bq[s], acc, 0, 0, 0);
            qr[2 * cb] = pack8(acc, 0, 0.125f * LOG2E); qr[2 * cb + 1] = pack8(acc, 1, 0.125f * LOG2E); }
    }
    const float b31 = F.in[I_RELB][31 * 8 + h] * LOG2E;
    const int sr = tid >> 4, scol = (tid & 15) * 8, vst0 = v_st(sr, scol), vst1 = v_st(32 + sr, scol);
    const int vb0 = (int)(unsigned)(uintptr_t)(lds + L_V) + v_rd_base(lane);
    const bf16* kvb = F.KV + rowbase * CL + (size_t)sr * CL + scol;
    v4u st0, st1;
#define ATT_SLOAD(k0) do { st0 = *(const GAS v4u*)(kvb + (size_t)(k0) * CL); st1 = *(const GAS v4u*)(kvb + (size_t)((k0) + 32) * CL); } while (0)
#define ATT_SWRITE(bf) do { *(LAS v4u*)(lds + L_V + (bf) * 16384 + vst0) = st0; *(LAS v4u*)(lds + L_V + (bf) * 16384 + vst1) = st1; \
        *(LAS v4u*)(lds + L_K + (bf) * 16384 + ATT_KSWZ(sr, scol * 2)) = st0; *(LAS v4u*)(lds + L_K + (bf) * 16384 + ATT_KSWZ(32 + sr, scol * 2)) = st1; } while (0)
    float m_run = -INFINITY, l_run = 0.f; f32x16 o[4] = {};
    ATT_SLOAD(0); ATT_SWRITE(0); __syncthreads();
    for (int j = 0; j < NT; ++j) {
        const int buf = j & 1, k0 = 64 * j;
        if (j + 1 < NT) ATT_SLOAD(k0 + 64);
        f32x16 p0 = {}, p1 = {};
        { const LAS unsigned char* Ks = lds + L_K + buf * 16384;
#pragma unroll
          for (int d0 = 0; d0 < 8; ++d0) { const int cbyte = (d0 * 16 + hi * 8) * 2;
              const bf16x8 k0f = *(const LAS bf16x8*)(Ks + ATT_KSWZ(r32, cbyte)), k1f = *(const LAS bf16x8*)(Ks + ATT_KSWZ(32 + r32, cbyte));
              p0 = __builtin_amdgcn_mfma_f32_32x32x16_bf16(k0f, qr[d0], p0, 0, 0, 0); p1 = __builtin_amdgcn_mfma_f32_32x32x16_bf16(k1f, qr[d0], p1, 0, 0, 0); } }
        const unsigned long long mwd = *(const LAS unsigned long long*)(msk + r32 * MROW + 2 * j);
        const unsigned w0 = (unsigned)mwd >> (4 * hi), w1 = (unsigned)(mwd >> 32) >> (4 * hi);
        const bool far = (k0 + 176 <= q0);
        if (!far) { const LAS float* tb = tbl + h * TBL_N + (255 - (q0 + r32) + k0 + 4 * hi);
#pragma unroll
            for (int r = 0; r < 16; ++r) { p0[r] += tb[(r & 3) + 8 * (r >> 2)]; p1[r] += tb[32 + (r & 3) + 8 * (r >> 2)]; } }
        float rm = fmaxf(p0[0], p1[0]);
#pragma unroll
        for (int r = 1; r < 16; ++r) rm = fmaxf(rm, fmaxf(p0[r], p1[r]));
        { auto rr = __builtin_amdgcn_permlane32_swap(__float_as_uint(rm), __float_as_uint(rm), false, false); rm = fmaxf(__uint_as_float(rr[0]), __uint_as_float(rr[1])); }
        const float boff = far ? b31 : 0.f, mnew = fmaxf(m_run, rm + boff), alpha = __builtin_amdgcn_exp2f(m_run - mnew), off = mnew - boff;
        m_run = mnew;
        float ps = 0.f;
#pragma unroll
        for (int r = 0; r < 16; ++r) { const int pos = (r & 3) + 8 * (r >> 2);
            const unsigned e0 = __float_as_uint(__builtin_amdgcn_exp2f(p0[r] - off)) & (unsigned)(((int)(w0 << (31 - pos))) >> 31);
            const unsigned e1 = __float_as_uint(__builtin_amdgcn_exp2f(p1[r] - off)) & (unsigned)(((int)(w1 << (31 - pos))) >> 31);
            p0[r] = __uint_as_float(e0); p1[r] = __uint_as_float(e1); ps += p0[r] + p1[r]; }
        { auto rr = __builtin_amdgcn_permlane32_swap(__float_as_uint(ps), __float_as_uint(ps), false, false); ps = __uint_as_float(rr[0]) + __uint_as_float(rr[1]); }
        l_run = l_run * alpha + ps;
        if (__any(alpha < 1.f)) {
#pragma unroll
            for (int d = 0; d < 4; ++d)
#pragma unroll
                for (int r = 0; r < 16; ++r) o[d][r] *= alpha; }
        bf16x8 pa0, pa1, pa2, pa3;
#define ATT_PK4(P, BASE, OUT) do { unsigned a0 = cvtpk(P[BASE + 0], P[BASE + 1]), a1 = cvtpk(P[BASE + 2], P[BASE + 3]);   \
        unsigned b0 = cvtpk(P[BASE + 4], P[BASE + 5]), b1 = cvtpk(P[BASE + 6], P[BASE + 7]);                              \
        auto r0 = __builtin_amdgcn_permlane32_swap(a0, b0, false, false); auto r1 = __builtin_amdgcn_permlane32_swap(a1, b1, false, false); \
        u32x4 w_ = {r0[0], r1[0], r0[1], r1[1]}; OUT = __builtin_bit_cast(bf16x8, w_); } while (0)
        ATT_PK4(p0, 0, pa0); ATT_PK4(p0, 8, pa1); ATT_PK4(p1, 0, pa2); ATT_PK4(p1, 8, pa3);
#undef ATT_PK4
        ATT_SBAR();
        { const int vb = vb0 + buf * 16384;
          pv_one<0>(o[0], vb, pa0, pa1, pa2, pa3); pv_one<1>(o[1], vb, pa0, pa1, pa2, pa3); pv_one<2>(o[2], vb, pa0, pa1, pa2, pa3); pv_one<3>(o[3], vb, pa0, pa1, pa2, pa3); }
        if (j + 1 < NT) ATT_SWRITE(buf ^ 1);
        __syncthreads();
    }
    const float inv = 1.f / l_run;
    f32x16 ot[2] = {};
#pragma unroll
    for (int cb = 0; cb < 4; ++cb)
#pragma unroll
        for (int s = 0; s < 2; ++s) { const bf16x8 Bo = pack8(o[cb], s, inv);
#pragma unroll
            for (int db = 0; db < 2; ++db) { const bf16* wp = F.WuvT + ((size_t)(h * 64 + 32 * db + r32)) * CL + 32 * cb + 16 * s + 4 * hi;
                const s16x4 lo = *(const GAS s16x4*)wp, hi4 = *(const GAS s16x4*)(wp + 8);
                ot[db] = __builtin_amdgcn_mfma_f32_32x32x16_bf16((bf16x8){lo[0], lo[1], lo[2], lo[3], hi4[0], hi4[1], hi4[2], hi4[3]}, Bo, ot[db], 0, 0, 0); } }
    float ss = 0.f;
#pragma unroll
    for (int r = 0; r < 16; ++r) ss += ot[0][r] * ot[0][r] + ot[1][r] * ot[1][r];
    { auto rr = __builtin_amdgcn_permlane32_swap(__float_as_uint(ss), __float_as_uint(ss), false, false); ss = __uint_as_float(rr[0]) + __uint_as_float(rr[1]); }
    if (hi == 0) rms[h * 32 + r32] = ss;
    __syncthreads();
    float tot = 0.f;
#pragma unroll
    for (int hh = 0; hh < 8; ++hh) tot += rms[hh * 32 + r32];
    const float rstd = 1.f / sqrtf(tot * (1.f / 512.f) + EPS);
    bf16* orow = F.MIX + (rowbase + q0 + r32) * D + h * 64 + 4 * hi; const float* gn = F.in[I_NATT] + h * 64 + 4 * hi;
#pragma unroll
    for (int db = 0; db < 2; ++db)
#pragma unroll
        for (int g4 = 0; g4 < 4; ++g4) { const int dd = 32 * db + 8 * g4; const f32x4 gv = *(const GAS f32x4*)(gn + dd);
            const unsigned x0 = cvtpk(ot[db][4 * g4] * rstd * gv.x, ot[db][4 * g4 + 1] * rstd * gv.y), x1 = cvtpk(ot[db][4 * g4 + 2] * rstd * gv.z, ot[db][4 * g4 + 3] * rstd * gv.w);
            *(GAS unsigned long long*)(orow + dd) = (unsigned long long)x0 | ((unsigned long long)x1 << 32); }
    __syncthreads();
#undef ATT_SLOAD
#undef ATT_SWRITE
}
__device__ __forceinline__ void attn_phase(Frame& F) {
    attn_tables(F, F.lds + RING_OFF);
    for (int v2 = 2 * F.vcu; v2 < 512; v2 += 2 * F.G)
        for (int u = 0; u < 2 * (1 + ((REP_MASK >> 6) & 1)); ++u) { const int v = v2 >> 1, b = v >> 5, j = v & 31; attn_unit(F, b, (u & 1) ? j : 63 - j, F.lds + RING_OFF); }
}
#undef ATT_KSWZ
#undef ATT_SBAR
}

struct Args { const float* in[20]; float* out; unsigned char* ws; int ph_lo, ph_hi, li, pad; };
__global__ void __launch_bounds__(NWAVES * 64, 2) mk_fwd(Args args) {
    extern __shared__ __attribute__((aligned(16))) unsigned char lds[];
    Frame F;
    F.lds = (LAS unsigned char*)lds;
    F.MISC = (volatile LAS unsigned*)(F.lds + MISC_OFF);
    F.tid = threadIdx.x; F.lane = F.tid & 63; F.wave = __builtin_amdgcn_readfirstlane(F.tid >> 6);
    F.G = gridDim.x; { const int bx = blockIdx.x; F.vcu = (F.G % 8 == 0) ? (bx % 8) * (F.G / 8) + bx / 8 : bx; }
    unsigned char* ws = args.ws;
    F.ctl = (gu32*)(ws + WS_CTL);
#pragma unroll
    for (int i = 0; i < 20; ++i) F.in[i] = args.in[i];
    F.out = args.out;
    F.Wgu1 = (bf16*)(ws + WS_WGU1); F.Wd1 = (bf16*)(ws + WS_WD1); F.Win = (bf16*)(ws + WS_WIN); F.Wout = (bf16*)(ws + WS_WOUT); F.Wgu2 = (bf16*)(ws + WS_WGU2); F.Wd2 = (bf16*)(ws + WS_WD2);
    F.Wuk = (bf16*)(ws + WS_WUK); F.WuvT = (bf16*)(ws + WS_WUV);
    F.XN = (bf16*)(ws + WS_XN); F.MIX = (bf16*)(ws + WS_MIX); F.KV = (bf16*)(ws + WS_KV); F.ACT = (bf16*)(ws + WS_ACT); F.PROJ = (bf16*)(ws + WS_ACT); F.MASK = (unsigned*)(ws + WS_MASK); F.SS = (float*)(ws + WS_SS);
    for (int u = F.tid; u < (LDS_BYTES - LDSCTL_OFF) / 4; u += NWAVES * 64) ((LAS unsigned*)(F.lds + LDSCTL_OFF))[u] = 0u;
    __syncthreads();
    XcdBarrier bar; bar.bar = (unsigned*)(F.ctl + CW_BAR); bar.x = 0; bar.st = nullptr;
    if (N_LAUNCHES != PER_PHASE) bar = xcd_barrier_post((unsigned*)(F.ctl + CW_BAR), F.MISC + 8);

    const int lo = args.ph_lo, hi = args.ph_hi;
#ifndef PH_MASK
#define PH_MASK 0xFFF
#endif
#define IN(k) (((PH_MASK >> (k)) & 1) && lo <= (k) && (k) < hi)
#define SEAM(k) do { if (IN(k) && (k) + 1 < hi) { xcd_barrier(bar); if (REP_MASK & 0x2000) xcd_barrier(bar); } } while (0)

    if (IN(0)) { p0_prologue(F); if (REP_MASK & 1) { VM_WAIT(); __syncthreads(); p0_prologue(F); } SEAM(0); }
    if (IN(1)) { pg8::Gemm g{F.XN, F.Wgu1, M, FF2, D}; pg8::StaticOrder S; S.init(M, FF2, F.G, (int)blockIdx.x, 1 + ((REP_MASK >> 1) & 1));
        pg8::EpiSwiglu<false> E{F.ACT, FF, F.SS, 1.0f / D, EPS, 1.0f};
        pg8::gemm_phase<pg8::EpiSwiglu<false>, pg8::StaticOrder, PG8_ALIGN, PG8_SP2>(F.lds + RING_OFF, g, S, E); SEAM(1); }
    if (IN(2)) { pg8::Gemm g{F.ACT, F.Wd1, M, D, FF}; pg8::StaticOrder S; S.init(M, D, F.G, (int)blockIdx.x, 1 + ((REP_MASK >> 2) & 1));
        pg8::EpiResNorm<false> E{F.in[I_X], F.out, D, 0.5f, F.in[I_NMIX], F.XN, F.SS};
        pg8::gemm_phase<pg8::EpiResNorm<false>, pg8::StaticOrder, PG8_ALIGN, PG8_SP2>(F.lds + RING_OFF, g, S, E); SEAM(2); }
    if (IN(4)) { pg8::Gemm g{F.XN, F.Win, M, NPROJ, D}; pg8::StaticOrder S; S.init(M, NPROJ, F.G, (int)blockIdx.x, 1 + ((REP_MASK >> 4) & 1));
        pg8::EpiBf16Rs E{F.PROJ, NPROJ, F.SS, 1.0f / D, EPS};
        pg8::gemm_phase<pg8::EpiBf16Rs, pg8::StaticOrder, PG8_ALIGN, PG8_SP2>(F.lds + RING_OFF, g, S, E); SEAM(4); }
#ifndef USE_NAIVE_ATTN
#define USE_NAIVE_ATTN 0
#endif
    if (IN(5)) { prep_phase(F); if (REP_MASK & 0x1000) prep_phase(F); if (!USE_NAIVE_ATTN) idx::idx_phase(F); SEAM(5); }
    if (IN(6)) { if (USE_NAIVE_ATTN) naive_attn_phase(F); else att::attn_phase(F); SEAM(6); }
    if (IN(7)) { pg8::Gemm g{F.MIX, F.Wout, M, D, D}; pg8::StaticOrder S; S.init(M, D, F.G, (int)blockIdx.x);
        pg8::EpiResNorm<true> E{F.out, F.out, D, 1.0f, F.in[I_N2], F.XN, F.SS};
        pg8::gemm_phase<pg8::EpiResNorm<true>, pg8::StaticOrder, PG8_ALIGN, PG8_SP2>(F.lds + RING_OFF, g, S, E); SEAM(7); }
    if (IN(9)) { pg8::Gemm g{F.XN, F.Wgu2, M, FF2, D / 2}; pg8::StaticOrder S; S.init(M, FF2, F.G, (int)blockIdx.x);
        pg8::EpiSwiglu<true> E{F.ACT, FF, F.SS, 1.0f / D, EPS, 1.0f / WSC_GU};
        pg8::gemm_phase<pg8::EpiSwiglu<true>, pg8::StaticOrder, PG8_ALIGN, PG8_SP2, true>(F.lds + RING_OFF, g, S, E); SEAM(9); }
    if (IN(10)) { pg8::Gemm g{F.ACT, F.Wd2, M, D, FF / 2}; pg8::StaticOrder S; S.init(M, D, F.G, (int)blockIdx.x);
        pg8::EpiRes E{F.out, F.out, D, 0.5f / WSC_DN};
        pg8::gemm_phase<pg8::EpiRes, pg8::StaticOrder, PG8_ALIGN, PG8_SP2, true>(F.lds + RING_OFF, g, S, E); SEAM(10); }
    if (IN(11)) { const bool poison = __hip_atomic_load((gu32*)(F.ctl + CW_BAR + XB_TMO), RLX_AGENT) != 0u;
        const int gw = F.vcu * NWAVES + F.wave, NGW = F.G * NWAVES;
        for (int m = gw; m < M; m += NGW) rms_row_to_f32(F.lane, F.out + (size_t)m * D, F.in[I_NF], F.out + (size_t)m * D, poison); }
#undef IN
#undef SEAM
}

extern "C" void kernel_launch(void* const* d_in, const int* in_sizes, int n_in, void* d_out, int out_size, void* d_ws, size_t ws_size, hipStream_t stream) {
    static int grid = 0;
    if (grid == 0) {
        if (n_in != 20 || in_sizes[0] != M * D || out_size != M * D || ws_size < WS_END) { fprintf(stderr, "kernel_launch: shape mismatch (n_in %d, in0 %d, out %d, ws %zu); nothing launched\n", n_in, n_in > 0 ? in_sizes[0] : -1, out_size, ws_size); grid = -1; return; }
        int dev = 0, cus = 0, per_cu = 0;
        if (hipGetDevice(&dev) != hipSuccess || hipDeviceGetAttribute(&cus, hipDeviceAttributeMultiprocessorCount, dev) != hipSuccess) { fprintf(stderr, "kernel_launch: hipGetDevice / hipDeviceGetAttribute failed\n"); grid = -1; return; }
        if (hipFuncSetAttribute((const void*)mk_fwd, hipFuncAttributeMaxDynamicSharedMemorySize, LDS_BYTES) != hipSuccess) { fprintf(stderr, "kernel_launch: hipFuncSetAttribute failed\n"); grid = -1; return; }
        if (hipOccupancyMaxActiveBlocksPerMultiprocessor(&per_cu, (const void*)mk_fwd, NWAVES * 64, LDS_BYTES) != hipSuccess || per_cu < 1)
            fprintf(stderr, "kernel_launch: note: occupancy query reports %d workgroups per CU\n", per_cu);
        (void)hipGetLastError();
        grid = cus;
    }
    if (grid < 0) return;
    if (hipMemsetAsync((char*)d_ws + WS_CTL, 0, CTL_ZERO_BYTES, stream) != hipSuccess) { fprintf(stderr, "kernel_launch: hipMemsetAsync failed\n"); return; }
    Args a{};
    for (int i = 0; i < 20; ++i) a.in[i] = (const float*)d_in[i];
    a.out = (float*)d_out; a.ws = (unsigned char*)d_ws;
    for (int li = 0; li < N_LAUNCHES; ++li) {
        a.ph_lo = (N_LAUNCHES == PER_PHASE) ? li : 0; a.ph_hi = (N_LAUNCHES == PER_PHASE) ? li + 1 : PER_PHASE; a.li = li;
        hipLaunchKernelGGL(mk_fwd, dim3(grid), dim3(NWAVES * 64), LDS_BYTES, stream, a);
        const hipError_t le = hipPeekAtLastError();
        if (le != hipSuccess) { fprintf(stderr, "kernel_launch: launch %d failed: %s\n", li, hipGetErrorName(le)); break; }
    }
}
```

```cpp
#include <hip/hip_runtime.h>
#include <cstdio>
#include <cstdint>
namespace pg8 {
#define PG8_LAS __attribute__((address_space(3)))
typedef unsigned short bf16_t;
typedef short bf16x8 __attribute__((ext_vector_type(8)));
typedef float f32x4 __attribute__((ext_vector_type(4)));
typedef unsigned u32x4 __attribute__((ext_vector_type(4)));
constexpr int BM = 256, BK = 64, HALF = 128, HTB = HALF * BK * 2  , STAGE_BYTES = 8 * HTB, NXCD = 8, WGM = 8;

__host__ __device__ __forceinline__ int lds_byte(int r, int c) { const int st = (r >> 4) * 2 + (c >> 5), rr = r & 15, cc = c & 31, ob = rr * 64 + cc * 2; return st * 1024 + (ob ^ (((ob >> 9) & 1) << 5)); }
__host__ __device__ __forceinline__ void stage_rc(int b, int& R, int& C) { const int st = b / 1024, sb = b % 1024, swz = sb ^ (((sb >> 9) & 1) << 5); R = (st >> 1) * 16 + swz / 64; C = (st & 1) * 32 + (swz % 64) / 2; }
__host__ __device__ __forceinline__ int perm32(int rho) { const int n = rho >> 4, i = rho & 15; return 8 * (i >> 2) + 4 * n + (i & 3); }

struct Unit { int pm, pn; };
struct Gemm { const bf16_t* A; const bf16_t* Bt; int M, N, K; };

struct StaticOrder {
    int nM, nN, nwg, G, c, rep;
    __host__ __device__ void init(int M, int N, int G_, int c_, int rep_ = 1) { nM = M / BM; nN = N / BM; nwg = nM * nN; G = G_; c = c_; rep = rep_; }
    __host__ __device__ bool next(int i, Unit& u) const {
        const long L = (long)i * G + c; if (L >= (long)nwg * rep) return false;
        int wgid = (int)(L % nwg); { const int q = nwg / NXCD, r = nwg % NXCD, xcd = wgid % NXCD, off = wgid / NXCD; wgid = (xcd < r ? xcd * (q + 1) : r * (q + 1) + (xcd - r) * q) + off; }
        const int nig = WGM * nN, gid = wgid / nig, fm = gid * WGM, gsz = (nM - fm) < WGM ? (nM - fm) : WGM;
        u.pm = fm + ((wgid % nig) % gsz); u.pn = (wgid % nig) / gsz; return true;
    }
    __device__ __forceinline__ void a_ready(const Unit&) const {}
    __device__ __forceinline__ void done(const Unit&) const {}
};

__device__ __forceinline__ unsigned cvt_pk_bf16(float lo, float hi) { unsigned r; asm volatile("v_cvt_pk_bf16_f32 %0, %1, %2" : "=v"(r) : "v"(lo), "v"(hi)); return r; }
typedef float f32x2 __attribute__((ext_vector_type(2)));
__device__ __forceinline__ f32x2 gelu_pk(f32x2 v) {
    const f32x2 av = __builtin_elementwise_abs(v), d = av * 0.2316418882f + 1.0f;
    f32x2 t; t.x = __builtin_amdgcn_rcpf(d.x); t.y = __builtin_amdgcn_rcpf(d.y);
    f32x2 q = t * 0.5307027145f + (-0.7265760135f); q = q * t + 0.7107068705f; q = q * t + (-0.142248368f); q = q * t + 0.127414796f; q = q * t;
    const f32x2 s = (v * v) * (-0.72134752044f);
    f32x2 e; e.x = __builtin_amdgcn_exp2f(s.x); e.y = __builtin_amdgcn_exp2f(s.y);
    const f32x2 m = v * (q * e), r = v - m;
    f32x2 o; o.x = v.x < 0.f ? m.x : r.x; o.y = v.y < 0.f ? m.y : r.y; return o;
}

template <int ACT  > struct EpiBf16 {
    static constexpr bool PERM = true, AFTER_DRAIN = false; static_assert(ACT == 0 || ACT == 1, "EpiBf16: ACT is 0 (none) or 1 (gelu_pk)");
    bf16_t* O; int ldc; const float* bias; int split_cols; size_t split_stride; float scale0;
    __device__ __forceinline__ void operator()(const f32x4 (&acc)[2][2][4][2], const Unit& u, int wr, int wc, int fr, int fq) const {
        const int row0 = u.pm * BM + wr * 64 + fr; int colt = u.pn * BM; bf16_t* base = O;
        float sc = 1.f; if (split_cols) { const int t = colt / split_cols; base += (size_t)t * split_stride; colt -= t * split_cols; if (t == 0) sc = scale0; }
        const int col0 = colt + wc * 32 + 8 * fq, bcol0 = u.pn * BM + wc * 32 + 8 * fq;
        f32x4 bv[2][2];
#pragma unroll
        for (int bj = 0; bj < 2; ++bj)
#pragma unroll
            for (int n = 0; n < 2; ++n) bv[bj][n] = bias ? *(const f32x4*)(bias + bcol0 + bj * HALF + 4 * n) : (f32x4){0.f, 0.f, 0.f, 0.f};
#pragma unroll
        for (int ai = 0; ai < 2; ++ai)
#pragma unroll
            for (int m = 0; m < 4; ++m) { bf16_t* rowp = base + (size_t)(row0 + ai * HALF + m * 16) * ldc + col0;
#pragma unroll
                for (int bj = 0; bj < 2; ++bj) { f32x4 v0 = acc[ai][bj][m][0] + bv[bj][0], v1 = acc[ai][bj][m][1] + bv[bj][1];
                    if (ACT == 1) { f32x2 a = gelu_pk((f32x2){v0[0], v0[1]}), b = gelu_pk((f32x2){v0[2], v0[3]}), c = gelu_pk((f32x2){v1[0], v1[1]}), d = gelu_pk((f32x2){v1[2], v1[3]});
                        v0 = (f32x4){a.x, a.y, b.x, b.y}; v1 = (f32x4){c.x, c.y, d.x, d.y}; }
                    v0 = v0 * sc; v1 = v1 * sc; u32x4 w; w.x = cvt_pk_bf16(v0[0], v0[1]); w.y = cvt_pk_bf16(v0[2], v0[3]); w.z = cvt_pk_bf16(v1[0], v1[1]); w.w = cvt_pk_bf16(v1[2], v1[3]);
                    *(u32x4*)(rowp + bj * HALF) = w; } }
    }
};


__device__ __forceinline__ unsigned cvt4_fp8(float a, float b, float c, float d) { int w = 0; w = __builtin_amdgcn_cvt_pk_fp8_f32(a, b, w, false); w = __builtin_amdgcn_cvt_pk_fp8_f32(c, d, w, true); return (unsigned)w; }
__device__ __forceinline__ void row_rstd8(const float* ss, int row0, int fq, float inv_n, float eps, float (&rs)[2][4]) {
#pragma unroll
    for (int ai = 0; ai < 2; ++ai)
#pragma unroll
        for (int m = 0; m < 4; ++m) { const f32x4 v = *(const f32x4*)(ss + (size_t)(row0 + ai * HALF + m * 16) * 16 + 4 * fq); float t = (v[0] + v[1]) + (v[2] + v[3]);
            t += __shfl_xor(t, 16); t += __shfl_xor(t, 32); rs[ai][m] = 1.0f / sqrtf(t * inv_n + eps); }
}
__device__ __forceinline__ float silu_mul(float g, float u) { const float e = __builtin_amdgcn_exp2f(g * -1.4426950408889634f); return g * __builtin_amdgcn_rcpf(1.0f + e) * u; }
template <bool OUT8> struct EpiSwiglu {
    static constexpr bool PERM = true, AFTER_DRAIN = false;
    bf16_t* O; int ldc; const float* ss; float inv_n, eps, ascale;
    __device__ __forceinline__ void operator()(const f32x4 (&acc)[2][2][4][2], const Unit& u, int wr, int wc, int fr, int fq) const {
        const int row0 = u.pm * BM + wr * 64 + fr, col0 = u.pn * HALF + wc * 32 + 8 * fq;
        float rs[2][4]; row_rstd8(ss, row0, fq, inv_n, eps, rs);
#pragma unroll
        for (int ai = 0; ai < 2; ++ai)
#pragma unroll
            for (int m = 0; m < 4; ++m) { const float r = rs[ai][m] * ascale;
                const f32x4 g0 = acc[ai][0][m][0] * r, g1 = acc[ai][0][m][1] * r, u0 = acc[ai][1][m][0] * r, u1 = acc[ai][1][m][1] * r;
                if constexpr (OUT8) { typedef unsigned u32x2v __attribute__((ext_vector_type(2))); u32x2v w;
                    w.x = cvt4_fp8(silu_mul(g0[0], u0[0]), silu_mul(g0[1], u0[1]), silu_mul(g0[2], u0[2]), silu_mul(g0[3], u0[3]));
                    w.y = cvt4_fp8(silu_mul(g1[0], u1[0]), silu_mul(g1[1], u1[1]), silu_mul(g1[2], u1[2]), silu_mul(g1[3], u1[3]));
                    *(u32x2v*)((unsigned char*)O + (size_t)(row0 + ai * HALF + m * 16) * ldc + col0) = w; }
                else { bf16_t* rowp = O + (size_t)(row0 + ai * HALF + m * 16) * ldc + col0;
                u32x4 w; w.x = cvt_pk_bf16(silu_mul(g0[0], u0[0]), silu_mul(g0[1], u0[1])); w.y = cvt_pk_bf16(silu_mul(g0[2], u0[2]), silu_mul(g0[3], u0[3]));
                w.z = cvt_pk_bf16(silu_mul(g1[0], u1[0]), silu_mul(g1[1], u1[1])); w.w = cvt_pk_bf16(silu_mul(g1[2], u1[2]), silu_mul(g1[3], u1[3]));
                *(u32x4*)rowp = w; } }
    }
};
struct EpiBf16Rs {
    static constexpr bool PERM = true, AFTER_DRAIN = false;
    bf16_t* O; int ldc; const float* ss; float inv_n, eps;
    __device__ __forceinline__ void operator()(const f32x4 (&acc)[2][2][4][2], const Unit& u, int wr, int wc, int fr, int fq) const {
        const int row0 = u.pm * BM + wr * 64 + fr, col0 = u.pn * BM + wc * 32 + 8 * fq;
        float rs[2][4]; row_rstd8(ss, row0, fq, inv_n, eps, rs);
#pragma unroll
        for (int ai = 0; ai < 2; ++ai)
#pragma unroll
            for (int m = 0; m < 4; ++m) { bf16_t* rowp = O + (size_t)(row0 + ai * HALF + m * 16) * ldc + col0; const float r = rs[ai][m];
#pragma unroll
                for (int bj = 0; bj < 2; ++bj) { const f32x4 v0 = acc[ai][bj][m][0] * r, v1 = acc[ai][bj][m][1] * r;
                    u32x4 w; w.x = cvt_pk_bf16(v0[0], v0[1]); w.y = cvt_pk_bf16(v0[2], v0[3]); w.z = cvt_pk_bf16(v1[0], v1[1]); w.w = cvt_pk_bf16(v1[2], v1[3]);
                    *(u32x4*)(rowp + bj * HALF) = w; } }
    }
};
template <bool XN8> struct EpiResNorm {
    static constexpr bool PERM = false, AFTER_DRAIN = false;
    const float* base; float* out; int ldc; float scale; const float* gain; bf16_t* xn; float* ss;
    __device__ __forceinline__ void operator()(const f32x4 (&acc)[2][2][4][2], const Unit& u, int wr, int wc, int fr, int fq) const {
        const int row0 = u.pm * BM + wr * 64 + fr, col0 = u.pn * BM + wc * 32 + 4 * fq;
        f32x4 gv[2][2];
#pragma unroll
        for (int bj = 0; bj < 2; ++bj)
#pragma unroll
            for (int n = 0; n < 2; ++n) gv[bj][n] = *(const f32x4*)(gain + col0 + bj * HALF + n * 16);
#pragma unroll
        for (int ai = 0; ai < 2; ++ai) {
            f32x4 pre[4][2][2];
#pragma unroll
            for (int m = 0; m < 4; ++m) { const size_t off = (size_t)(row0 + ai * HALF + m * 16) * ldc + col0;
#pragma unroll
                for (int bj = 0; bj < 2; ++bj)
#pragma unroll
                    for (int n = 0; n < 2; ++n) pre[m][bj][n] = *(const f32x4*)(base + off + bj * HALF + n * 16); }
#pragma unroll
            for (int m = 0; m < 4; ++m) { const int row = row0 + ai * HALF + m * 16; const size_t off = (size_t)row * ldc + col0; float q = 0.f;
#pragma unroll
                for (int bj = 0; bj < 2; ++bj)
#pragma unroll
                    for (int n = 0; n < 2; ++n) { const f32x4 o = pre[m][bj][n] + acc[ai][bj][m][n] * scale; *(f32x4*)(out + off + bj * HALF + n * 16) = o;
                        q += (o[0] * o[0] + o[1] * o[1]) + (o[2] * o[2] + o[3] * o[3]); const f32x4 x = o * gv[bj][n];
                        if constexpr (XN8) *(unsigned*)((unsigned char*)xn + off + bj * HALF + n * 16) = cvt4_fp8(x[0], x[1], x[2], x[3]);
                        else { typedef unsigned u32x2v __attribute__((ext_vector_type(2))); u32x2v w; w.x = cvt_pk_bf16(x[0], x[1]); w.y = cvt_pk_bf16(x[2], x[3]); *(u32x2v*)(xn + off + bj * HALF + n * 16) = w; } }
                q += __shfl_xor(q, 16); q += __shfl_xor(q, 32);
                if (fq == 0) ss[(size_t)row * 16 + u.pn * 4 + wc] = q; }
        }
    }
};
struct EpiRes {
    static constexpr bool PERM = false, AFTER_DRAIN = false;
    const float* base; float* out; int ldc; float scale;
    __device__ __forceinline__ void operator()(const f32x4 (&acc)[2][2][4][2], const Unit& u, int wr, int wc, int fr, int fq) const {
        const int row0 = u.pm * BM + wr * 64 + fr, col0 = u.pn * BM + wc * 32 + 4 * fq;
#pragma unroll
        for (int ai = 0; ai < 2; ++ai)
#pragma unroll
            for (int mp = 0; mp < 4; mp += 2) {
                f32x4 pre[2][2][2];
#pragma unroll
                for (int m = 0; m < 2; ++m) { const size_t off = (size_t)(row0 + ai * HALF + (mp + m) * 16) * ldc + col0;
#pragma unroll
                    for (int bj = 0; bj < 2; ++bj)
#pragma unroll
                        for (int n = 0; n < 2; ++n) pre[m][bj][n] = *(const f32x4*)(base + off + bj * HALF + n * 16); }
#pragma unroll
                for (int m = 0; m < 2; ++m) { const size_t off = (size_t)(row0 + ai * HALF + (mp + m) * 16) * ldc + col0;
#pragma unroll
                    for (int bj = 0; bj < 2; ++bj)
#pragma unroll
                        for (int n = 0; n < 2; ++n) *(f32x4*)(out + off + bj * HALF + n * 16) = pre[m][bj][n] + acc[ai][bj][mp + m][n] * scale; }
            }
    }
};

typedef int i32x4 __attribute__((ext_vector_type(4))); typedef int i32x8 __attribute__((ext_vector_type(8)));
template <class Epi, class Sched, bool ALIGN_EPI = false, bool SP2 = false, bool FP8 = false>
__device__ __forceinline__ void gemm_phase(PG8_LAS unsigned char* lds, const Gemm g, const Sched& S, const Epi& E) {
    const int tid = threadIdx.x, wid = __builtin_amdgcn_readfirstlane(tid >> 6), lane = tid & 63, wr = wid >> 2, wc = wid & 3, fr = lane & 15, fq = lane >> 4;
    const int K = g.K, nt = K / BK;
    unsigned voffA[2], voffB[2];
#pragma unroll
    for (int i = 0; i < 2; ++i) { int R, C; stage_rc(tid * 16 + i * 8192, R, C); const int Rb = Epi::PERM ? ((R & ~31) + perm32(R & 31)) : R;
        voffA[i] = (unsigned)(R * K + C) * 2u; voffB[i] = (unsigned)(Rb * K + C) * 2u; }
    const size_t kstep = (size_t)(BK * 2);
    const size_t hstep = (size_t)HALF * K * 2;
    const size_t tstep = 2 * hstep;
    const unsigned ldsw = (unsigned)wid * 1024u;
    const int aoff = lds_byte(wr * 64 + fr, fq * 8), boff = lds_byte(wc * 32 + fr, fq * 8);
#define PG8_SA(b, h) (((b) * 2 + (h)) * HTB)
#define PG8_SB(b, h) ((4 + (b) * 2 + (h)) * HTB)
#define PG8_STAGE(bufoff, gbase, voff) do { _Pragma("unroll") for (int _i = 0; _i < 2; ++_i) \
        __builtin_amdgcn_global_load_lds((const unsigned*)((const char*)(gbase) + (voff)[_i]), (PG8_LAS unsigned*)(lds + (bufoff) + ldsw + _i * 8192), 16, 0, 0); } while (0)
#define PG8_LDA(dst, b, h) do { _Pragma("unroll") for (int m = 0; m < 4; ++m) { dst[m].lo = *(const PG8_LAS i32x4*)(lds + PG8_SA(b, h) + aoff + m * 2048); dst[m].hi = *(const PG8_LAS i32x4*)(lds + PG8_SA(b, h) + aoff + m * 2048 + 1024); } } while (0)
#define PG8_LDB(dst, b, h) do { _Pragma("unroll") for (int n = 0; n < 2; ++n) { dst[n].lo = *(const PG8_LAS i32x4*)(lds + PG8_SB(b, h) + boff + n * 2048); dst[n].hi = *(const PG8_LAS i32x4*)(lds + PG8_SB(b, h) + boff + n * 2048 + 1024); } } while (0)
#define PG8_H(x, k) __builtin_bit_cast(bf16x8, (k) == 0 ? (x).lo : (x).hi)
#define PG8_MMA(ai, bj, At, Bt) do { __builtin_amdgcn_s_setprio(1); \
        if constexpr (FP8) { _Pragma("unroll") for (int m = 0; m < 4; ++m) _Pragma("unroll") for (int n = 0; n < 2; ++n) \
            asm volatile("v_mfma_scale_f32_16x16x128_f8f6f4 %0, %1, %2, %0, %3, %3 op_sel_hi:[0,0,0]" : "+v"(acc[ai][bj][m][n]) : "v"(Bt[n]), "v"(At[m]), "v"(sc8)); } \
        else { _Pragma("unroll") for (int m = 0; m < 4; ++m) _Pragma("unroll") for (int n = 0; n < 2; ++n) _Pragma("unroll") for (int k = 0; k < 2; ++k) \
            acc[ai][bj][m][n] = __builtin_amdgcn_mfma_f32_16x16x32_bf16(PG8_H(Bt[n], k), PG8_H(At[m], k), acc[ai][bj][m][n], 0, 0, 0); } \
        __builtin_amdgcn_s_setprio(0); } while (0)
#define PG8_WAIT_V(n) asm volatile("s_waitcnt vmcnt(" #n ")" ::: "memory")
#define PG8_WAIT_L(n) asm volatile("s_waitcnt lgkmcnt(" #n ")" ::: "memory")
#define PG8_BAR __builtin_amdgcn_s_barrier()
#define PG8_SCHED __builtin_amdgcn_sched_barrier(0)
    Unit cur, nxt; int ui = 0;
    if (!S.next(0, cur)) return;
    f32x4 acc[2][2][4][2];
#pragma unroll
    for (int a = 0; a < 2; ++a)
#pragma unroll
        for (int b = 0; b < 2; ++b)
#pragma unroll
            for (int m = 0; m < 4; ++m)
#pragma unroll
                for (int n = 0; n < 2; ++n) acc[a][b][m][n] = (f32x4){0.f, 0.f, 0.f, 0.f};
    i32x8 At[4], B0[2], B1[2]; int sc8 = 0x7f7f7f7f; asm volatile("" : "+v"(sc8));
    const char* cA = (const char*)g.A + (size_t)cur.pm * tstep; const char* cB = (const char*)g.Bt + (size_t)cur.pn * tstep;
    S.a_ready(cur);
    if constexpr (SP2) {
        PG8_STAGE(PG8_SB(0, 0), cB, voffB); PG8_STAGE(PG8_SB(0, 1), cB + hstep, voffB); PG8_STAGE(PG8_SA(0, 0), cA, voffA); PG8_STAGE(PG8_SA(0, 1), cA + hstep, voffA);
        if (wr == 1) PG8_BAR;
        PG8_WAIT_V(2); PG8_BAR;
        PG8_STAGE(PG8_SB(1, 0), cB + kstep, voffB); PG8_STAGE(PG8_SA(1, 0), cA + kstep, voffA); PG8_STAGE(PG8_SB(1, 1), cB + hstep + kstep, voffB);
        PG8_WAIT_V(6); PG8_BAR;
    } else {
        PG8_STAGE(PG8_SB(0, 0), cB, voffB); PG8_STAGE(PG8_SA(0, 0), cA, voffA); PG8_STAGE(PG8_SB(0, 1), cB + hstep, voffB); PG8_STAGE(PG8_SA(0, 1), cA + hstep, voffA);
        if (wr == 1) PG8_BAR;
        PG8_WAIT_V(4); PG8_BAR;
        PG8_STAGE(PG8_SB(1, 0), cB + kstep, voffB); PG8_STAGE(PG8_SA(1, 0), cA + kstep, voffA); PG8_STAGE(PG8_SB(1, 1), cB + hstep + kstep, voffB);
        PG8_WAIT_V(6); PG8_BAR;
    }
    for (;;) {
        const bool has_next = S.next(ui + 1, nxt);
        const char* nA = has_next ? (const char*)g.A + (size_t)nxt.pm * tstep : cA; const char* nB = has_next ? (const char*)g.Bt + (size_t)nxt.pn * tstep : cB;
#pragma unroll 1
        for (int t = 0; t < nt; t += 2) {
            const bool last = (t == nt - 2);
            const char* a1 = cA + (size_t)(t + 1) * kstep;
            const char* a2 = last ? nA : cA + (size_t)(t + 2) * kstep; const char* b2 = last ? nB : cB + (size_t)(t + 2) * kstep;
            const char* a3 = a2 + kstep; const char* b3 = b2 + kstep;
            if (last && has_next) S.a_ready(nxt);
            if constexpr (SP2) {
            PG8_LDB(B0, 0, 0); PG8_LDB(B1, 0, 1); PG8_SCHED; PG8_LDA(At, 0, 0); PG8_STAGE(PG8_SA(1, 1), a1 + hstep, voffA);
            PG8_WAIT_V(8); PG8_WAIT_L(0); PG8_BAR; PG8_MMA(0, 0, At, B0); PG8_MMA(0, 1, At, B1); PG8_BAR; PG8_SCHED;
            PG8_LDA(At, 0, 1); PG8_STAGE(PG8_SB(0, 0), b2, voffB); PG8_STAGE(PG8_SB(0, 1), b2 + hstep, voffB); PG8_STAGE(PG8_SA(0, 0), a2, voffA);
            PG8_WAIT_V(8); PG8_WAIT_L(0); PG8_BAR; PG8_MMA(1, 0, At, B0); PG8_MMA(1, 1, At, B1); PG8_BAR; PG8_SCHED;
            PG8_LDB(B0, 1, 0); PG8_LDB(B1, 1, 1); PG8_SCHED; PG8_LDA(At, 1, 0); PG8_STAGE(PG8_SA(0, 1), a2 + hstep, voffA);
            PG8_WAIT_V(8); PG8_WAIT_L(0); PG8_BAR; PG8_MMA(0, 0, At, B0); PG8_MMA(0, 1, At, B1); PG8_BAR; PG8_SCHED;
            PG8_LDA(At, 1, 1); PG8_STAGE(PG8_SB(1, 0), b3, voffB); PG8_STAGE(PG8_SB(1, 1), b3 + hstep, voffB); PG8_STAGE(PG8_SA(1, 0), a3, voffA);
            PG8_WAIT_V(8); PG8_WAIT_L(0); PG8_BAR; PG8_MMA(1, 0, At, B0); PG8_MMA(1, 1, At, B1); PG8_BAR; PG8_SCHED;
            } else {
            PG8_LDB(B0, 0, 0); PG8_SCHED; PG8_LDA(At, 0, 0); PG8_STAGE(PG8_SA(1, 1), a1 + hstep, voffA);
            PG8_WAIT_L(8); PG8_BAR; PG8_WAIT_L(0); PG8_MMA(0, 0, At, B0); PG8_BAR; PG8_SCHED;
            PG8_LDB(B1, 0, 1); PG8_STAGE(PG8_SB(0, 0), b2, voffB);
            PG8_BAR; PG8_WAIT_L(0); PG8_MMA(0, 1, At, B1); PG8_BAR;
            PG8_LDA(At, 0, 1); PG8_STAGE(PG8_SA(0, 0), a2, voffA);
            PG8_BAR; PG8_WAIT_L(0); PG8_MMA(1, 0, At, B0); PG8_BAR; PG8_SCHED;
            PG8_STAGE(PG8_SB(0, 1), b2 + hstep, voffB);
            PG8_WAIT_V(6); PG8_BAR; PG8_MMA(1, 1, At, B1); PG8_BAR;
            PG8_LDB(B0, 1, 0); PG8_SCHED; PG8_LDA(At, 1, 0); PG8_STAGE(PG8_SA(0, 1), a2 + hstep, voffA);
            PG8_WAIT_L(8); PG8_BAR; PG8_WAIT_L(0); PG8_MMA(0, 0, At, B0); PG8_BAR; PG8_SCHED;
            PG8_LDB(B1, 1, 1); PG8_STAGE(PG8_SB(1, 0), b3, voffB);
            PG8_BAR; PG8_WAIT_L(0); PG8_MMA(0, 1, At, B1); PG8_BAR;
            PG8_LDA(At, 1, 1); PG8_STAGE(PG8_SA(1, 0), a3, voffA);
            PG8_BAR; PG8_WAIT_L(0); PG8_MMA(1, 0, At, B0); PG8_BAR; PG8_SCHED;
            PG8_STAGE(PG8_SB(1, 1), b3 + hstep, voffB);
            PG8_WAIT_V(6); PG8_BAR; PG8_MMA(1, 1, At, B1); PG8_BAR;
            }
        }
        if constexpr (FP8) asm volatile("s_nop 15\n\ts_nop 15" ::: "memory");
        if constexpr (ALIGN_EPI) { if (wr == 0) PG8_BAR; }
        if constexpr (!Epi::AFTER_DRAIN) { E(acc, cur, wr, wc, fr, fq); S.done(cur); }
        if (!has_next) break;
#pragma unroll
        for (int a = 0; a < 2; ++a)
#pragma unroll
            for (int b = 0; b < 2; ++b)
#pragma unroll
                for (int m = 0; m < 4; ++m)
#pragma unroll
                    for (int n = 0; n < 2; ++n) acc[a][b][m][n] = (f32x4){0.f, 0.f, 0.f, 0.f};
        cur = nxt; cA = nA; cB = nB; ++ui;
        if constexpr (ALIGN_EPI) { if (wr == 1) PG8_BAR; }
    }
    PG8_WAIT_V(0);
    if constexpr (!ALIGN_EPI) { if (wr == 0) PG8_BAR; }
    PG8_BAR;
    if constexpr (Epi::AFTER_DRAIN) { E.fused(acc, cur, wr, wc, fr, fq, lds, wid, lane); S.done(cur); }
#undef PG8_SA
#undef PG8_SB
#undef PG8_STAGE
#undef PG8_LDA
#undef PG8_LDB
#undef PG8_MMA
#undef PG8_H
#undef PG8_WAIT_V
#undef PG8_WAIT_L
#undef PG8_BAR
#undef PG8_SCHED
}
}

#ifndef PG8_SP2
#define PG8_SP2 true
#endif
#ifndef PG8_ALIGN
#define PG8_ALIGN true
#endif

constexpr int NWAVES = 8;
#ifndef MK_N_LAUNCHES
#define MK_N_LAUNCHES 1
#endif
#ifndef REP_MASK
#define REP_MASK 0x2000
#endif
#ifndef FFN1_FP8
#define FFN1_FP8 1
#endif
constexpr int PER_PHASE = 12;
constexpr int N_LAUNCHES = MK_N_LAUNCHES;
static_assert(N_LAUNCHES == 1 || N_LAUNCHES == PER_PHASE, "MK_N_LAUNCHES is 1 or 12");

constexpr int BATCH = 8, SEQ = 2048, D = 1024, M = BATCH * SEQ;
constexpr int FF = 2816, FF2 = 2 * FF;
constexpr int NH = 8, HD = 64, CL = 128, TOPK = 256;
constexpr int NPROJ = 2816;
constexpr int PQ = 0, PQI = 512, PCKV = 1024, PKI = 1152, PWI = 1216, PGB = 1280, PGC = 1792, PXIN = 2304;
constexpr int WIN_N = 2760;
constexpr float EPS = 1e-6f;
constexpr float WSC_GU = 32.f, WSC_DN = 64.f;
constexpr float IDX_SCALE = 0.044194173824159216f;

constexpr size_t MiB = 1u << 20;
constexpr size_t WS_CTL = 0, CTL_ZERO_BYTES = 1 * MiB;
constexpr size_t WS_WUK = 1 * MiB, WS_WUV = 1 * MiB + 256 * 1024;
constexpr size_t WS_WGU1 = 2 * MiB, WS_WD1 = 14 * MiB, WS_WIN = 20 * MiB, WS_WOUT = 26 * MiB, WS_WGU2 = 28 * MiB, WS_WD2 = 40 * MiB;
constexpr size_t WS_XN = 48 * MiB;
constexpr size_t WS_MIX = 80 * MiB;
constexpr size_t WS_KV = 112 * MiB;
constexpr size_t WS_MASK = 116 * MiB;
constexpr size_t WS_SS = 120 * MiB;
constexpr size_t WS_ACT = 128 * MiB;
constexpr size_t WS_END = 216 * MiB;
static_assert(WS_WGU1 + (size_t)FF2 * D * 2 <= WS_WD1 && WS_WD1 + (size_t)D * FF * 2 <= WS_WIN && WS_WIN + (size_t)NPROJ * D * 2 <= WS_WOUT && WS_WOUT + (size_t)D * D * 2 <= WS_WGU2 &&
              WS_WGU2 + (size_t)FF2 * D * 2 <= WS_WD2 && WS_WD2 + (size_t)D * FF * 2 <= WS_XN && WS_ACT + (size_t)M * FF * 2 <= WS_END, "d_ws map");
constexpr int CW_BAR = 4096;

constexpr int RING_OFF = 0, RING_BYTES = 131072;
constexpr int LDSCTL_OFF = RING_BYTES, MISC_OFF = LDSCTL_OFF + 320;
constexpr int LDS_BYTES = 147456;
static_assert(MISC_OFF + 128 <= LDS_BYTES, "LDS map");
#define GAS __attribute__((address_space(1)))
#define LAS __attribute__((address_space(3)))
typedef unsigned short bf16;
typedef unsigned v4u __attribute__((ext_vector_type(4)));
typedef float f32x4 __attribute__((ext_vector_type(4)));
typedef short bf16x8 __attribute__((ext_vector_type(8)));
typedef GAS unsigned gu32;
typedef GAS unsigned long long gu64;
#define RLX_AGENT __ATOMIC_RELAXED, __HIP_MEMORY_SCOPE_AGENT
#define LDS_WAIT() asm volatile("s_waitcnt lgkmcnt(0)" ::: "memory")
#define VM_WAIT() asm volatile("s_waitcnt vmcnt(0)" ::: "memory")
__device__ __forceinline__ unsigned long long rt() { return __builtin_amdgcn_s_memrealtime(); }
__device__ __forceinline__ unsigned f2bf(float f) { unsigned u = __builtin_bit_cast(unsigned, f); return (u + 0x7fffu + ((u >> 16) & 1u)) >> 16; }
__device__ __forceinline__ unsigned pk2(float lo, float hi) { return f2bf(lo) | (f2bf(hi) << 16); }

#define XB_TMO      128
#define XB_XCNT(j)  (256  + 64 * (j))
#define XB_XSUB(j)  (1280 + 64 * (j))
#define XB_XGEN(j)  (2304 + 64 * (j))
#define XB_TOP      3328
#define XB_TOPGEN   3392
#define XCD_BAR_WORDS 3456
#define XB_SPIN_CAP (1u << 18)

__device__ __forceinline__ unsigned xb_ld(unsigned* p)              { return __hip_atomic_load(p, __ATOMIC_RELAXED, __HIP_MEMORY_SCOPE_AGENT); }
__device__ __forceinline__ unsigned xb_add(unsigned* p, unsigned v) { return __hip_atomic_fetch_add(p, v, __ATOMIC_RELAXED, __HIP_MEMORY_SCOPE_AGENT); }
__device__ __forceinline__ unsigned xb_xcc_id() { return (unsigned)__builtin_amdgcn_s_getreg((3 << 11) | 20) & 0xFu; }
#define XB_SPIN(cond, bar) do { unsigned _sp = 0; while (cond) { __builtin_amdgcn_s_sleep(1); \
    if ((++_sp & 255u) == 0u) { if (xb_ld(&(bar)[XB_TMO])) break; if (_sp > XB_SPIN_CAP) { atomicAdd(&(bar)[XB_TMO], 1u); break; } } } } while (0)

struct XcdBarrier {
    unsigned* bar; unsigned x;
    volatile LAS unsigned* st;
};

__device__ __forceinline__ XcdBarrier xcd_barrier_post(unsigned* bar, volatile LAS unsigned* st) {
    XcdBarrier b; b.bar = bar; b.x = xb_xcc_id(); b.st = st;
    if (threadIdx.x == 0) (void)xb_add(&bar[XB_XCNT(b.x)], 1u);
    return b;
}
__device__ __forceinline__ void xcd_barrier_complete(unsigned* bar, unsigned x, unsigned& nloc, unsigned& nx) {
    const unsigned G = gridDim.x * gridDim.y * gridDim.z;
    unsigned sum, cnt, mine, sp = 0u;
    for (;;) {
        sum = 0u; cnt = 0u; mine = 0u;
#pragma unroll
        for (unsigned j = 0; j < 16; ++j) { const unsigned c = xb_ld(&bar[XB_XCNT(j)]); sum += c; cnt += (c > 0u) ? 1u : 0u; mine = (j == x) ? c : mine; }
        if (sum == G) break;
        __builtin_amdgcn_s_sleep(1);
        if ((++sp & 255u) == 0u) { if (xb_ld(&bar[XB_TMO])) break; if (sp > XB_SPIN_CAP) { atomicAdd(&bar[XB_TMO], 1u); break; } }
    }
    nloc = mine > 0u ? mine : 1u; nx = cnt > 0u ? cnt : 1u;
}

__device__ __forceinline__ void xcd_barrier(const XcdBarrier& b) {
    asm volatile("s_waitcnt vmcnt(0)" ::: "memory");
    __syncthreads();
    if (threadIdx.x == 0) {
        unsigned* bar = b.bar;
        __builtin_amdgcn_s_waitcnt(0);
        unsigned nloc = b.st[0], nx = b.st[1];
        if (nloc == 0u) { xcd_barrier_complete(bar, b.x, nloc, nx); b.st[0] = nloc; b.st[1] = nx; }
        const unsigned old = xb_add(&bar[XB_XSUB(b.x)], 1u);
        const unsigned gen = old / nloc;
        if (old + 1u == (gen + 1u) * nloc) {
            __builtin_amdgcn_fence(__ATOMIC_RELEASE, "agent");
            asm volatile("s_waitcnt vmcnt(0)" ::: "memory");
            const unsigned og = xb_add(&bar[XB_TOP], 1u);
            const unsigned tg = og / nx;
            if (og + 1u == (tg + 1u) * nx) xb_add(&bar[XB_TOPGEN], 1u);
            else XB_SPIN(xb_ld(&bar[XB_TOPGEN]) == tg, bar);
            __builtin_amdgcn_fence(__ATOMIC_ACQUIRE, "agent");
            xb_add(&bar[XB_XGEN(b.x)], 1u);
            asm volatile("s_waitcnt vmcnt(0)" ::: "memory");
        } else {
            XB_SPIN(xb_ld(&bar[XB_XGEN(b.x)]) == gen, bar);
            __builtin_amdgcn_fence(__ATOMIC_ACQUIRE, "agent");
            asm volatile("s_waitcnt vmcnt(0)" ::: "memory");
        }
    }
    __syncthreads();
}


struct Frame {
    LAS unsigned char* lds;
    volatile LAS unsigned* MISC;
    gu32* ctl;
    int tid, lane, wave;
    int vcu, G;
    const float* in[20]; float* out;
    bf16 *Wgu1, *Wd1, *Win, *Wout, *Wgu2, *Wd2, *Wuk, *WuvT;
    bf16 *XN, *MIX, *KV, *ACT, *PROJ; unsigned* MASK; float* SS;
};
enum { I_X = 0, I_N1, I_G1, I_U1, I_D1, I_NMIX, I_WIN, I_NKV, I_WUK, I_WUV, I_RELB, I_CONVW, I_NATT, I_NCONV, I_WOUT, I_N2, I_G2, I_U2, I_D2, I_NF };

__device__ __forceinline__ float wave_sum(float v) {
#pragma unroll
    for (int o = 1; o < 64; o <<= 1) v += __shfl_xor(v, o);
    return v;
}
__device__ __forceinline__ float wave_max(float v) {
#pragma unroll
    for (int o = 1; o < 64; o <<= 1) v = fmaxf(v, __shfl_xor(v, o));
    return v;
}
__device__ __forceinline__ float bflo(unsigned w) { return __uint_as_float(w << 16); }
__device__ __forceinline__ float bfhi(unsigned w) { return __uint_as_float(w & 0xffff0000u); }

struct Src { const float* W; int N; int col; };
struct MapPlain { const float* W; int N; __device__ __forceinline__ Src operator()(int d) const { return Src{W, N, d}; } };
struct MapGU { const float* W; __device__ __forceinline__ Src operator()(int d) const { return Src{W, FF, (d >> 8) * 128 + (d & 127)}; } };
struct MapWin { const float* W; __device__ __forceinline__ Src operator()(int d) const { int c;
    if (d < 512) c = d;
    else if (d < 1024) c = 640 + (d - 512);
    else if (d < 1152) c = 512 + (d - 1024);
    else if (d < 1224) c = d;
    else if (d < 1280) c = -1;
    else if (d < 1792) c = 1224 + (d - 1280);
    else if (d < 2304) c = 1736 + (d - 1792);
    else c = 2248 + (d - 2304);
    return Src{W, WIN_N, c}; } };
template <class MAP>
__device__ __forceinline__ void p0_transpose_item(const MAP& map, int K, int ndg, bf16* WT, LAS float* scr, int item, int lane) {
    const int kb = item / ndg, dg = item % ndg, k0 = 64 * kb, d0 = 32 * dg;
    const Src src = map(d0 + (lane & 31)); const int sc = src.col; const float* wp = src.W + (size_t)(k0 + (lane >> 5)) * src.N + (sc >= 0 ? sc : 0);
#pragma unroll 8
    for (int i = 0; i < 32; ++i) { const int kk = 2 * i + (lane >> 5); scr[kk * 33 + (lane & 31)] = sc >= 0 ? wp[(size_t)(2 * i) * src.N] : 0.f; }
    LDS_WAIT(); asm volatile("" ::: "memory");
    const int c = lane & 7;
#pragma unroll
    for (int j = 0; j < 4; ++j) { const int n = (lane >> 3) + 8 * j; const LAS float* s = scr + (8 * c) * 33 + n;
        v4u o; o.x = pk2(s[0 * 33], s[1 * 33]); o.y = pk2(s[2 * 33], s[3 * 33]); o.z = pk2(s[4 * 33], s[5 * 33]); o.w = pk2(s[6 * 33], s[7 * 33]);
        *(GAS v4u*)(WT + (size_t)(d0 + n) * K + k0 + 8 * c) = o; }
    LDS_WAIT(); asm volatile("" ::: "memory");
}
template <class MAP>
__device__ __forceinline__ void p0_transpose_item8(const MAP& map, int K, int ndg, unsigned char* WT, LAS float* scr, int item, int lane, float wscale) {
    const int kb = item / ndg, dg = item % ndg, k0 = 64 * kb, d0 = 32 * dg;
    const Src src = map(d0 + (lane & 31)); const int sc = src.col; const float* wp = src.W + (size_t)(k0 + (lane >> 5)) * src.N + (sc >= 0 ? sc : 0);
#pragma unroll 8
    for (int i = 0; i < 32; ++i) { const int kk = 2 * i + (lane >> 5); scr[kk * 33 + (lane & 31)] = sc >= 0 ? wp[(size_t)(2 * i) * src.N] * wscale : 0.f; }
    LDS_WAIT(); asm volatile("" ::: "memory");
    const int c = lane & 7;
#pragma unroll
    for (int j = 0; j < 4; ++j) { const int n = (lane >> 3) + 8 * j; const LAS float* s = scr + (8 * c) * 33 + n;
        typedef unsigned u32x2v __attribute__((ext_vector_type(2))); u32x2v o; o.x = pg8::cvt4_fp8(s[0 * 33], s[1 * 33], s[2 * 33], s[3 * 33]); o.y = pg8::cvt4_fp8(s[4 * 33], s[5 * 33], s[6 * 33], s[7 * 33]);
        *(GAS u32x2v*)(WT + (size_t)(d0 + n) * K + k0 + 8 * c) = o; }
    LDS_WAIT(); asm volatile("" ::: "memory");
}
__device__ __forceinline__ void rms_row_to_bf16(int lane, const float* xrow, const float* gain, bf16* orow) {
    const GAS f32x4* xr = (const GAS f32x4*)xrow + lane; const GAS f32x4* gr = (const GAS f32x4*)gain + lane;
    f32x4 v[4]; float s = 0.f;
#pragma unroll
    for (int j = 0; j < 4; ++j) { v[j] = xr[64 * j]; s += (v[j].x * v[j].x + v[j].y * v[j].y) + (v[j].z * v[j].z + v[j].w * v[j].w); }
    const float rstd = 1.f / sqrtf(wave_sum(s) * (1.f / D) + EPS);
    GAS unsigned long long* o8 = (GAS unsigned long long*)orow + lane;
#pragma unroll
    for (int j = 0; j < 4; ++j) { const f32x4 g = gr[64 * j]; o8[64 * j] = (unsigned long long)pk2(v[j].x * rstd * g.x, v[j].y * rstd * g.y) | ((unsigned long long)pk2(v[j].z * rstd * g.z, v[j].w * rstd * g.w) << 32); }
}
template <bool OUT8> __device__ __forceinline__ void gain_row_to_bf16(int lane, const float* xrow, const float* gain, bf16* orow, float* ssrow) {
    const GAS f32x4* xr = (const GAS f32x4*)xrow + lane; const GAS f32x4* gr = (const GAS f32x4*)gain + lane;
    f32x4 v[4]; float s = 0.f;
#pragma unroll
    for (int j = 0; j < 4; ++j) { v[j] = xr[64 * j]; s += (v[j].x * v[j].x + v[j].y * v[j].y) + (v[j].z * v[j].z + v[j].w * v[j].w); }
    s = wave_sum(s);
    if constexpr (OUT8) { GAS unsigned* o4 = (GAS unsigned*)orow + lane;
#pragma unroll
        for (int j = 0; j < 4; ++j) { const f32x4 g = gr[64 * j]; o4[64 * j] = pg8::cvt4_fp8(v[j].x * g.x, v[j].y * g.y, v[j].z * g.z, v[j].w * g.w); } }
    else { GAS unsigned long long* o8 = (GAS unsigned long long*)orow + lane;
#pragma unroll
        for (int j = 0; j < 4; ++j) { const f32x4 g = gr[64 * j]; o8[64 * j] = (unsigned long long)pk2(v[j].x * g.x, v[j].y * g.y) | ((unsigned long long)pk2(v[j].z * g.z, v[j].w * g.w) << 32); } }
    if (lane < 16) ((GAS float*)ssrow)[lane] = lane == 0 ? s : 0.f;
}
__device__ __forceinline__ void rms_row_to_f32(int lane, const float* xrow, const float* gain, float* orow, bool poison) {
    const GAS f32x4* xr = (const GAS f32x4*)xrow + lane; const GAS f32x4* gr = (const GAS f32x4*)gain + lane;
    f32x4 v[4]; float s = 0.f;
#pragma unroll
    for (int j = 0; j < 4; ++j) { v[j] = xr[64 * j]; s += (v[j].x * v[j].x + v[j].y * v[j].y) + (v[j].z * v[j].z + v[j].w * v[j].w); }
    float rstd = 1.f / sqrtf(wave_sum(s) * (1.f / D) + EPS); if (poison) rstd = __builtin_nanf("");
    GAS f32x4* o = (GAS f32x4*)orow + lane;
#pragma unroll
    for (int j = 0; j < 4; ++j) { const f32x4 g = gr[64 * j]; o[64 * j] = v[j] * rstd * g; }
}
__device__ __forceinline__ void p0_prologue(Frame& F) {
    LAS float* scr = (LAS float*)(F.lds + RING_OFF + F.wave * 16384);
    const int gw = F.vcu * NWAVES + F.wave, NGW = F.G * NWAVES;
    constexpr int I_GU = (D / 64) * (FF2 / 32), I_DN = (FF / 64) * (D / 32), I_IN = (D / 64) * (NPROJ / 32), I_OUT = (D / 64) * (D / 32);
    constexpr int NITEMS = 2 * I_GU + 2 * I_DN + I_IN + I_OUT;
    for (int it = gw; it < NITEMS; it += NGW) {
        int r = it;
        if (r < I_GU) { const float* wsrc = (((r % (FF2 / 32)) & 7) < 4) ? F.in[I_G1] : F.in[I_U1];
            if (FFN1_FP8) p0_transpose_item8(MapGU{wsrc}, D, FF2 / 32, (unsigned char*)F.Wgu1, scr, r, F.lane, WSC_GU); else p0_transpose_item(MapGU{wsrc}, D, FF2 / 32, F.Wgu1, scr, r, F.lane); continue; } r -= I_GU;
        if (r < I_GU) { if (((r % (FF2 / 32)) & 7) < 4) p0_transpose_item8(MapGU{F.in[I_G2]}, D, FF2 / 32, (unsigned char*)F.Wgu2, scr, r, F.lane, WSC_GU); else p0_transpose_item8(MapGU{F.in[I_U2]}, D, FF2 / 32, (unsigned char*)F.Wgu2, scr, r, F.lane, WSC_GU); continue; } r -= I_GU;
        if (r < I_DN) { if (FFN1_FP8) p0_transpose_item8(MapPlain{F.in[I_D1], D}, FF, D / 32, (unsigned char*)F.Wd1, scr, r, F.lane, WSC_DN); else p0_transpose_item(MapPlain{F.in[I_D1], D}, FF, D / 32, F.Wd1, scr, r, F.lane); continue; } r -= I_DN;
        if (r < I_DN) { p0_transpose_item8(MapPlain{F.in[I_D2], D}, FF, D / 32, (unsigned char*)F.Wd2, scr, r, F.lane, WSC_DN); continue; } r -= I_DN;
        if (r < I_IN) { p0_transpose_item(MapWin{F.in[I_WIN]}, D, NPROJ / 32, F.Win, scr, r, F.lane); continue; } r -= I_IN;
        p0_transpose_item(MapPlain{F.in[I_WOUT], D}, D, D / 32, F.Wout, scr, r, F.lane);
    }
    for (int i = F.vcu * NWAVES * 64 + F.tid; i < CL * NH * HD; i += F.G * NWAVES * 64) {
        F.Wuk[i] = (bf16)f2bf(F.in[I_WUK][i]); const int h = i >> 13, d = (i >> 7) & 63, c = i & 127; F.WuvT[i] = (bf16)f2bf(F.in[I_WUV][((size_t)c * NH + h) * HD + d]); }
    for (int m = gw; m < M; m += NGW) gain_row_to_bf16<FFN1_FP8 != 0>(F.lane, F.in[I_X] + (size_t)m * D, F.in[I_N1], FFN1_FP8 ? (bf16*)((unsigned char*)F.XN + (size_t)m * D) : F.XN + (size_t)m * D, F.SS + (size_t)m * 16);
}
__device__ __forceinline__ void norm_phase(Frame& F, const float* src, const float* gain) {
    const int gw = F.vcu * NWAVES + F.wave, NGW = F.G * NWAVES;
    for (int m = gw; m < M; m += NGW) rms_row_to_bf16(F.lane, src + (size_t)m * D, gain, F.XN + (size_t)m * D);
}

__device__ __forceinline__ void ld8bf(const bf16* p, float (&f)[8]) { const v4u w = *(const GAS v4u*)p; f[0] = bflo(w.x); f[1] = bfhi(w.x); f[2] = bflo(w.y); f[3] = bfhi(w.y); f[4] = bflo(w.z); f[5] = bfhi(w.z); f[6] = bflo(w.w); f[7] = bfhi(w.w); }
__device__ __forceinline__ void prep_phase(Frame& F) {
    const int gw = F.vcu * NWAVES + F.wave, NGW = F.G * NWAVES, lane = F.lane;
    const float* cw = F.in[I_CONVW];
    for (int m = gw; m < M; m += NGW) {
        const bf16* prow = F.PROJ + (size_t)m * NPROJ; const int t = m & (SEQ - 1);
        {
            const unsigned w = *(const GAS unsigned*)(prow + PCKV + 2 * lane); const float a = bflo(w), b = bfhi(w);
            const float rstd = 1.f / sqrtf(wave_sum(a * a + b * b) * (1.f / CL) + EPS);
            const float g0 = F.in[I_NKV][2 * lane], g1 = F.in[I_NKV][2 * lane + 1];
            *(GAS unsigned*)(F.KV + (size_t)m * CL + 2 * lane) = pk2(a * rstd * g0, b * rstd * g1);
        }
        {
            const int c0 = 8 * lane; float gb[8], gc[8], xi[8], y[8];
            ld8bf(prow + PGB + c0, gb); ld8bf(prow + PGC + c0, gc); ld8bf(prow + PXIN + c0, xi);
#pragma unroll
            for (int e = 0; e < 8; ++e) y[e] = cw[2 * 512 + c0 + e] * (gc[e] * xi[e]);
            if (t >= 1) { ld8bf(prow - NPROJ + PGC + c0, gc); ld8bf(prow - NPROJ + PXIN + c0, xi);
#pragma unroll
                for (int e = 0; e < 8; ++e) y[e] += cw[1 * 512 + c0 + e] * (gc[e] * xi[e]); }
            if (t >= 2) { ld8bf(prow - 2 * NPROJ + PGC + c0, gc); ld8bf(prow - 2 * NPROJ + PXIN + c0, xi);
#pragma unroll
                for (int e = 0; e < 8; ++e) y[e] += cw[0 * 512 + c0 + e] * (gc[e] * xi[e]); }
            float ss = 0.f;
#pragma unroll
            for (int e = 0; e < 8; ++e) { y[e] *= gb[e]; ss += y[e] * y[e]; }
            const float rstd = 1.f / sqrtf(wave_sum(ss) * (1.f / 512.f) + EPS);
            const float* g = F.in[I_NCONV] + c0;
            v4u o; o.x = pk2(y[0] * rstd * g[0], y[1] * rstd * g[1]); o.y = pk2(y[2] * rstd * g[2], y[3] * rstd * g[3]); o.z = pk2(y[4] * rstd * g[4], y[5] * rstd * g[5]); o.w = pk2(y[6] * rstd * g[6], y[7] * rstd * g[7]);
            *(GAS v4u*)(F.MIX + (size_t)m * D + 512 + c0) = o;
        }
    }
}

__device__ __forceinline__ int wave_sum_i(int v) {
#pragma unroll
    for (int o = 1; o < 64; o <<= 1) v += __shfl_xor(v, o);
    return v;
}
__device__ __forceinline__ int rel_bucket(int d) {
    if (d < 16) return d;
    return 16 + (d >= 19) + (d >= 21) + (d >= 24) + (d >= 27) + (d >= 31) + (d >= 35) + (d >= 40) + (d >= 46) + (d >= 52) + (d >= 59) + (d >= 67) + (d >= 77) + (d >= 87) + (d >= 99) + (d >= 113);
}
__device__ __forceinline__ void naive_attn_query(Frame& F, int m, LAS float* L) {
    const int lane = F.lane, b = m >> 11, t = m & (SEQ - 1);
    LAS float* qi_s = L;
    LAS float* qa_s = L + 512;
    LAS int* sel_s = (LAS int*)(L + 1536);
    LAS unsigned* sc_s = (LAS unsigned*)(L + 1792);
    LAS float* p_s = L + 1792;
    const bf16* prow = F.PROJ + (size_t)m * NPROJ;
    const bf16* pb = F.PROJ + (size_t)(b * SEQ) * NPROJ;
    float f8[8];
    ld8bf(prow + PQI + 8 * lane, f8);
#pragma unroll
    for (int e = 0; e < 8; ++e) qi_s[8 * lane + e] = f8[e];
    float wv[8]; ld8bf(prow + PWI, wv);
#pragma unroll
    for (int h = 0; h < 8; ++h) wv[h] *= IDX_SCALE;
    LDS_WAIT();
    for (int s = lane; s <= t; s += 64) {
        const bf16* kr = pb + (size_t)s * NPROJ + PKI; float dot[8];
#pragma unroll
        for (int h = 0; h < 8; ++h) dot[h] = 0.f;
#pragma unroll 1
        for (int ch = 0; ch < 8; ++ch) { float k[8]; ld8bf(kr + 8 * ch, k);
#pragma unroll
            for (int h = 0; h < 8; ++h)
#pragma unroll
                for (int e = 0; e < 8; ++e) dot[h] += qi_s[h * 64 + ch * 8 + e] * k[e]; }
        float score = 0.f;
#pragma unroll
        for (int h = 0; h < 8; ++h) score += wv[h] * fmaxf(dot[h], 0.f);
        unsigned u = __float_as_uint(score); u = (u & 0x80000000u) ? ~u : (u | 0x80000000u);
        sc_s[s] = u;
    }
    LDS_WAIT();
    int nsel;
    if (t < TOPK) { nsel = t + 1; for (int i = lane; i < nsel; i += 64) sel_s[i] = i; }
    else {
        unsigned T = 0u;
        for (int bit = 31; bit >= 0; --bit) { const unsigned cand = T | (1u << bit); int cnt = 0;
            for (int s = lane; s <= t; s += 64) cnt += (sc_s[s] >= cand) ? 1 : 0;
            cnt = wave_sum_i(cnt); if (cnt >= TOPK) T = cand; }
        int cgt = 0; for (int s = lane; s <= t; s += 64) cgt += (sc_s[s] > T) ? 1 : 0;
        cgt = wave_sum_i(cgt);
        const int need = TOPK - cgt; int base = 0, taken = 0; const unsigned long long lt = (1ull << lane) - 1ull;
        for (int s0 = 0; s0 <= t; s0 += 64) { const int s = s0 + lane; const bool valid = s <= t; const unsigned key = valid ? sc_s[s] : 0u;
            const bool gt = valid && key > T, eq = valid && key == T;
            const unsigned long long eqm = __ballot(eq); const int eqrank = taken + __popcll(eqm & lt);
            const bool selb = gt || (eq && eqrank < need);
            const unsigned long long sm = __ballot(selb); const int pos = base + __popcll(sm & lt);
            if (selb) sel_s[pos] = s;
            base += __popcll(sm); taken += __popcll(eqm); }
        nsel = TOPK;
    }
    ld8bf(prow + PQ + 8 * lane, f8);
#pragma unroll
    for (int e = 0; e < 8; ++e) qi_s[8 * lane + e] = f8[e];
    LDS_WAIT();
    for (int i = 0; i < 16; ++i) { const int o = lane + 64 * i, h = o >> 7, c = o & 127; const GAS f32x4* w = (const GAS f32x4*)(F.in[I_WUK] + ((size_t)c * 8 + h) * 64); float a = 0.f;
#pragma unroll
        for (int d4 = 0; d4 < 16; ++d4) { const f32x4 wv4 = w[d4]; a += qi_s[h * 64 + 4 * d4] * wv4.x + qi_s[h * 64 + 4 * d4 + 1] * wv4.y + qi_s[h * 64 + 4 * d4 + 2] * wv4.z + qi_s[h * 64 + 4 * d4 + 3] * wv4.w; }
        qa_s[o] = a * 0.125f; }
    LDS_WAIT();
    for (int i = 0; i < 4; ++i) { const int kidx = lane + 64 * i; float lg[8];
        if (kidx < nsel) { const int s = sel_s[kidx]; const bf16* kr = F.KV + (size_t)(b * SEQ + s) * CL;
#pragma unroll
            for (int h = 0; h < 8; ++h) lg[h] = 0.f;
#pragma unroll 1
            for (int ch = 0; ch < 16; ++ch) { float k[8]; ld8bf(kr + 8 * ch, k);
#pragma unroll
                for (int h = 0; h < 8; ++h)
#pragma unroll
                    for (int e = 0; e < 8; ++e) lg[h] += qa_s[h * 128 + ch * 8 + e] * k[e]; }
            const float* rb = F.in[I_RELB] + rel_bucket(t - s) * 8;
#pragma unroll
            for (int h = 0; h < 8; ++h) lg[h] += rb[h];
        } else {
#pragma unroll
            for (int h = 0; h < 8; ++h) lg[h] = -INFINITY; }
#pragma unroll
        for (int h = 0; h < 8; ++h) p_s[h * 256 + kidx] = lg[h]; }
    LDS_WAIT();
    for (int h = 0; h < 8; ++h) { float v[4], mx = -INFINITY;
#pragma unroll
        for (int i = 0; i < 4; ++i) { v[i] = p_s[h * 256 + lane + 64 * i]; mx = fmaxf(mx, v[i]); }
        mx = wave_max(mx); float sm = 0.f;
#pragma unroll
        for (int i = 0; i < 4; ++i) { v[i] = __expf(v[i] - mx); sm += v[i]; }
        sm = wave_sum(sm); const float inv = 1.f / sm;
#pragma unroll
        for (int i = 0; i < 4; ++i) p_s[h * 256 + lane + 64 * i] = v[i] * inv; }
    LDS_WAIT();
    float cx[8][2];
#pragma unroll
    for (int h = 0; h < 8; ++h) { cx[h][0] = 0.f; cx[h][1] = 0.f; }
    for (int k = 0; k < nsel; ++k) { const int s = sel_s[k]; const unsigned w = *(const GAS unsigned*)(F.KV + (size_t)(b * SEQ + s) * CL + 2 * lane); const float k0 = bflo(w), k1 = bfhi(w);
#pragma unroll
        for (int h = 0; h < 8; ++h) { const float p = p_s[h * 256 + k]; cx[h][0] += p * k0; cx[h][1] += p * k1; } }
#pragma unroll
    for (int h = 0; h < 8; ++h) { qa_s[h * 128 + 2 * lane] = cx[h][0]; qa_s[h * 128 + 2 * lane + 1] = cx[h][1]; }
    LDS_WAIT();
    float o8[8]; float ss = 0.f;
#pragma unroll
    for (int h = 0; h < 8; ++h) { float a = 0.f; const float* w = F.in[I_WUV] + h * 64 + lane;
        for (int c = 0; c < 128; ++c) a += qa_s[h * 128 + c] * w[(size_t)c * 512];
        o8[h] = a; ss += a * a; }
    const float rstd = 1.f / sqrtf(wave_sum(ss) * (1.f / 512.f) + EPS);
#pragma unroll
    for (int h = 0; h < 8; ++h) F.MIX[(size_t)m * D + h * 64 + lane] = (bf16)f2bf(o8[h] * rstd * F.in[I_NATT][h * 64 + lane]);
    LDS_WAIT();
}
__device__ __forceinline__ void naive_attn_phase(Frame& F) {
    LAS float* L = (LAS float*)(F.lds + RING_OFF + F.wave * 16384);
    const int gw = F.vcu * NWAVES + F.wave, NGW = F.G * NWAVES;
    for (int idx = gw; idx < M; idx += NGW) { const int b = idx >> 11, tt = idx & (SEQ - 1), t = (b & 1) ? (SEQ - 1 - tt) : tt; naive_attn_query(F, b * SEQ + t, L); }
}

namespace idx {
typedef short bf16x8 __attribute__((ext_vector_type(8)));
typedef float f32x16 __attribute__((ext_vector_type(16)));
constexpr int CHUNK_KEYS = 256, CHUNK_BYTES = CHUNK_KEYS * 128;
__device__ __forceinline__ unsigned sortable(float s) { const unsigned u = __float_as_uint(s); return (u & 0x80000000u) ? ~u : (u | 0x80000000u); }
__device__ __forceinline__ int half_sum(int v) {
#pragma unroll
    for (int o = 1; o < 32; o <<= 1) v += __shfl_xor(v, o);
    return v;
}
#define IDX_WL(dst, val, ln) asm volatile("v_writelane_b32 %0, %1, %2" : "+v"(dst) : "s"(val), "i"(ln))
#define IDX_FOR_KB(...) _Pragma("unroll") for (int g_ = 0; g_ < 8; ++g_) { if (8 * g_ <= qb) { _Pragma("unroll") for (int k_ = 0; k_ < 8; ++k_) { const int kb = 8 * g_ + k_; __VA_ARGS__ } } }
__device__ __forceinline__ void idx_unit(Frame& F, int b, int qb, LAS unsigned char* lds) {
    const int tid = F.tid, lane = F.lane, w = F.wave, r32 = lane & 31, hi = lane >> 5;
    const int q0 = 32 * qb; const size_t rowbase = (size_t)b * SEQ;
    const int ri = (r32 & 3) + 4 * (r32 >> 3), hii = (r32 >> 2) & 1;
    const bf16* arow = F.PROJ + (rowbase + q0 + 4 * w + 2 * hii + (ri >> 3)) * NPROJ + PQI + (ri & 7) * 64 + 8 * hi;
    bf16x8 A[4];
#pragma unroll
    for (int s = 0; s < 4; ++s) A[s] = *(const GAS bf16x8*)(arow + 16 * s);
    float wv[2][8];
#pragma unroll
    for (int qq = 0; qq < 2; ++qq) { ld8bf(F.PROJ + (rowbase + q0 + 4 * w + 2 * hi + qq) * NPROJ + PWI, wv[qq]);
#pragma unroll
        for (int h = 0; h < 8; ++h) wv[qq][h] *= IDX_SCALE; }
    const int lim0 = 4 * w + 2 * hi;
    unsigned sc[64][2];
#pragma unroll
    for (int kb = 0; kb < 64; ++kb) { sc[kb][0] = 0u; sc[kb][1] = 0u; }
    const bf16* kptr = F.PROJ + rowbase * NPROJ + PKI + (size_t)(tid >> 3) * NPROJ + (tid & 7) * 8;
    v4u stg[4];
#define IDX_SLOAD(c) do { _Pragma("unroll") for (int i_ = 0; i_ < 4; ++i_) stg[i_] = *(const GAS v4u*)(kptr + (size_t)(64 * i_) * NPROJ); kptr += (size_t)CHUNK_KEYS * NPROJ; asm volatile("" : "+v"(kptr)); } while (0)
#define IDX_SWRITE() do { _Pragma("unroll") for (int i_ = 0; i_ < 4; ++i_) { const int key_ = (tid >> 3) + 64 * i_; *(LAS v4u*)(lds + key_ * 128 + ((((tid & 7) ^ ((key_ >> 1) & 7))) << 4)) = stg[i_]; } } while (0)
    unsigned boff[4];
#pragma unroll
    for (int s = 0; s < 4; ++s) boff[s] = (unsigned)(r32 * 128 + (((2 * s + hi) ^ ((r32 >> 1) & 7)) << 4));
    IDX_SLOAD(0);
#pragma unroll
    for (int ch = 0; ch < 8; ++ch) {
        if (8 * ch <= qb) {
            __syncthreads();
            IDX_SWRITE();
            __syncthreads();
            if (8 * (ch + 1) <= qb) IDX_SLOAD(ch + 1);
#pragma unroll
            for (int k = 0; k < 8; ++k) {
                const int kb = 8 * ch + k;
                if (kb <= qb) {
                    f32x16 acc = {};
#pragma unroll
                    for (int s = 0; s < 4; ++s) { const bf16x8 B = *(const LAS bf16x8*)(lds + boff[s] + k * 4096);
                        acc = __builtin_amdgcn_mfma_f32_32x32x16_bf16(A[s], B, acc, 0, 0, 0); }
                    float s0 = 0.f, s1 = 0.f;
#pragma unroll
                    for (int h = 0; h < 8; ++h) { s0 = fmaf(fmaxf(acc[h], 0.f), wv[0][h], s0); s1 = fmaf(fmaxf(acc[8 + h], 0.f), wv[1][h], s1); }
                    unsigned u0 = sortable(s0), u1 = sortable(s1);
                    if (kb == qb) { if (r32 > lim0) u0 = 0u; if (r32 > lim0 + 1) u1 = 0u; }
                    sc[kb][0] = u0; sc[kb][1] = u1;
                }
            }
        }
    }
    __syncthreads();
    unsigned T0 = 1u, T1 = 1u; bool d0 = true, d1 = true;
    if (qb >= 8) {
        T0 = 0u; T1 = 0u; d0 = false; d1 = false;
        for (int bit = 31; bit >= 0; --bit) {
            const unsigned c0 = T0 | (1u << bit), c1 = T1 | (1u << bit); int cnt = 0;
            IDX_FOR_KB( cnt += (sc[kb][0] >= c0 ? 1 : 0) + (sc[kb][1] >= c1 ? 65536 : 0); )
            cnt = half_sum(cnt);
            const int n0 = cnt & 0xffff, n1 = cnt >> 16;
            if (!d0 && n0 >= TOPK) { T0 = c0; d0 = (n0 == TOPK); }
            if (!d1 && n1 >= TOPK) { T1 = c1; d1 = (n1 == TOPK); }
            if (__all(d0 && d1)) break;
        }
    }
    unsigned mw0 = 0u, mw1 = 0u, mw2 = 0u, mw3 = 0u;
    if (__all(d0 && d1)) {
        IDX_FOR_KB( const unsigned long long m0 = __ballot(sc[kb][0] >= T0), m1 = __ballot(sc[kb][1] >= T1);
            IDX_WL(mw0, (unsigned)m0, kb); IDX_WL(mw2, (unsigned)(m0 >> 32), kb);
            IDX_WL(mw1, (unsigned)m1, kb); IDX_WL(mw3, (unsigned)(m1 >> 32), kb); )
    } else {
        int cg = 0;
        IDX_FOR_KB( cg += (sc[kb][0] > T0 ? 1 : 0) + (sc[kb][1] > T1 ? 65536 : 0); )
        cg = half_sum(cg);
        const int need0 = d0 ? (1 << 20) : TOPK - (cg & 0xffff), need1 = d1 ? (1 << 20) : TOPK - (cg >> 16);
        int taken0 = 0, taken1 = 0; const unsigned lt = (1u << r32) - 1u;
        IDX_FOR_KB( const bool e0 = sc[kb][0] == T0, e1 = sc[kb][1] == T1;
            const unsigned long long em0 = __ballot(e0), em1 = __ballot(e1);
            const unsigned h0 = hi ? (unsigned)(em0 >> 32) : (unsigned)em0, h1 = hi ? (unsigned)(em1 >> 32) : (unsigned)em1;
            const bool s0 = sc[kb][0] > T0 || (e0 && taken0 + __popc(h0 & lt) < need0), s1 = sc[kb][1] > T1 || (e1 && taken1 + __popc(h1 & lt) < need1);
            taken0 += __popc(h0); taken1 += __popc(h1);
            const unsigned long long m0 = __ballot(s0), m1 = __ballot(s1);
            IDX_WL(mw0, (unsigned)m0, kb); IDX_WL(mw2, (unsigned)(m0 >> 32), kb);
            IDX_WL(mw1, (unsigned)m1, kb); IDX_WL(mw3, (unsigned)(m1 >> 32), kb); )
    }
    unsigned* mrow = F.MASK + (rowbase + q0 + 4 * w) * 64 + lane;
    mrow[0] = mw0; mrow[64] = mw1; mrow[128] = mw2; mrow[192] = mw3;
#undef IDX_SLOAD
#undef IDX_SWRITE
}
#undef IDX_FOR_KB
#undef IDX_WL
__device__ __forceinline__ void idx_phase(Frame& F) {
    for (int v2 = 2 * F.vcu; v2 < 512; v2 += 2 * F.G)
        for (int u = 0; u < 2 * (1 + ((REP_MASK >> 5) & 1)); ++u) { const int v = v2 >> 1, b = v >> 5, j = v & 31; idx_unit(F, b, (u & 1) ? j : 63 - j, F.lds + RING_OFF); }
}
}

namespace att {
typedef short bf16x8 __attribute__((ext_vector_type(8)));
typedef short s16x4 __attribute__((ext_vector_type(4)));
typedef float f32x16 __attribute__((ext_vector_type(16)));
typedef unsigned u32x4 __attribute__((ext_vector_type(4)));
typedef float f32x2_t __attribute__((ext_vector_type(2))); typedef __bf16 bf16x2_t __attribute__((ext_vector_type(2)));
constexpr float LOG2E = 1.4426950408889634f;
constexpr int L_K = 0, L_V = 32768, L_TBL = 65536, TBL_N = 320, L_MASK = L_TBL + 8 * TBL_N * 4, MROW = 66, L_RMS = L_MASK + 32 * MROW * 4, L_END = L_RMS + 8 * 32 * 4;
static_assert(L_END <= RING_BYTES, "attention LDS map");
#define ATT_KSWZ(row, colB) ((row) * 256 + ((colB) ^ (((row) & 7) << 4)))
#define ATT_SBAR() __builtin_amdgcn_sched_barrier(0)
__device__ __forceinline__ unsigned cvtpk(float lo, float hi) { f32x2_t v = {lo, hi}; bf16x2_t b = __builtin_convertvector(v, bf16x2_t); return __builtin_bit_cast(unsigned, b); }
__device__ __forceinline__ int v_st(int k, int c) { const int kk = (k & ~0xC) | ((k & 4) << 1) | ((k & 8) >> 1); return ((kk >> 3) * 4 + (c >> 5)) * 512 + ((kk & 7) * 32 + (c & 31)) * 2; }
__device__ __forceinline__ int v_rd_base(int lane) { return ((lane & 3) << 3) | (((lane >> 2) & 3) << 6) | (((lane >> 4) & 1) << 5) | (((lane >> 5) & 1) << 8); }
constexpr int v_rd_off(int d0, int ks, int half) { return d0 * 512 + ks * 4096 + half * 2048; }
template <int OFF> __device__ __forceinline__ s16x4 tr_read(int vb) { s16x4 r; asm volatile("ds_read_b64_tr_b16 %0, %1 offset:%2" : "=&v"(r) : "v"(vb), "i"(OFF) : "memory"); return r; }
template <int D0> __device__ __forceinline__ void pv_one(f32x16& od, int vb, bf16x8 pa0, bf16x8 pa1, bf16x8 pa2, bf16x8 pa3) {
    const s16x4 l0 = tr_read<v_rd_off(D0, 0, 0)>(vb), h0 = tr_read<v_rd_off(D0, 0, 1)>(vb), l1 = tr_read<v_rd_off(D0, 1, 0)>(vb), h1 = tr_read<v_rd_off(D0, 1, 1)>(vb);
    const s16x4 l2 = tr_read<v_rd_off(D0, 2, 0)>(vb), h2 = tr_read<v_rd_off(D0, 2, 1)>(vb), l3 = tr_read<v_rd_off(D0, 3, 0)>(vb), h3 = tr_read<v_rd_off(D0, 3, 1)>(vb);
    asm volatile("s_waitcnt lgkmcnt(0)" ::: "memory"); ATT_SBAR();
#define ATT_PK(L, H) (bf16x8){L[0], L[1], L[2], L[3], H[0], H[1], H[2], H[3]}
    od = __builtin_amdgcn_mfma_f32_32x32x16_bf16(ATT_PK(l0, h0), pa0, od, 0, 0, 0);
    od = __builtin_amdgcn_mfma_f32_32x32x16_bf16(ATT_PK(l1, h1), pa1, od, 0, 0, 0);
    od = __builtin_amdgcn_mfma_f32_32x32x16_bf16(ATT_PK(l2, h2), pa2, od, 0, 0, 0);
    od = __builtin_amdgcn_mfma_f32_32x32x16_bf16(ATT_PK(l3, h3), pa3, od, 0, 0, 0);
#undef ATT_PK
}
__device__ __forceinline__ bf16x8 pack8(const f32x16& x, int s, float sc) {
    u32x4 w = {cvtpk(x[8 * s] * sc, x[8 * s + 1] * sc), cvtpk(x[8 * s + 2] * sc, x[8 * s + 3] * sc), cvtpk(x[8 * s + 4] * sc, x[8 * s + 5] * sc), cvtpk(x[8 * s + 6] * sc, x[8 * s + 7] * sc)};
    return __builtin_bit_cast(bf16x8, w);
}
__device__ __forceinline__ void attn_tables(Frame& F, LAS unsigned char* lds) {
    LAS float* tbl = (LAS float*)(lds + L_TBL);
    for (int i = F.tid; i < 8 * TBL_N; i += NWAVES * 64) { const int h = i / TBL_N, dist = 255 - (i % TBL_N); tbl[i] = dist >= 0 ? F.in[I_RELB][rel_bucket(dist) * 8 + h] * LOG2E : 0.f; }
    __syncthreads();
}
__device__ __forceinline__ void attn_unit(Frame& F, int b, int qb, LAS unsigned char* lds) {
    const int tid = F.tid, lane = F.lane, h = F.wave, r32 = lane & 31, hi = lane >> 5;
    const int q0 = 32 * qb, NT = (qb >> 1) + 1; const size_t rowbase = (size_t)b * SEQ;
    LAS unsigned* msk = (LAS unsigned*)(lds + L_MASK); const LAS float* tbl = (const LAS float*)(lds + L_TBL); LAS float* rms = (LAS float*)(lds + L_RMS);
#pragma unroll
    for (int i = 0; i < 4; ++i) { const int wd = tid + 512 * i; msk[(wd >> 6) * MROW + (wd & 63)] = F.MASK[(rowbase + q0 + (wd >> 6)) * 64 + (wd & 63)]; }
    bf16x8 qr[8];
    {
        bf16x8 Bq[4];
        const bf16* qrow = F.PROJ + (rowbase + q0 + r32) * NPROJ + PQ + h * 64 + 8 * hi;
#pragma unroll
        for (int s = 0; s < 4; ++s) Bq[s] = *(const GAS bf16x8*)(qrow + 16 * s);
        const int ri = (r32 & 3) + 4 * (r32 >> 3), hii = (r32 >> 2) & 1;
#pragma unroll
        for (int cb = 0; cb < 4; ++cb) { const int c = 32 * cb + 16 * (ri >> 3) + 8 * hii + (ri & 7); const bf16* wrow = F.Wuk + ((size_t)c * 8 + h) * 64 + 8 * hi;
            f32x16 acc = {};
#pragma unroll
            for (int s = 0; s < 4; ++s) acc = __builtin_amdgcn_mfma_f32_32x32x16_bf16(*(const GAS bf16x8*)(wrow + 16 * s), Bq[s], acc, 0, 0, 0);
            qr[2 * cb] = pack8(acc, 0, 0.125f * LOG2E); qr[2 * cb + 1] = pack8(acc, 1, 0.125f * LOG2E); }
    }
    const float b31 = F.in[I_RELB][31 * 8 + h] * LOG2E;
    const int sr = tid >> 4, scol = (tid & 15) * 8, vst0 = v_st(sr, scol), vst1 = v_st(32 + sr, scol);
    const int vb0 = (int)(unsigned)(uintptr_t)(lds + L_V) + v_rd_base(lane);
    const bf16* kvb = F.KV + rowbase * CL + (size_t)sr * CL + scol;
    v4u st0, st1;
#define ATT_SLOAD(k0) do { st0 = *(const GAS v4u*)(kvb + (size_t)(k0) * CL); st1 = *(const GAS v4u*)(kvb + (size_t)((k0) + 32) * CL); } while (0)
#define ATT_SWRITE(bf) do { *(LAS v4u*)(lds + L_V + (bf) * 16384 + vst0) = st0; *(LAS v4u*)(lds + L_V + (bf) * 16384 + vst1) = st1; \
        *(LAS v4u*)(lds + L_K + (bf) * 16384 + ATT_KSWZ(sr, scol * 2)) = st0; *(LAS v4u*)(lds + L_K + (bf) * 16384 + ATT_KSWZ(32 + sr, scol * 2)) = st1; } while (0)
    float m_run = -INFINITY, l_run = 0.f; f32x16 o[4] = {};
    ATT_SLOAD(0); ATT_SWRITE(0); __syncthreads();
    for (int j = 0; j < NT; ++j) {
        const int buf = j & 1, k0 = 64 * j;
        if (j + 1 < NT) ATT_SLOAD(k0 + 64);
        f32x16 p0 = {}, p1 = {};
        { const LAS unsigned char* Ks = lds + L_K + buf * 16384;
#pragma unroll
          for (int d0 = 0; d0 < 8; ++d0) { const int cbyte = (d0 * 16 + hi * 8) * 2;
              const bf16x8 k0f = *(const LAS bf16x8*)(Ks + ATT_KSWZ(r32, cbyte)), k1f = *(const LAS bf16x8*)(Ks + ATT_KSWZ(32 + r32, cbyte));
              p0 = __builtin_amdgcn_mfma_f32_32x32x16_bf16(k0f, qr[d0], p0, 0, 0, 0); p1 = __builtin_amdgcn_mfma_f32_32x32x16_bf16(k1f, qr[d0], p1, 0, 0, 0); } }
        const unsigned long long mwd = *(const LAS unsigned long long*)(msk + r32 * MROW + 2 * j);
        const unsigned w0 = (unsigned)mwd >> (4 * hi), w1 = (unsigned)(mwd >> 32) >> (4 * hi);
        const bool far = (k0 + 176 <= q0);
        if (!far) { const LAS float* tb = tbl + h * TBL_N + (255 - (q0 + r32) + k0 + 4 * hi);
#pragma unroll
            for (int r = 0; r < 16; ++r) { p0[r] += tb[(r & 3) + 8 * (r >> 2)]; p1[r] += tb[32 + (r & 3) + 8 * (r >> 2)]; } }
        float rm = fmaxf(p0[0], p1[0]);
#pragma unroll
        for (int r = 1; r < 16; ++r) rm = fmaxf(rm, fmaxf(p0[r], p1[r]));
        { auto rr = __builtin_amdgcn_permlane32_swap(__float_as_uint(rm), __float_as_uint(rm), false, false); rm = fmaxf(__uint_as_float(rr[0]), __uint_as_float(rr[1])); }
        const float boff = far ? b31 : 0.f, mnew = fmaxf(m_run, rm + boff), alpha = __builtin_amdgcn_exp2f(m_run - mnew), off = mnew - boff;
        m_run = mnew;
        float ps = 0.f;
#pragma unroll
        for (int r = 0; r < 16; ++r) { const int pos = (r & 3) + 8 * (r >> 2);
            const unsigned e0 = __float_as_uint(__builtin_amdgcn_exp2f(p0[r] - off)) & (unsigned)(((int)(w0 << (31 - pos))) >> 31);
            const unsigned e1 = __float_as_uint(__builtin_amdgcn_exp2f(p1[r] - off)) & (unsigned)(((int)(w1 << (31 - pos))) >> 31);
            p0[r] = __uint_as_float(e0); p1[r] = __uint_as_float(e1); ps += p0[r] + p1[r]; }
        { auto rr = __builtin_amdgcn_permlane32_swap(__float_as_uint(ps), __float_as_uint(ps), false, false); ps = __uint_as_float(rr[0]) + __uint_as_float(rr[1]); }
        l_run = l_run * alpha + ps;
        if (__any(alpha < 1.f)) {
#pragma unroll
            for (int d = 0; d < 4; ++d)
#pragma unroll
                for (int r = 0; r < 16; ++r) o[d][r] *= alpha; }
        bf16x8 pa0, pa1, pa2, pa3;
#define ATT_PK4(P, BASE, OUT) do { unsigned a0 = cvtpk(P[BASE + 0], P[BASE + 1]), a1 = cvtpk(P[BASE + 2], P[BASE + 3]);   \
        unsigned b0 = cvtpk(P[BASE + 4], P[BASE + 5]), b1 = cvtpk(P[BASE + 6], P[BASE + 7]);                              \
        auto r0 = __builtin_amdgcn_permlane32_swap(a0, b0, false, false); auto r1 = __builtin_amdgcn_permlane32_swap(a1, b1, false, false); \
        u32x4 w_ = {r0[0], r1[0], r0[1], r1[1]}; OUT = __builtin_bit_cast(bf16x8, w_); } while (0)
        ATT_PK4(p0, 0, pa0); ATT_PK4(p0, 8, pa1); ATT_PK4(p1, 0, pa2); ATT_PK4(p1, 8, pa3);
#undef ATT_PK4
        ATT_SBAR();
        { const int vb = vb0 + buf * 16384;
          pv_one<0>(o[0], vb, pa0, pa1, pa2, pa3); pv_one<1>(o[1], vb, pa0, pa1, pa2, pa3); pv_one<2>(o[2], vb, pa0, pa1, pa2, pa3); pv_one<3>(o[3], vb, pa0, pa1, pa2, pa3); }
        if (j + 1 < NT) ATT_SWRITE(buf ^ 1);
        __syncthreads();
    }
    const float inv = 1.f / l_run;
    f32x16 ot[2] = {};
#pragma unroll
    for (int cb = 0; cb < 4; ++cb)
#pragma unroll
        for (int s = 0; s < 2; ++s) { const bf16x8 Bo = pack8(o[cb], s, inv);
#pragma unroll
            for (int db = 0; db < 2; ++db) { const bf16* wp = F.WuvT + ((size_t)(h * 64 + 32 * db + r32)) * CL + 32 * cb + 16 * s + 4 * hi;
                const s16x4 lo = *(const GAS s16x4*)wp, hi4 = *(const GAS s16x4*)(wp + 8);
                ot[db] = __builtin_amdgcn_mfma_f32_32x32x16_bf16((bf16x8){lo[0], lo[1], lo[2], lo[3], hi4[0], hi4[1], hi4[2], hi4[3]}, Bo, ot[db], 0, 0, 0); } }
    float ss = 0.f;
#pragma unroll
    for (int r = 0; r < 16; ++r) ss += ot[0][r] * ot[0][r] + ot[1][r] * ot[1][r];
    { auto rr = __builtin_amdgcn_permlane32_swap(__float_as_uint(ss), __float_as_uint(ss), false, false); ss = __uint_as_float(rr[0]) + __uint_as_float(rr[1]); }
    if (hi == 0) rms[h * 32 + r32] = ss;
    __syncthreads();
    float tot = 0.f;
#pragma unroll
    for (int hh = 0; hh < 8; ++hh) tot += rms[hh * 32 + r32];
    const float rstd = 1.f / sqrtf(tot * (1.f / 512.f) + EPS);
    bf16* orow = F.MIX + (rowbase + q0 + r32) * D + h * 64 + 4 * hi; const float* gn = F.in[I_NATT] + h * 64 + 4 * hi;
#pragma unroll
    for (int db = 0; db < 2; ++db)
#pragma unroll
        for (int g4 = 0; g4 < 4; ++g4) { const int dd = 32 * db + 8 * g4; const f32x4 gv = *(const GAS f32x4*)(gn + dd);
            const unsigned x0 = cvtpk(ot[db][4 * g4] * rstd * gv.x, ot[db][4 * g4 + 1] * rstd * gv.y), x1 = cvtpk(ot[db][4 * g4 + 2] * rstd * gv.z, ot[db][4 * g4 + 3] * rstd * gv.w);
            *(GAS unsigned long long*)(orow + dd) = (unsigned long long)x0 | ((unsigned long long)x1 << 32); }
    __syncthreads();
#undef ATT_SLOAD
#undef ATT_SWRITE
}
__device__ __forceinline__ void attn_phase(Frame& F) {
    attn_tables(F, F.lds + RING_OFF);
    for (int v2 = 2 * F.vcu; v2 < 512; v2 += 2 * F.G)
        for (int u = 0; u < 2 * (1 + ((REP_MASK >> 6) & 1)); ++u) { const int v = v2 >> 1, b = v >> 5, j = v & 31; attn_unit(F, b, (u & 1) ? j : 63 - j, F.lds + RING_OFF); }
}
#undef ATT_KSWZ
#undef ATT_SBAR
}

struct Args { const float* in[20]; float* out; unsigned char* ws; int ph_lo, ph_hi, li, pad; };
__global__ void __launch_bounds__(NWAVES * 64, 2) mk_fwd(Args args) {
    extern __shared__ __attribute__((aligned(16))) unsigned char lds[];
    Frame F;
    F.lds = (LAS unsigned char*)lds;
    F.MISC = (volatile LAS unsigned*)(F.lds + MISC_OFF);
    F.tid = threadIdx.x; F.lane = F.tid & 63; F.wave = __builtin_amdgcn_readfirstlane(F.tid >> 6);
    F.G = gridDim.x; { const int bx = blockIdx.x; F.vcu = (F.G % 8 == 0) ? (bx % 8) * (F.G / 8) + bx / 8 : bx; }
    unsigned char* ws = args.ws;
    F.ctl = (gu32*)(ws + WS_CTL);
#pragma unroll
    for (int i = 0; i < 20; ++i) F.in[i] = args.in[i];
    F.out = args.out;
    F.Wgu1 = (bf16*)(ws + WS_WGU1); F.Wd1 = (bf16*)(ws + WS_WD1); F.Win = (bf16*)(ws + WS_WIN); F.Wout = (bf16*)(ws + WS_WOUT); F.Wgu2 = (bf16*)(ws + WS_WGU2); F.Wd2 = (bf16*)(ws + WS_WD2);
    F.Wuk = (bf16*)(ws + WS_WUK); F.WuvT = (bf16*)(ws + WS_WUV);
    F.XN = (bf16*)(ws + WS_XN); F.MIX = (bf16*)(ws + WS_MIX); F.KV = (bf16*)(ws + WS_KV); F.ACT = (bf16*)(ws + WS_ACT); F.PROJ = (bf16*)(ws + WS_ACT); F.MASK = (unsigned*)(ws + WS_MASK); F.SS = (float*)(ws + WS_SS);
    for (int u = F.tid; u < (LDS_BYTES - LDSCTL_OFF) / 4; u += NWAVES * 64) ((LAS unsigned*)(F.lds + LDSCTL_OFF))[u] = 0u;
    __syncthreads();
    XcdBarrier bar; bar.bar = (unsigned*)(F.ctl + CW_BAR); bar.x = 0; bar.st = nullptr;
    if (N_LAUNCHES != PER_PHASE) bar = xcd_barrier_post((unsigned*)(F.ctl + CW_BAR), F.MISC + 8);

    const int lo = args.ph_lo, hi = args.ph_hi;
#ifndef PH_MASK
#define PH_MASK 0xFFF
#endif
#define IN(k) (((PH_MASK >> (k)) & 1) && lo <= (k) && (k) < hi)
#define SEAM(k) do { if (IN(k) && (k) + 1 < hi) { xcd_barrier(bar); if (REP_MASK & 0x2000) xcd_barrier(bar); } } while (0)

    if (IN(0)) { p0_prologue(F); if (REP_MASK & 1) { VM_WAIT(); __syncthreads(); p0_prologue(F); } SEAM(0); }
    if (IN(1)) { pg8::Gemm g{F.XN, F.Wgu1, M, FF2, FFN1_FP8 ? D / 2 : D}; pg8::StaticOrder S; S.init(M, FF2, F.G, (int)blockIdx.x, 1 + ((REP_MASK >> 1) & 1));
        pg8::EpiSwiglu<FFN1_FP8 != 0> E{F.ACT, FF, F.SS, 1.0f / D, EPS, FFN1_FP8 ? 1.0f / WSC_GU : 1.0f};
        pg8::gemm_phase<pg8::EpiSwiglu<FFN1_FP8 != 0>, pg8::StaticOrder, PG8_ALIGN, PG8_SP2, FFN1_FP8 != 0>(F.lds + RING_OFF, g, S, E); SEAM(1); }
    if (IN(2)) { pg8::Gemm g{F.ACT, F.Wd1, M, D, FFN1_FP8 ? FF / 2 : FF}; pg8::StaticOrder S; S.init(M, D, F.G, (int)blockIdx.x, 1 + ((REP_MASK >> 2) & 1));
        pg8::EpiResNorm<false> E{F.in[I_X], F.out, D, FFN1_FP8 ? 0.5f / WSC_DN : 0.5f, F.in[I_NMIX], F.XN, F.SS};
        pg8::gemm_phase<pg8::EpiResNorm<false>, pg8::StaticOrder, PG8_ALIGN, PG8_SP2, FFN1_FP8 != 0>(F.lds + RING_OFF, g, S, E); SEAM(2); }
    if (IN(4)) { pg8::Gemm g{F.XN, F.Win, M, NPROJ, D}; pg8::StaticOrder S; S.init(M, NPROJ, F.G, (int)blockIdx.x, 1 + ((REP_MASK >> 4) & 1));
        pg8::EpiBf16Rs E{F.PROJ, NPROJ, F.SS, 1.0f / D, EPS};
        pg8::gemm_phase<pg8::EpiBf16Rs, pg8::StaticOrder, PG8_ALIGN, PG8_SP2>(F.lds + RING_OFF, g, S, E); SEAM(4); }
#ifndef USE_NAIVE_ATTN
#define USE_NAIVE_ATTN 0
#endif
    if (IN(5)) { prep_phase(F); if (REP_MASK & 0x1000) prep_phase(F); if (!USE_NAIVE_ATTN) idx::idx_phase(F); SEAM(5); }
    if (IN(6)) { if (USE_NAIVE_ATTN) naive_attn_phase(F); else att::attn_phase(F); SEAM(6); }
    if (IN(7)) { pg8::Gemm g{F.MIX, F.Wout, M, D, D}; pg8::StaticOrder S; S.init(M, D, F.G, (int)blockIdx.x);
        pg8::EpiResNorm<true> E{F.out, F.out, D, 1.0f, F.in[I_N2], F.XN, F.SS};
        pg8::gemm_phase<pg8::EpiResNorm<true>, pg8::StaticOrder, PG8_ALIGN, PG8_SP2>(F.lds + RING_OFF, g, S, E); SEAM(7); }
    if (IN(9)) { pg8::Gemm g{F.XN, F.Wgu2, M, FF2, D / 2}; pg8::StaticOrder S; S.init(M, FF2, F.G, (int)blockIdx.x);
        pg8::EpiSwiglu<true> E{F.ACT, FF, F.SS, 1.0f / D, EPS, 1.0f / WSC_GU};
        pg8::gemm_phase<pg8::EpiSwiglu<true>, pg8::StaticOrder, PG8_ALIGN, PG8_SP2, true>(F.lds + RING_OFF, g, S, E); SEAM(9); }
    if (IN(10)) { pg8::Gemm g{F.ACT, F.Wd2, M, D, FF / 2}; pg8::StaticOrder S; S.init(M, D, F.G, (int)blockIdx.x);
        pg8::EpiRes E{F.out, F.out, D, 0.5f / WSC_DN};
        pg8::gemm_phase<pg8::EpiRes, pg8::StaticOrder, PG8_ALIGN, PG8_SP2, true>(F.lds + RING_OFF, g, S, E); SEAM(10); }
    if (IN(11)) { const bool poison = __hip_atomic_load((gu32*)(F.ctl + CW_BAR + XB_TMO), RLX_AGENT) != 0u;
        const int gw = F.vcu * NWAVES + F.wave, NGW = F.G * NWAVES;
        for (int m = gw; m < M; m += NGW) rms_row_to_f32(F.lane, F.out + (size_t)m * D, F.in[I_NF], F.out + (size_t)m * D, poison); }
#undef IN
#undef SEAM
}

extern "C" void kernel_launch(void* const* d_in, const int* in_sizes, int n_in, void* d_out, int out_size, void* d_ws, size_t ws_size, hipStream_t stream) {
    static int grid = 0;
    if (grid == 0) {
        if (n_in != 20 || in_sizes[0] != M * D || out_size != M * D || ws_size < WS_END) { fprintf(stderr, "kernel_launch: shape mismatch (n_in %d, in0 %d, out %d, ws %zu); nothing launched\n", n_in, n_in > 0 ? in_sizes[0] : -1, out_size, ws_size); grid = -1; return; }
        int dev = 0, cus = 0, per_cu = 0;
        if (hipGetDevice(&dev) != hipSuccess || hipDeviceGetAttribute(&cus, hipDeviceAttributeMultiprocessorCount, dev) != hipSuccess) { fprintf(stderr, "kernel_launch: hipGetDevice / hipDeviceGetAttribute failed\n"); grid = -1; return; }
        if (hipFuncSetAttribute((const void*)mk_fwd, hipFuncAttributeMaxDynamicSharedMemorySize, LDS_BYTES) != hipSuccess) { fprintf(stderr, "kernel_launch: hipFuncSetAttribute failed\n"); grid = -1; return; }
        if (hipOccupancyMaxActiveBlocksPerMultiprocessor(&per_cu, (const void*)mk_fwd, NWAVES * 64, LDS_BYTES) != hipSuccess || per_cu < 1)
            fprintf(stderr, "kernel_launch: note: occupancy query reports %d workgroups per CU\n", per_cu);
        (void)hipGetLastError();
        grid = cus;
    }
    if (grid < 0) return;
    if (hipMemsetAsync((char*)d_ws + WS_CTL, 0, CTL_ZERO_BYTES, stream) != hipSuccess) { fprintf(stderr, "kernel_launch: hipMemsetAsync failed\n"); return; }
    Args a{};
    for (int i = 0; i < 20; ++i) a.in[i] = (const float*)d_in[i];
    a.out = (float*)d_out; a.ws = (unsigned char*)d_ws;
    for (int li = 0; li < N_LAUNCHES; ++li) {
        a.ph_lo = (N_LAUNCHES == PER_PHASE) ? li : 0; a.ph_hi = (N_LAUNCHES == PER_PHASE) ? li + 1 : PER_PHASE; a.li = li;
        hipLaunchKernelGGL(mk_fwd, dim3(grid), dim3(NWAVES * 64), LDS_BYTES, stream, a);
        const hipError_t le = hipPeekAtLastError();
        if (le != hipSuccess) { fprintf(stderr, "kernel_launch: launch %d failed: %s\n", li, hipGetErrorName(le)); break; }
    }
}
```

```cpp
#include <hip/hip_runtime.h>
#include <cstdio>
#include <cstdint>
namespace pg8 {
#define PG8_LAS __attribute__((address_space(3)))
typedef unsigned short bf16_t;
typedef short bf16x8 __attribute__((ext_vector_type(8)));
typedef float f32x4 __attribute__((ext_vector_type(4)));
typedef unsigned u32x4 __attribute__((ext_vector_type(4)));
constexpr int BM = 256, BK = 64, HALF = 128, HTB = HALF * BK * 2  , STAGE_BYTES = 8 * HTB, NXCD = 8, WGM = 8;

__host__ __device__ __forceinline__ int lds_byte(int r, int c) { const int st = (r >> 4) * 2 + (c >> 5), rr = r & 15, cc = c & 31, ob = rr * 64 + cc * 2; return st * 1024 + (ob ^ (((ob >> 9) & 1) << 5)); }
__host__ __device__ __forceinline__ void stage_rc(int b, int& R, int& C) { const int st = b / 1024, sb = b % 1024, swz = sb ^ (((sb >> 9) & 1) << 5); R = (st >> 1) * 16 + swz / 64; C = (st & 1) * 32 + (swz % 64) / 2; }
__host__ __device__ __forceinline__ int perm32(int rho) { const int n = rho >> 4, i = rho & 15; return 8 * (i >> 2) + 4 * n + (i & 3); }

struct Unit { int pm, pn; };
struct Gemm { const bf16_t* A; const bf16_t* Bt; int M, N, K; };

struct StaticOrder {
    int nM, nN, nwg, G, c, rep;
    __host__ __device__ void init(int M, int N, int G_, int c_, int rep_ = 1) { nM = M / BM; nN = N / BM; nwg = nM * nN; G = G_; c = c_; rep = rep_; }
    __host__ __device__ bool next(int i, Unit& u) const {
        const long L = (long)i * G + c; if (L >= (long)nwg * rep) return false;
        int wgid = (int)(L % nwg); { const int q = nwg / NXCD, r = nwg % NXCD, xcd = wgid % NXCD, off = wgid / NXCD; wgid = (xcd < r ? xcd * (q + 1) : r * (q + 1) + (xcd - r) * q) + off; }
        const int nig = WGM * nN, gid = wgid / nig, fm = gid * WGM, gsz = (nM - fm) < WGM ? (nM - fm) : WGM;
        u.pm = fm + ((wgid % nig) % gsz); u.pn = (wgid % nig) / gsz; return true;
    }
    __device__ __forceinline__ void a_ready(const Unit&) const {}
    __device__ __forceinline__ void done(const Unit&) const {}
};

__device__ __forceinline__ unsigned cvt_pk_bf16(float lo, float hi) { unsigned r; asm volatile("v_cvt_pk_bf16_f32 %0, %1, %2" : "=v"(r) : "v"(lo), "v"(hi)); return r; }
typedef float f32x2 __attribute__((ext_vector_type(2)));
__device__ __forceinline__ f32x2 gelu_pk(f32x2 v) {
    const f32x2 av = __builtin_elementwise_abs(v), d = av * 0.2316418882f + 1.0f;
    f32x2 t; t.x = __builtin_amdgcn_rcpf(d.x); t.y = __builtin_amdgcn_rcpf(d.y);
    f32x2 q = t * 0.5307027145f + (-0.7265760135f); q = q * t + 0.7107068705f; q = q * t + (-0.142248368f); q = q * t + 0.127414796f; q = q * t;
    const f32x2 s = (v * v) * (-0.72134752044f);
    f32x2 e; e.x = __builtin_amdgcn_exp2f(s.x); e.y = __builtin_amdgcn_exp2f(s.y);
    const f32x2 m = v * (q * e), r = v - m;
    f32x2 o; o.x = v.x < 0.f ? m.x : r.x; o.y = v.y < 0.f ? m.y : r.y; return o;
}

template <int ACT  > struct EpiBf16 {
    static constexpr bool PERM = true, AFTER_DRAIN = false; static_assert(ACT == 0 || ACT == 1, "EpiBf16: ACT is 0 (none) or 1 (gelu_pk)");
    bf16_t* O; int ldc; const float* bias; int split_cols; size_t split_stride; float scale0;
    __device__ __forceinline__ void operator()(const f32x4 (&acc)[2][2][4][2], const Unit& u, int wr, int wc, int fr, int fq) const {
        const int row0 = u.pm * BM + wr * 64 + fr; int colt = u.pn * BM; bf16_t* base = O;
        float sc = 1.f; if (split_cols) { const int t = colt / split_cols; base += (size_t)t * split_stride; colt -= t * split_cols; if (t == 0) sc = scale0; }
        const int col0 = colt + wc * 32 + 8 * fq, bcol0 = u.pn * BM + wc * 32 + 8 * fq;
        f32x4 bv[2][2];
#pragma unroll
        for (int bj = 0; bj < 2; ++bj)
#pragma unroll
            for (int n = 0; n < 2; ++n) bv[bj][n] = bias ? *(const f32x4*)(bias + bcol0 + bj * HALF + 4 * n) : (f32x4){0.f, 0.f, 0.f, 0.f};
#pragma unroll
        for (int ai = 0; ai < 2; ++ai)
#pragma unroll
            for (int m = 0; m < 4; ++m) { bf16_t* rowp = base + (size_t)(row0 + ai * HALF + m * 16) * ldc + col0;
#pragma unroll
                for (int bj = 0; bj < 2; ++bj) { f32x4 v0 = acc[ai][bj][m][0] + bv[bj][0], v1 = acc[ai][bj][m][1] + bv[bj][1];
                    if (ACT == 1) { f32x2 a = gelu_pk((f32x2){v0[0], v0[1]}), b = gelu_pk((f32x2){v0[2], v0[3]}), c = gelu_pk((f32x2){v1[0], v1[1]}), d = gelu_pk((f32x2){v1[2], v1[3]});
                        v0 = (f32x4){a.x, a.y, b.x, b.y}; v1 = (f32x4){c.x, c.y, d.x, d.y}; }
                    v0 = v0 * sc; v1 = v1 * sc; u32x4 w; w.x = cvt_pk_bf16(v0[0], v0[1]); w.y = cvt_pk_bf16(v0[2], v0[3]); w.z = cvt_pk_bf16(v1[0], v1[1]); w.w = cvt_pk_bf16(v1[2], v1[3]);
                    *(u32x4*)(rowp + bj * HALF) = w; } }
    }
};


__device__ __forceinline__ unsigned cvt4_fp8(float a, float b, float c, float d) { int w = 0; w = __builtin_amdgcn_cvt_pk_fp8_f32(a, b, w, false); w = __builtin_amdgcn_cvt_pk_fp8_f32(c, d, w, true); return (unsigned)w; }
__device__ __forceinline__ void row_rstd8(const float* ss, int row0, int fq, float inv_n, float eps, float (&rs)[2][4]) {
#pragma unroll
    for (int ai = 0; ai < 2; ++ai)
#pragma unroll
        for (int m = 0; m < 4; ++m) { const f32x4 v = *(const f32x4*)(ss + (size_t)(row0 + ai * HALF + m * 16) * 16 + 4 * fq); float t = (v[0] + v[1]) + (v[2] + v[3]);
            t += __shfl_xor(t, 16); t += __shfl_xor(t, 32); rs[ai][m] = 1.0f / sqrtf(t * inv_n + eps); }
}
__device__ __forceinline__ float silu_mul(float g, float u) { const float e = __builtin_amdgcn_exp2f(g * -1.4426950408889634f); return g * __builtin_amdgcn_rcpf(1.0f + e) * u; }
template <bool OUT8> struct EpiSwiglu {
    static constexpr bool PERM = true, AFTER_DRAIN = false;
    bf16_t* O; int ldc; const float* ss; float inv_n, eps, ascale;
    __device__ __forceinline__ void operator()(const f32x4 (&acc)[2][2][4][2], const Unit& u, int wr, int wc, int fr, int fq) const {
        const int row0 = u.pm * BM + wr * 64 + fr, col0 = u.pn * HALF + wc * 32 + 8 * fq;
        float rs[2][4]; row_rstd8(ss, row0, fq, inv_n, eps, rs);
#pragma unroll
        for (int ai = 0; ai < 2; ++ai)
#pragma unroll
            for (int m = 0; m < 4; ++m) { const float r = rs[ai][m] * ascale;
                const f32x4 g0 = acc[ai][0][m][0] * r, g1 = acc[ai][0][m][1] * r, u0 = acc[ai][1][m][0] * r, u1 = acc[ai][1][m][1] * r;
                if constexpr (OUT8) { typedef unsigned u32x2v __attribute__((ext_vector_type(2))); u32x2v w;
                    w.x = cvt4_fp8(silu_mul(g0[0], u0[0]), silu_mul(g0[1], u0[1]), silu_mul(g0[2], u0[2]), silu_mul(g0[3], u0[3]));
                    w.y = cvt4_fp8(silu_mul(g1[0], u1[0]), silu_mul(g1[1], u1[1]), silu_mul(g1[2], u1[2]), silu_mul(g1[3], u1[3]));
                    *(u32x2v*)((unsigned char*)O + (size_t)(row0 + ai * HALF + m * 16) * ldc + col0) = w; }
                else { bf16_t* rowp = O + (size_t)(row0 + ai * HALF + m * 16) * ldc + col0;
                u32x4 w; w.x = cvt_pk_bf16(silu_mul(g0[0], u0[0]), silu_mul(g0[1], u0[1])); w.y = cvt_pk_bf16(silu_mul(g0[2], u0[2]), silu_mul(g0[3], u0[3]));
                w.z = cvt_pk_bf16(silu_mul(g1[0], u1[0]), silu_mul(g1[1], u1[1])); w.w = cvt_pk_bf16(silu_mul(g1[2], u1[2]), silu_mul(g1[3], u1[3]));
                *(u32x4*)rowp = w; } }
    }
};
struct EpiBf16Rs {
    static constexpr bool PERM = true, AFTER_DRAIN = false;
    bf16_t* O; int ldc; const float* ss; float inv_n, eps;
    __device__ __forceinline__ void operator()(const f32x4 (&acc)[2][2][4][2], const Unit& u, int wr, int wc, int fr, int fq) const {
        const int row0 = u.pm * BM + wr * 64 + fr, col0 = u.pn * BM + wc * 32 + 8 * fq;
        float rs[2][4]; row_rstd8(ss, row0, fq, inv_n, eps, rs);
#pragma unroll
        for (int ai = 0; ai < 2; ++ai)
#pragma unroll
            for (int m = 0; m < 4; ++m) { bf16_t* rowp = O + (size_t)(row0 + ai * HALF + m * 16) * ldc + col0; const float r = rs[ai][m];
#pragma unroll
                for (int bj = 0; bj < 2; ++bj) { const f32x4 v0 = acc[ai][bj][m][0] * r, v1 = acc[ai][bj][m][1] * r;
                    u32x4 w; w.x = cvt_pk_bf16(v0[0], v0[1]); w.y = cvt_pk_bf16(v0[2], v0[3]); w.z = cvt_pk_bf16(v1[0], v1[1]); w.w = cvt_pk_bf16(v1[2], v1[3]);
                    *(u32x4*)(rowp + bj * HALF) = w; } }
    }
};
template <bool BASE_BF16, bool OUT8, bool SS> struct EpiRes2 {
    static constexpr bool PERM = false, AFTER_DRAIN = false;
    const void* base; bf16_t* hb; unsigned char* x8; float* ss; int ldc; float scale;
    __device__ __forceinline__ void operator()(const f32x4 (&acc)[2][2][4][2], const Unit& u, int wr, int wc, int fr, int fq) const {
        typedef unsigned u32x2v __attribute__((ext_vector_type(2)));
        const int row0 = u.pm * BM + wr * 64 + fr, col0 = u.pn * BM + wc * 32 + 4 * fq;
#pragma unroll
        for (int ai = 0; ai < 2; ++ai) {
            f32x4 pre[4][2][2];
#pragma unroll
            for (int m = 0; m < 4; ++m) { const size_t off = (size_t)(row0 + ai * HALF + m * 16) * ldc + col0;
#pragma unroll
                for (int bj = 0; bj < 2; ++bj)
#pragma unroll
                    for (int n = 0; n < 2; ++n) {
                        if constexpr (BASE_BF16) { const u32x2v w = *(const u32x2v*)((const bf16_t*)base + off + bj * HALF + n * 16);
                            pre[m][bj][n] = (f32x4){__uint_as_float(w.x << 16), __uint_as_float(w.x & 0xffff0000u), __uint_as_float(w.y << 16), __uint_as_float(w.y & 0xffff0000u)}; }
                        else pre[m][bj][n] = *(const f32x4*)((const float*)base + off + bj * HALF + n * 16); } }
#pragma unroll
            for (int m = 0; m < 4; ++m) { const int row = row0 + ai * HALF + m * 16; const size_t off = (size_t)row * ldc + col0; float q = 0.f;
#pragma unroll
                for (int bj = 0; bj < 2; ++bj)
#pragma unroll
                    for (int n = 0; n < 2; ++n) { const f32x4 o = pre[m][bj][n] + acc[ai][bj][m][n] * scale;
                        u32x2v w; w.x = cvt_pk_bf16(o[0], o[1]); w.y = cvt_pk_bf16(o[2], o[3]); *(u32x2v*)(hb + off + bj * HALF + n * 16) = w;
                        if constexpr (SS) q += (o[0] * o[0] + o[1] * o[1]) + (o[2] * o[2] + o[3] * o[3]);
                        if constexpr (OUT8) *(unsigned*)(x8 + off + bj * HALF + n * 16) = cvt4_fp8(o[0], o[1], o[2], o[3]); }
                if constexpr (SS) { q += __shfl_xor(q, 16); q += __shfl_xor(q, 32); if (fq == 0) ss[(size_t)row * 16 + u.pn * 4 + wc] = q; } }
        }
    }
};
template <bool XN8> struct EpiResNorm {
    static constexpr bool PERM = false, AFTER_DRAIN = false;
    const float* base; float* out; int ldc; float scale; const float* gain; bf16_t* xn; float* ss;
    __device__ __forceinline__ void operator()(const f32x4 (&acc)[2][2][4][2], const Unit& u, int wr, int wc, int fr, int fq) const {
        const int row0 = u.pm * BM + wr * 64 + fr, col0 = u.pn * BM + wc * 32 + 4 * fq;
        f32x4 gv[2][2];
#pragma unroll
        for (int bj = 0; bj < 2; ++bj)
#pragma unroll
            for (int n = 0; n < 2; ++n) gv[bj][n] = *(const f32x4*)(gain + col0 + bj * HALF + n * 16);
#pragma unroll
        for (int ai = 0; ai < 2; ++ai) {
            f32x4 pre[4][2][2];
#pragma unroll
            for (int m = 0; m < 4; ++m) { const size_t off = (size_t)(row0 + ai * HALF + m * 16) * ldc + col0;
#pragma unroll
                for (int bj = 0; bj < 2; ++bj)
#pragma unroll
                    for (int n = 0; n < 2; ++n) pre[m][bj][n] = *(const f32x4*)(base + off + bj * HALF + n * 16); }
#pragma unroll
            for (int m = 0; m < 4; ++m) { const int row = row0 + ai * HALF + m * 16; const size_t off = (size_t)row * ldc + col0; float q = 0.f;
#pragma unroll
                for (int bj = 0; bj < 2; ++bj)
#pragma unroll
                    for (int n = 0; n < 2; ++n) { const f32x4 o = pre[m][bj][n] + acc[ai][bj][m][n] * scale; *(f32x4*)(out + off + bj * HALF + n * 16) = o;
                        q += (o[0] * o[0] + o[1] * o[1]) + (o[2] * o[2] + o[3] * o[3]); const f32x4 x = o * gv[bj][n];
                        if constexpr (XN8) *(unsigned*)((unsigned char*)xn + off + bj * HALF + n * 16) = cvt4_fp8(x[0], x[1], x[2], x[3]);
                        else { typedef unsigned u32x2v __attribute__((ext_vector_type(2))); u32x2v w; w.x = cvt_pk_bf16(x[0], x[1]); w.y = cvt_pk_bf16(x[2], x[3]); *(u32x2v*)(xn + off + bj * HALF + n * 16) = w; } }
                q += __shfl_xor(q, 16); q += __shfl_xor(q, 32);
                if (fq == 0) ss[(size_t)row * 16 + u.pn * 4 + wc] = q; }
        }
    }
};
struct EpiRes {
    static constexpr bool PERM = false, AFTER_DRAIN = false;
    const float* base; float* out; int ldc; float scale;
    __device__ __forceinline__ void operator()(const f32x4 (&acc)[2][2][4][2], const Unit& u, int wr, int wc, int fr, int fq) const {
        const int row0 = u.pm * BM + wr * 64 + fr, col0 = u.pn * BM + wc * 32 + 4 * fq;
#pragma unroll
        for (int ai = 0; ai < 2; ++ai)
#pragma unroll
            for (int mp = 0; mp < 4; mp += 2) {
                f32x4 pre[2][2][2];
#pragma unroll
                for (int m = 0; m < 2; ++m) { const size_t off = (size_t)(row0 + ai * HALF + (mp + m) * 16) * ldc + col0;
#pragma unroll
                    for (int bj = 0; bj < 2; ++bj)
#pragma unroll
                        for (int n = 0; n < 2; ++n) pre[m][bj][n] = *(const f32x4*)(base + off + bj * HALF + n * 16); }
#pragma unroll
                for (int m = 0; m < 2; ++m) { const size_t off = (size_t)(row0 + ai * HALF + (mp + m) * 16) * ldc + col0;
#pragma unroll
                    for (int bj = 0; bj < 2; ++bj)
#pragma unroll
                        for (int n = 0; n < 2; ++n) *(f32x4*)(out + off + bj * HALF + n * 16) = pre[m][bj][n] + acc[ai][bj][mp + m][n] * scale; }
            }
    }
};

typedef int i32x4 __attribute__((ext_vector_type(4))); typedef int i32x8 __attribute__((ext_vector_type(8)));
template <class Epi, class Sched, bool ALIGN_EPI = false, bool SP2 = false, bool FP8 = false>
__device__ __forceinline__ void gemm_phase(PG8_LAS unsigned char* lds, const Gemm g, const Sched& S, const Epi& E) {
    const int tid = threadIdx.x, wid = __builtin_amdgcn_readfirstlane(tid >> 6), lane = tid & 63, wr = wid >> 2, wc = wid & 3, fr = lane & 15, fq = lane >> 4;
    const int K = g.K, nt = K / BK;
    unsigned voffA[2], voffB[2];
#pragma unroll
    for (int i = 0; i < 2; ++i) { int R, C; stage_rc(tid * 16 + i * 8192, R, C); const int Rb = Epi::PERM ? ((R & ~31) + perm32(R & 31)) : R;
        voffA[i] = (unsigned)(R * K + C) * 2u; voffB[i] = (unsigned)(Rb * K + C) * 2u; }
    const size_t kstep = (size_t)(BK * 2);
    const size_t hstep = (size_t)HALF * K * 2;
    const size_t tstep = 2 * hstep;
    const unsigned ldsw = (unsigned)wid * 1024u;
    const int aoff = lds_byte(wr * 64 + fr, fq * 8), boff = lds_byte(wc * 32 + fr, fq * 8);
#define PG8_SA(b, h) (((b) * 2 + (h)) * HTB)
#define PG8_SB(b, h) ((4 + (b) * 2 + (h)) * HTB)
#define PG8_STAGE(bufoff, gbase, voff) do { _Pragma("unroll") for (int _i = 0; _i < 2; ++_i) \
        __builtin_amdgcn_global_load_lds((const unsigned*)((const char*)(gbase) + (voff)[_i]), (PG8_LAS unsigned*)(lds + (bufoff) + ldsw + _i * 8192), 16, 0, 0); } while (0)
#define PG8_LDA(dst, b, h) do { _Pragma("unroll") for (int m = 0; m < 4; ++m) { dst[m].lo = *(const PG8_LAS i32x4*)(lds + PG8_SA(b, h) + aoff + m * 2048); dst[m].hi = *(const PG8_LAS i32x4*)(lds + PG8_SA(b, h) + aoff + m * 2048 + 1024); } } while (0)
#define PG8_LDB(dst, b, h) do { _Pragma("unroll") for (int n = 0; n < 2; ++n) { dst[n].lo = *(const PG8_LAS i32x4*)(lds + PG8_SB(b, h) + boff + n * 2048); dst[n].hi = *(const PG8_LAS i32x4*)(lds + PG8_SB(b, h) + boff + n * 2048 + 1024); } } while (0)
#define PG8_H(x, k) __builtin_bit_cast(bf16x8, (k) == 0 ? (x).lo : (x).hi)
#define PG8_MMA(ai, bj, At, Bt) do { __builtin_amdgcn_s_setprio(1); \
        if constexpr (FP8) { _Pragma("unroll") for (int m = 0; m < 4; ++m) _Pragma("unroll") for (int n = 0; n < 2; ++n) \
            asm volatile("v_mfma_scale_f32_16x16x128_f8f6f4 %0, %1, %2, %0, %3, %3 op_sel_hi:[0,0,0]" : "+v"(acc[ai][bj][m][n]) : "v"(Bt[n]), "v"(At[m]), "v"(sc8)); } \
        else { _Pragma("unroll") for (int m = 0; m < 4; ++m) _Pragma("unroll") for (int n = 0; n < 2; ++n) _Pragma("unroll") for (int k = 0; k < 2; ++k) \
            acc[ai][bj][m][n] = __builtin_amdgcn_mfma_f32_16x16x32_bf16(PG8_H(Bt[n], k), PG8_H(At[m], k), acc[ai][bj][m][n], 0, 0, 0); } \
        __builtin_amdgcn_s_setprio(0); } while (0)
#define PG8_WAIT_V(n) asm volatile("s_waitcnt vmcnt(" #n ")" ::: "memory")
#define PG8_WAIT_L(n) asm volatile("s_waitcnt lgkmcnt(" #n ")" ::: "memory")
#define PG8_BAR __builtin_amdgcn_s_barrier()
#define PG8_SCHED __builtin_amdgcn_sched_barrier(0)
    Unit cur, nxt; int ui = 0;
    if (!S.next(0, cur)) return;
    f32x4 acc[2][2][4][2];
#pragma unroll
    for (int a = 0; a < 2; ++a)
#pragma unroll
        for (int b = 0; b < 2; ++b)
#pragma unroll
            for (int m = 0; m < 4; ++m)
#pragma unroll
                for (int n = 0; n < 2; ++n) acc[a][b][m][n] = (f32x4){0.f, 0.f, 0.f, 0.f};
    i32x8 At[4], B0[2], B1[2]; int sc8 = 0x7f7f7f7f; asm volatile("" : "+v"(sc8));
    const char* cA = (const char*)g.A + (size_t)cur.pm * tstep; const char* cB = (const char*)g.Bt + (size_t)cur.pn * tstep;
    S.a_ready(cur);
    if constexpr (SP2) {
        PG8_STAGE(PG8_SB(0, 0), cB, voffB); PG8_STAGE(PG8_SB(0, 1), cB + hstep, voffB); PG8_STAGE(PG8_SA(0, 0), cA, voffA); PG8_STAGE(PG8_SA(0, 1), cA + hstep, voffA);
        if (wr == 1) PG8_BAR;
        PG8_WAIT_V(2); PG8_BAR;
        PG8_STAGE(PG8_SB(1, 0), cB + kstep, voffB); PG8_STAGE(PG8_SA(1, 0), cA + kstep, voffA); PG8_STAGE(PG8_SB(1, 1), cB + hstep + kstep, voffB);
        PG8_WAIT_V(6); PG8_BAR;
    } else {
        PG8_STAGE(PG8_SB(0, 0), cB, voffB); PG8_STAGE(PG8_SA(0, 0), cA, voffA); PG8_STAGE(PG8_SB(0, 1), cB + hstep, voffB); PG8_STAGE(PG8_SA(0, 1), cA + hstep, voffA);
        if (wr == 1) PG8_BAR;
        PG8_WAIT_V(4); PG8_BAR;
        PG8_STAGE(PG8_SB(1, 0), cB + kstep, voffB); PG8_STAGE(PG8_SA(1, 0), cA + kstep, voffA); PG8_STAGE(PG8_SB(1, 1), cB + hstep + kstep, voffB);
        PG8_WAIT_V(6); PG8_BAR;
    }
    for (;;) {
        const bool has_next = S.next(ui + 1, nxt);
        const char* nA = has_next ? (const char*)g.A + (size_t)nxt.pm * tstep : cA; const char* nB = has_next ? (const char*)g.Bt + (size_t)nxt.pn * tstep : cB;
#pragma unroll 1
        for (int t = 0; t < nt; t += 2) {
            const bool last = (t == nt - 2);
            const char* a1 = cA + (size_t)(t + 1) * kstep;
            const char* a2 = last ? nA : cA + (size_t)(t + 2) * kstep; const char* b2 = last ? nB : cB + (size_t)(t + 2) * kstep;
            const char* a3 = a2 + kstep; const char* b3 = b2 + kstep;
            if (last && has_next) S.a_ready(nxt);
            if constexpr (SP2) {
            PG8_LDB(B0, 0, 0); PG8_LDB(B1, 0, 1); PG8_SCHED; PG8_LDA(At, 0, 0); PG8_STAGE(PG8_SA(1, 1), a1 + hstep, voffA);
            PG8_WAIT_V(8); PG8_WAIT_L(0); PG8_BAR; PG8_MMA(0, 0, At, B0); PG8_MMA(0, 1, At, B1); PG8_BAR; PG8_SCHED;
            PG8_LDA(At, 0, 1); PG8_STAGE(PG8_SB(0, 0), b2, voffB); PG8_STAGE(PG8_SB(0, 1), b2 + hstep, voffB); PG8_STAGE(PG8_SA(0, 0), a2, voffA);
            PG8_WAIT_V(8); PG8_WAIT_L(0); PG8_BAR; PG8_MMA(1, 0, At, B0); PG8_MMA(1, 1, At, B1); PG8_BAR; PG8_SCHED;
            PG8_LDB(B0, 1, 0); PG8_LDB(B1, 1, 1); PG8_SCHED; PG8_LDA(At, 1, 0); PG8_STAGE(PG8_SA(0, 1), a2 + hstep, voffA);
            PG8_WAIT_V(8); PG8_WAIT_L(0); PG8_BAR; PG8_MMA(0, 0, At, B0); PG8_MMA(0, 1, At, B1); PG8_BAR; PG8_SCHED;
            PG8_LDA(At, 1, 1); PG8_STAGE(PG8_SB(1, 0), b3, voffB); PG8_STAGE(PG8_SB(1, 1), b3 + hstep, voffB); PG8_STAGE(PG8_SA(1, 0), a3, voffA);
            PG8_WAIT_V(8); PG8_WAIT_L(0); PG8_BAR; PG8_MMA(1, 0, At, B0); PG8_MMA(1, 1, At, B1); PG8_BAR; PG8_SCHED;
            } else {
            PG8_LDB(B0, 0, 0); PG8_SCHED; PG8_LDA(At, 0, 0); PG8_STAGE(PG8_SA(1, 1), a1 + hstep, voffA);
            PG8_WAIT_L(8); PG8_BAR; PG8_WAIT_L(0); PG8_MMA(0, 0, At, B0); PG8_BAR; PG8_SCHED;
            PG8_LDB(B1, 0, 1); PG8_STAGE(PG8_SB(0, 0), b2, voffB);
            PG8_BAR; PG8_WAIT_L(0); PG8_MMA(0, 1, At, B1); PG8_BAR;
            PG8_LDA(At, 0, 1); PG8_STAGE(PG8_SA(0, 0), a2, voffA);
            PG8_BAR; PG8_WAIT_L(0); PG8_MMA(1, 0, At, B0); PG8_BAR; PG8_SCHED;
            PG8_STAGE(PG8_SB(0, 1), b2 + hstep, voffB);
            PG8_WAIT_V(6); PG8_BAR; PG8_MMA(1, 1, At, B1); PG8_BAR;
            PG8_LDB(B0, 1, 0); PG8_SCHED; PG8_LDA(At, 1, 0); PG8_STAGE(PG8_SA(0, 1), a2 + hstep, voffA);
            PG8_WAIT_L(8); PG8_BAR; PG8_WAIT_L(0); PG8_MMA(0, 0, At, B0); PG8_BAR; PG8_SCHED;
            PG8_LDB(B1, 1, 1); PG8_STAGE(PG8_SB(1, 0), b3, voffB);
            PG8_BAR; PG8_WAIT_L(0); PG8_MMA(0, 1, At, B1); PG8_BAR;
            PG8_LDA(At, 1, 1); PG8_STAGE(PG8_SA(1, 0), a3, voffA);
            PG8_BAR; PG8_WAIT_L(0); PG8_MMA(1, 0, At, B0); PG8_BAR; PG8_SCHED;
            PG8_STAGE(PG8_SB(1, 1), b3 + hstep, voffB);
            PG8_WAIT_V(6); PG8_BAR; PG8_MMA(1, 1, At, B1); PG8_BAR;
            }
        }
        if constexpr (FP8) asm volatile("s_nop 15\n\ts_nop 15" ::: "memory");
        if constexpr (ALIGN_EPI) { if (wr == 0) PG8_BAR; }
        if constexpr (!Epi::AFTER_DRAIN) { E(acc, cur, wr, wc, fr, fq); S.done(cur); }
        if (!has_next) break;
#pragma unroll
        for (int a = 0; a < 2; ++a)
#pragma unroll
            for (int b = 0; b < 2; ++b)
#pragma unroll
                for (int m = 0; m < 4; ++m)
#pragma unroll
                    for (int n = 0; n < 2; ++n) acc[a][b][m][n] = (f32x4){0.f, 0.f, 0.f, 0.f};
        cur = nxt; cA = nA; cB = nB; ++ui;
        if constexpr (ALIGN_EPI) { if (wr == 1) PG8_BAR; }
    }
    PG8_WAIT_V(0);
    if constexpr (!ALIGN_EPI) { if (wr == 0) PG8_BAR; }
    PG8_BAR;
    if constexpr (Epi::AFTER_DRAIN) { E.fused(acc, cur, wr, wc, fr, fq, lds, wid, lane); S.done(cur); }
#undef PG8_SA
#undef PG8_SB
#undef PG8_STAGE
#undef PG8_LDA
#undef PG8_LDB
#undef PG8_MMA
#undef PG8_H
#undef PG8_WAIT_V
#undef PG8_WAIT_L
#undef PG8_BAR
#undef PG8_SCHED
}
}

#ifndef PG8_SP2
#define PG8_SP2 true
#endif
#ifndef PG8_ALIGN
#define PG8_ALIGN true
#endif

constexpr int NWAVES = 8;
#ifndef MK_N_LAUNCHES
#define MK_N_LAUNCHES 1
#endif
#ifndef REP_MASK
#define REP_MASK 0
#endif
#ifndef FFN1_FP8
#define FFN1_FP8 1
#endif
constexpr int PER_PHASE = 12;
constexpr int N_LAUNCHES = MK_N_LAUNCHES;
static_assert(N_LAUNCHES == 1 || N_LAUNCHES == PER_PHASE, "MK_N_LAUNCHES is 1 or 12");

constexpr int BATCH = 8, SEQ = 2048, D = 1024, M = BATCH * SEQ;
constexpr int FF = 2816, FF2 = 2 * FF;
constexpr int NH = 8, HD = 64, CL = 128, TOPK = 256;
constexpr int NPROJ = 2816;
constexpr int PQ = 0, PQI = 512, PCKV = 1024, PKI = 1152, PWI = 1216, PGB = 1280, PGC = 1792, PXIN = 2304;
constexpr int WIN_N = 2760;
constexpr float EPS = 1e-6f;
constexpr float WSC_GU = 32.f, WSC_DN = 64.f;
constexpr float IDX_SCALE = 0.044194173824159216f;

constexpr size_t MiB = 1u << 20;
constexpr size_t WS_CTL = 0, CTL_ZERO_BYTES = 1 * MiB;
constexpr size_t WS_WUK = 1 * MiB, WS_WUV = 1 * MiB + 256 * 1024;
constexpr size_t WS_WGU1 = 2 * MiB, WS_WD1 = 14 * MiB, WS_WIN = 20 * MiB, WS_WOUT = 26 * MiB, WS_WGU2 = 28 * MiB, WS_WD2 = 40 * MiB;
constexpr size_t WS_XN = 48 * MiB;
constexpr size_t WS_MIX = 80 * MiB;
constexpr size_t WS_KV = 112 * MiB;
constexpr size_t WS_MASK = 116 * MiB;
constexpr size_t WS_SS = 120 * MiB;
constexpr size_t WS_ACT = 128 * MiB;
constexpr size_t WS_HB = 216 * MiB;
constexpr size_t WS_END = 248 * MiB;
static_assert(WS_WGU1 + (size_t)FF2 * D * 2 <= WS_WD1 && WS_WD1 + (size_t)D * FF * 2 <= WS_WIN && WS_WIN + (size_t)NPROJ * D * 2 <= WS_WOUT && WS_WOUT + (size_t)D * D * 2 <= WS_WGU2 &&
              WS_WGU2 + (size_t)FF2 * D * 2 <= WS_WD2 && WS_WD2 + (size_t)D * FF * 2 <= WS_XN && WS_ACT + (size_t)M * FF * 2 <= WS_HB && WS_HB + (size_t)M * D * 2 <= WS_END, "d_ws map");
constexpr int CW_BAR = 4096;

constexpr int RING_OFF = 0, RING_BYTES = 131072;
constexpr int LDSCTL_OFF = RING_BYTES, MISC_OFF = LDSCTL_OFF + 320;
constexpr int LDS_BYTES = 147456;
static_assert(MISC_OFF + 128 <= LDS_BYTES, "LDS map");
#define GAS __attribute__((address_space(1)))
#define LAS __attribute__((address_space(3)))
typedef unsigned short bf16;
typedef unsigned v4u __attribute__((ext_vector_type(4)));
typedef float f32x4 __attribute__((ext_vector_type(4)));
typedef short bf16x8 __attribute__((ext_vector_type(8)));
typedef GAS unsigned gu32;
typedef GAS unsigned long long gu64;
#define RLX_AGENT __ATOMIC_RELAXED, __HIP_MEMORY_SCOPE_AGENT
#define LDS_WAIT() asm volatile("s_waitcnt lgkmcnt(0)" ::: "memory")
#define VM_WAIT() asm volatile("s_waitcnt vmcnt(0)" ::: "memory")
__device__ __forceinline__ unsigned long long rt() { return __builtin_amdgcn_s_memrealtime(); }
__device__ __forceinline__ unsigned f2bf(float f) { unsigned u = __builtin_bit_cast(unsigned, f); return (u + 0x7fffu + ((u >> 16) & 1u)) >> 16; }
__device__ __forceinline__ unsigned pk2(float lo, float hi) { return f2bf(lo) | (f2bf(hi) << 16); }

#define XB_TMO      128
#define XB_XCNT(j)  (256  + 64 * (j))
#define XB_XSUB(j)  (1280 + 64 * (j))
#define XB_XGEN(j)  (2304 + 64 * (j))
#define XB_TOP      3328
#define XB_TOPGEN   3392
#define XCD_BAR_WORDS 3456
#define XB_SPIN_CAP (1u << 18)

__device__ __forceinline__ unsigned xb_ld(unsigned* p)              { return __hip_atomic_load(p, __ATOMIC_RELAXED, __HIP_MEMORY_SCOPE_AGENT); }
__device__ __forceinline__ unsigned xb_add(unsigned* p, unsigned v) { return __hip_atomic_fetch_add(p, v, __ATOMIC_RELAXED, __HIP_MEMORY_SCOPE_AGENT); }
__device__ __forceinline__ unsigned xb_xcc_id() { return (unsigned)__builtin_amdgcn_s_getreg((3 << 11) | 20) & 0xFu; }
#define XB_SPIN(cond, bar) do { unsigned _sp = 0; while (cond) { __builtin_amdgcn_s_sleep(1); \
    if ((++_sp & 255u) == 0u) { if (xb_ld(&(bar)[XB_TMO])) break; if (_sp > XB_SPIN_CAP) { atomicAdd(&(bar)[XB_TMO], 1u); break; } } } } while (0)

struct XcdBarrier {
    unsigned* bar; unsigned x;
    volatile LAS unsigned* st;
};

__device__ __forceinline__ XcdBarrier xcd_barrier_post(unsigned* bar, volatile LAS unsigned* st) {
    XcdBarrier b; b.bar = bar; b.x = xb_xcc_id(); b.st = st;
    if (threadIdx.x == 0) (void)xb_add(&bar[XB_XCNT(b.x)], 1u);
    return b;
}
__device__ __forceinline__ void xcd_barrier_complete(unsigned* bar, unsigned x, unsigned& nloc, unsigned& nx) {
    const unsigned G = gridDim.x * gridDim.y * gridDim.z;
    unsigned sum, cnt, mine, sp = 0u;
    for (;;) {
        sum = 0u; cnt = 0u; mine = 0u;
#pragma unroll
        for (unsigned j = 0; j < 16; ++j) { const unsigned c = xb_ld(&bar[XB_XCNT(j)]); sum += c; cnt += (c > 0u) ? 1u : 0u; mine = (j == x) ? c : mine; }
        if (sum == G) break;
        __builtin_amdgcn_s_sleep(1);
        if ((++sp & 255u) == 0u) { if (xb_ld(&bar[XB_TMO])) break; if (sp > XB_SPIN_CAP) { atomicAdd(&bar[XB_TMO], 1u); break; } }
    }
    nloc = mine > 0u ? mine : 1u; nx = cnt > 0u ? cnt : 1u;
}

__device__ __forceinline__ void xcd_barrier(const XcdBarrier& b) {
    asm volatile("s_waitcnt vmcnt(0)" ::: "memory");
    __syncthreads();
    if (threadIdx.x == 0) {
        unsigned* bar = b.bar;
        __builtin_amdgcn_s_waitcnt(0);
        unsigned nloc = b.st[0], nx = b.st[1];
        if (nloc == 0u) { xcd_barrier_complete(bar, b.x, nloc, nx); b.st[0] = nloc; b.st[1] = nx; }
        const unsigned old = xb_add(&bar[XB_XSUB(b.x)], 1u);
        const unsigned gen = old / nloc;
        if (old + 1u == (gen + 1u) * nloc) {
            __builtin_amdgcn_fence(__ATOMIC_RELEASE, "agent");
            asm volatile("s_waitcnt vmcnt(0)" ::: "memory");
            const unsigned og = xb_add(&bar[XB_TOP], 1u);
            const unsigned tg = og / nx;
            if (og + 1u == (tg + 1u) * nx) xb_add(&bar[XB_TOPGEN], 1u);
            else XB_SPIN(xb_ld(&bar[XB_TOPGEN]) == tg, bar);
            __builtin_amdgcn_fence(__ATOMIC_ACQUIRE, "agent");
            xb_add(&bar[XB_XGEN(b.x)], 1u);
            asm volatile("s_waitcnt vmcnt(0)" ::: "memory");
        } else {
            XB_SPIN(xb_ld(&bar[XB_XGEN(b.x)]) == gen, bar);
            __builtin_amdgcn_fence(__ATOMIC_ACQUIRE, "agent");
            asm volatile("s_waitcnt vmcnt(0)" ::: "memory");
        }
    }
    __syncthreads();
}


struct Frame {
    LAS unsigned char* lds;
    volatile LAS unsigned* MISC;
    gu32* ctl;
    int tid, lane, wave;
    int vcu, G;
    const float* in[20]; float* out;
    bf16 *Wgu1, *Wd1, *Win, *Wout, *Wgu2, *Wd2, *Wuk, *WuvT;
    bf16 *XN, *MIX, *KV, *ACT, *PROJ; unsigned* MASK; float* SS; bf16* HB;
};
enum { I_X = 0, I_N1, I_G1, I_U1, I_D1, I_NMIX, I_WIN, I_NKV, I_WUK, I_WUV, I_RELB, I_CONVW, I_NATT, I_NCONV, I_WOUT, I_N2, I_G2, I_U2, I_D2, I_NF };

__device__ __forceinline__ float wave_sum(float v) {
#pragma unroll
    for (int o = 1; o < 64; o <<= 1) v += __shfl_xor(v, o);
    return v;
}
__device__ __forceinline__ float wave_max(float v) {
#pragma unroll
    for (int o = 1; o < 64; o <<= 1) v = fmaxf(v, __shfl_xor(v, o));
    return v;
}
__device__ __forceinline__ float bflo(unsigned w) { return __uint_as_float(w << 16); }
__device__ __forceinline__ float bfhi(unsigned w) { return __uint_as_float(w & 0xffff0000u); }

__device__ __forceinline__ void ld8bf(const bf16* p, float (&f)[8]) { const v4u w = *(const GAS v4u*)p; f[0] = bflo(w.x); f[1] = bfhi(w.x); f[2] = bflo(w.y); f[3] = bfhi(w.y); f[4] = bflo(w.z); f[5] = bfhi(w.z); f[6] = bflo(w.w); f[7] = bfhi(w.w); }
struct Src { const float* W; int N; int col; };
struct MapPlain { const float* W; int N; __device__ __forceinline__ Src operator()(int d) const { return Src{W, N, d}; } };
struct MapGU { const float* W; __device__ __forceinline__ Src operator()(int d) const { return Src{W, FF, (d >> 8) * 128 + (d & 127)}; } };
struct MapWin { const float* W; __device__ __forceinline__ Src operator()(int d) const { int c;
    if (d < 512) c = d;
    else if (d < 1024) c = 640 + (d - 512);
    else if (d < 1152) c = 512 + (d - 1024);
    else if (d < 1224) c = d;
    else if (d < 1280) c = -1;
    else if (d < 1792) c = 1224 + (d - 1280);
    else if (d < 2304) c = 1736 + (d - 1792);
    else c = 2248 + (d - 2304);
    return Src{W, WIN_N, c}; } };
template <class MAP>
__device__ __forceinline__ void p0_transpose_item(const MAP& map, int K, int ndg, bf16* WT, LAS float* scr, int item, int lane, const float* gk = nullptr) {
    const int kb = item / ndg, dg = item % ndg, k0 = 64 * kb, d0 = 32 * dg;
    const Src src = map(d0 + (lane & 31)); const int sc = src.col; const float* wp = src.W + (size_t)(k0 + (lane >> 5)) * src.N + (sc >= 0 ? sc : 0);
#pragma unroll 8
    for (int i = 0; i < 32; ++i) { const int kk = 2 * i + (lane >> 5); scr[kk * 33 + (lane & 31)] = sc >= 0 ? wp[(size_t)(2 * i) * src.N] * (gk ? gk[k0 + kk] : 1.f) : 0.f; }
    LDS_WAIT(); asm volatile("" ::: "memory");
    const int c = lane & 7;
#pragma unroll
    for (int j = 0; j < 4; ++j) { const int n = (lane >> 3) + 8 * j; const LAS float* s = scr + (8 * c) * 33 + n;
        v4u o; o.x = pk2(s[0 * 33], s[1 * 33]); o.y = pk2(s[2 * 33], s[3 * 33]); o.z = pk2(s[4 * 33], s[5 * 33]); o.w = pk2(s[6 * 33], s[7 * 33]);
        *(GAS v4u*)(WT + (size_t)(d0 + n) * K + k0 + 8 * c) = o; }
    LDS_WAIT(); asm volatile("" ::: "memory");
}
template <class MAP>
__device__ __forceinline__ void p0_transpose_item8(const MAP& map, int K, int ndg, unsigned char* WT, LAS float* scr, int item, int lane, float wscale, const float* gk = nullptr) {
    const int kb = item / ndg, dg = item % ndg, k0 = 64 * kb, d0 = 32 * dg;
    const Src src = map(d0 + (lane & 31)); const int sc = src.col; const float* wp = src.W + (size_t)(k0 + (lane >> 5)) * src.N + (sc >= 0 ? sc : 0);
#pragma unroll 8
    for (int i = 0; i < 32; ++i) { const int kk = 2 * i + (lane >> 5); scr[kk * 33 + (lane & 31)] = sc >= 0 ? wp[(size_t)(2 * i) * src.N] * (gk ? gk[k0 + kk] * wscale : wscale) : 0.f; }
    LDS_WAIT(); asm volatile("" ::: "memory");
    const int c = lane & 7;
#pragma unroll
    for (int j = 0; j < 4; ++j) { const int n = (lane >> 3) + 8 * j; const LAS float* s = scr + (8 * c) * 33 + n;
        typedef unsigned u32x2v __attribute__((ext_vector_type(2))); u32x2v o; o.x = pg8::cvt4_fp8(s[0 * 33], s[1 * 33], s[2 * 33], s[3 * 33]); o.y = pg8::cvt4_fp8(s[4 * 33], s[5 * 33], s[6 * 33], s[7 * 33]);
        *(GAS u32x2v*)(WT + (size_t)(d0 + n) * K + k0 + 8 * c) = o; }
    LDS_WAIT(); asm volatile("" ::: "memory");
}
__device__ __forceinline__ void rms_row_to_bf16(int lane, const float* xrow, const float* gain, bf16* orow) {
    const GAS f32x4* xr = (const GAS f32x4*)xrow + lane; const GAS f32x4* gr = (const GAS f32x4*)gain + lane;
    f32x4 v[4]; float s = 0.f;
#pragma unroll
    for (int j = 0; j < 4; ++j) { v[j] = xr[64 * j]; s += (v[j].x * v[j].x + v[j].y * v[j].y) + (v[j].z * v[j].z + v[j].w * v[j].w); }
    const float rstd = 1.f / sqrtf(wave_sum(s) * (1.f / D) + EPS);
    GAS unsigned long long* o8 = (GAS unsigned long long*)orow + lane;
#pragma unroll
    for (int j = 0; j < 4; ++j) { const f32x4 g = gr[64 * j]; o8[64 * j] = (unsigned long long)pk2(v[j].x * rstd * g.x, v[j].y * rstd * g.y) | ((unsigned long long)pk2(v[j].z * rstd * g.z, v[j].w * rstd * g.w) << 32); }
}
template <bool OUT8> __device__ __forceinline__ void gain_row_to_bf16(int lane, const float* xrow, bf16* orow, float* ssrow) {
    const GAS f32x4* xr = (const GAS f32x4*)xrow + lane;
    f32x4 v[4]; float s = 0.f;
#pragma unroll
    for (int j = 0; j < 4; ++j) { v[j] = xr[64 * j]; s += (v[j].x * v[j].x + v[j].y * v[j].y) + (v[j].z * v[j].z + v[j].w * v[j].w); }
    s = wave_sum(s);
    if constexpr (OUT8) { GAS unsigned* o4 = (GAS unsigned*)orow + lane;
#pragma unroll
        for (int j = 0; j < 4; ++j) o4[64 * j] = pg8::cvt4_fp8(v[j].x, v[j].y, v[j].z, v[j].w); }
    else { GAS unsigned long long* o8 = (GAS unsigned long long*)orow + lane;
#pragma unroll
        for (int j = 0; j < 4; ++j) o8[64 * j] = (unsigned long long)pk2(v[j].x, v[j].y) | ((unsigned long long)pk2(v[j].z, v[j].w) << 32); }
    if (lane < 16) ((GAS float*)ssrow)[lane] = lane == 0 ? s : 0.f;
}
__device__ __forceinline__ void rms_row_bf16_to_f32(int lane, const bf16* xrow, const float* gain, float* orow, bool poison) {
    float v[2][8]; float s = 0.f;
#pragma unroll
    for (int j = 0; j < 2; ++j) { ld8bf(xrow + 512 * j + 8 * lane, v[j]);
#pragma unroll
        for (int e = 0; e < 8; ++e) s += v[j][e] * v[j][e]; }
    float rstd = 1.f / sqrtf(wave_sum(s) * (1.f / D) + EPS); if (poison) rstd = __builtin_nanf("");
#pragma unroll
    for (int j = 0; j < 2; ++j) { const GAS f32x4* g = (const GAS f32x4*)(gain + 512 * j + 8 * lane); GAS f32x4* o = (GAS f32x4*)(orow + 512 * j + 8 * lane);
        const f32x4 g0 = g[0], g1 = g[1];
        o[0] = (f32x4){v[j][0] * rstd * g0.x, v[j][1] * rstd * g0.y, v[j][2] * rstd * g0.z, v[j][3] * rstd * g0.w};
        o[1] = (f32x4){v[j][4] * rstd * g1.x, v[j][5] * rstd * g1.y, v[j][6] * rstd * g1.z, v[j][7] * rstd * g1.w}; }
}
__device__ __forceinline__ void rms_row_to_f32(int lane, const float* xrow, const float* gain, float* orow, bool poison) {
    const GAS f32x4* xr = (const GAS f32x4*)xrow + lane; const GAS f32x4* gr = (const GAS f32x4*)gain + lane;
    f32x4 v[4]; float s = 0.f;
#pragma unroll
    for (int j = 0; j < 4; ++j) { v[j] = xr[64 * j]; s += (v[j].x * v[j].x + v[j].y * v[j].y) + (v[j].z * v[j].z + v[j].w * v[j].w); }
    float rstd = 1.f / sqrtf(wave_sum(s) * (1.f / D) + EPS); if (poison) rstd = __builtin_nanf("");
    GAS f32x4* o = (GAS f32x4*)orow + lane;
#pragma unroll
    for (int j = 0; j < 4; ++j) { const f32x4 g = gr[64 * j]; o[64 * j] = v[j] * rstd * g; }
}
__device__ __forceinline__ void p0_prologue(Frame& F) {
    LAS float* scr = (LAS float*)(F.lds + RING_OFF + F.wave * 16384);
    const int gw = F.vcu * NWAVES + F.wave, NGW = F.G * NWAVES;
    constexpr int I_GU = (D / 64) * (FF2 / 32), I_DN = (FF / 64) * (D / 32), I_IN = (D / 64) * (NPROJ / 32), I_OUT = (D / 64) * (D / 32);
    constexpr int NITEMS = 2 * I_GU + 2 * I_DN + I_IN + I_OUT;
    for (int it = gw; it < NITEMS; it += NGW) {
        int r = it;
        if (r < I_GU) { const float* wsrc = (((r % (FF2 / 32)) & 7) < 4) ? F.in[I_G1] : F.in[I_U1];
            if (FFN1_FP8) p0_transpose_item8(MapGU{wsrc}, D, FF2 / 32, (unsigned char*)F.Wgu1, scr, r, F.lane, WSC_GU, F.in[I_N1]); else p0_transpose_item(MapGU{wsrc}, D, FF2 / 32, F.Wgu1, scr, r, F.lane, F.in[I_N1]); continue; } r -= I_GU;
        if (r < I_GU) { if (((r % (FF2 / 32)) & 7) < 4) p0_transpose_item8(MapGU{F.in[I_G2]}, D, FF2 / 32, (unsigned char*)F.Wgu2, scr, r, F.lane, WSC_GU, F.in[I_N2]); else p0_transpose_item8(MapGU{F.in[I_U2]}, D, FF2 / 32, (unsigned char*)F.Wgu2, scr, r, F.lane, WSC_GU, F.in[I_N2]); continue; } r -= I_GU;
        if (r < I_DN) { if (FFN1_FP8) p0_transpose_item8(MapPlain{F.in[I_D1], D}, FF, D / 32, (unsigned char*)F.Wd1, scr, r, F.lane, WSC_DN); else p0_transpose_item(MapPlain{F.in[I_D1], D}, FF, D / 32, F.Wd1, scr, r, F.lane); continue; } r -= I_DN;
        if (r < I_DN) { p0_transpose_item8(MapPlain{F.in[I_D2], D}, FF, D / 32, (unsigned char*)F.Wd2, scr, r, F.lane, WSC_DN); continue; } r -= I_DN;
        if (r < I_IN) { p0_transpose_item(MapWin{F.in[I_WIN]}, D, NPROJ / 32, F.Win, scr, r, F.lane, F.in[I_NMIX]); continue; } r -= I_IN;
        p0_transpose_item(MapPlain{F.in[I_WOUT], D}, D, D / 32, F.Wout, scr, r, F.lane);
    }
    for (int i = F.vcu * NWAVES * 64 + F.tid; i < CL * NH * HD; i += F.G * NWAVES * 64) {
        F.Wuk[i] = (bf16)f2bf(F.in[I_WUK][i]); const int h = i >> 13, d = (i >> 7) & 63, c = i & 127; F.WuvT[i] = (bf16)f2bf(F.in[I_WUV][((size_t)c * NH + h) * HD + d]); }
    for (int m = gw; m < M; m += NGW) gain_row_to_bf16<FFN1_FP8 != 0>(F.lane, F.in[I_X] + (size_t)m * D, FFN1_FP8 ? (bf16*)((unsigned char*)F.XN + (size_t)m * D) : F.XN + (size_t)m * D, F.SS + (size_t)m * 16);
}
__device__ __forceinline__ void norm_phase(Frame& F, const float* src, const float* gain) {
    const int gw = F.vcu * NWAVES + F.wave, NGW = F.G * NWAVES;
    for (int m = gw; m < M; m += NGW) rms_row_to_bf16(F.lane, src + (size_t)m * D, gain, F.XN + (size_t)m * D);
}

__device__ __forceinline__ void prep_phase(Frame& F) {
    const int gw = F.vcu * NWAVES + F.wave, NGW = F.G * NWAVES, lane = F.lane;
    const float* cw = F.in[I_CONVW];
    for (int m = gw; m < M; m += NGW) {
        const bf16* prow = F.PROJ + (size_t)m * NPROJ; const int t = m & (SEQ - 1);
        {
            const unsigned w = *(const GAS unsigned*)(prow + PCKV + 2 * lane); const float a = bflo(w), b = bfhi(w);
            const float rstd = 1.f / sqrtf(wave_sum(a * a + b * b) * (1.f / CL) + EPS);
            const float g0 = F.in[I_NKV][2 * lane], g1 = F.in[I_NKV][2 * lane + 1];
            *(GAS unsigned*)(F.KV + (size_t)m * CL + 2 * lane) = pk2(a * rstd * g0, b * rstd * g1);
        }
        {
            const int c0 = 8 * lane; float gb[8], gc[8], xi[8], y[8];
            ld8bf(prow + PGB + c0, gb); ld8bf(prow + PGC + c0, gc); ld8bf(prow + PXIN + c0, xi);
#pragma unroll
            for (int e = 0; e < 8; ++e) y[e] = cw[2 * 512 + c0 + e] * (gc[e] * xi[e]);
            if (t >= 1) { ld8bf(prow - NPROJ + PGC + c0, gc); ld8bf(prow - NPROJ + PXIN + c0, xi);
#pragma unroll
                for (int e = 0; e < 8; ++e) y[e] += cw[1 * 512 + c0 + e] * (gc[e] * xi[e]); }
            if (t >= 2) { ld8bf(prow - 2 * NPROJ + PGC + c0, gc); ld8bf(prow - 2 * NPROJ + PXIN + c0, xi);
#pragma unroll
                for (int e = 0; e < 8; ++e) y[e] += cw[0 * 512 + c0 + e] * (gc[e] * xi[e]); }
            float ss = 0.f;
#pragma unroll
            for (int e = 0; e < 8; ++e) { y[e] *= gb[e]; ss += y[e] * y[e]; }
            const float rstd = 1.f / sqrtf(wave_sum(ss) * (1.f / 512.f) + EPS);
            const float* g = F.in[I_NCONV] + c0;
            v4u o; o.x = pk2(y[0] * rstd * g[0], y[1] * rstd * g[1]); o.y = pk2(y[2] * rstd * g[2], y[3] * rstd * g[3]); o.z = pk2(y[4] * rstd * g[4], y[5] * rstd * g[5]); o.w = pk2(y[6] * rstd * g[6], y[7] * rstd * g[7]);
            *(GAS v4u*)(F.MIX + (size_t)m * D + 512 + c0) = o;
        }
    }
}

__device__ __forceinline__ int wave_sum_i(int v) {
#pragma unroll
    for (int o = 1; o < 64; o <<= 1) v += __shfl_xor(v, o);
    return v;
}
__device__ __forceinline__ int rel_bucket(int d) {
    if (d < 16) return d;
    return 16 + (d >= 19) + (d >= 21) + (d >= 24) + (d >= 27) + (d >= 31) + (d >= 35) + (d >= 40) + (d >= 46) + (d >= 52) + (d >= 59) + (d >= 67) + (d >= 77) + (d >= 87) + (d >= 99) + (d >= 113);
}
__device__ __forceinline__ void naive_attn_query(Frame& F, int m, LAS float* L) {
    const int lane = F.lane, b = m >> 11, t = m & (SEQ - 1);
    LAS float* qi_s = L;
    LAS float* qa_s = L + 512;
    LAS int* sel_s = (LAS int*)(L + 1536);
    LAS unsigned* sc_s = (LAS unsigned*)(L + 1792);
    LAS float* p_s = L + 1792;
    const bf16* prow = F.PROJ + (size_t)m * NPROJ;
    const bf16* pb = F.PROJ + (size_t)(b * SEQ) * NPROJ;
    float f8[8];
    ld8bf(prow + PQI + 8 * lane, f8);
#pragma unroll
    for (int e = 0; e < 8; ++e) qi_s[8 * lane + e] = f8[e];
    float wv[8]; ld8bf(prow + PWI, wv);
#pragma unroll
    for (int h = 0; h < 8; ++h) wv[h] *= IDX_SCALE;
    LDS_WAIT();
    for (int s = lane; s <= t; s += 64) {
        const bf16* kr = pb + (size_t)s * NPROJ + PKI; float dot[8];
#pragma unroll
        for (int h = 0; h < 8; ++h) dot[h] = 0.f;
#pragma unroll 1
        for (int ch = 0; ch < 8; ++ch) { float k[8]; ld8bf(kr + 8 * ch, k);
#pragma unroll
            for (int h = 0; h < 8; ++h)
#pragma unroll
                for (int e = 0; e < 8; ++e) dot[h] += qi_s[h * 64 + ch * 8 + e] * k[e]; }
        float score = 0.f;
#pragma unroll
        for (int h = 0; h < 8; ++h) score += wv[h] * fmaxf(dot[h], 0.f);
        unsigned u = __float_as_uint(score); u = (u & 0x80000000u) ? ~u : (u | 0x80000000u);
        sc_s[s] = u;
    }
    LDS_WAIT();
    int nsel;
    if (t < TOPK) { nsel = t + 1; for (int i = lane; i < nsel; i += 64) sel_s[i] = i; }
    else {
        unsigned T = 0u;
        for (int bit = 31; bit >= 0; --bit) { const unsigned cand = T | (1u << bit); int cnt = 0;
            for (int s = lane; s <= t; s += 64) cnt += (sc_s[s] >= cand) ? 1 : 0;
            cnt = wave_sum_i(cnt); if (cnt >= TOPK) T = cand; }
        int cgt = 0; for (int s = lane; s <= t; s += 64) cgt += (sc_s[s] > T) ? 1 : 0;
        cgt = wave_sum_i(cgt);
        const int need = TOPK - cgt; int base = 0, taken = 0; const unsigned long long lt = (1ull << lane) - 1ull;
        for (int s0 = 0; s0 <= t; s0 += 64) { const int s = s0 + lane; const bool valid = s <= t; const unsigned key = valid ? sc_s[s] : 0u;
            const bool gt = valid && key > T, eq = valid && key == T;
            const unsigned long long eqm = __ballot(eq); const int eqrank = taken + __popcll(eqm & lt);
            const bool selb = gt || (eq && eqrank < need);
            const unsigned long long sm = __ballot(selb); const int pos = base + __popcll(sm & lt);
            if (selb) sel_s[pos] = s;
            base += __popcll(sm); taken += __popcll(eqm); }
        nsel = TOPK;
    }
    ld8bf(prow + PQ + 8 * lane, f8);
#pragma unroll
    for (int e = 0; e < 8; ++e) qi_s[8 * lane + e] = f8[e];
    LDS_WAIT();
    for (int i = 0; i < 16; ++i) { const int o = lane + 64 * i, h = o >> 7, c = o & 127; const GAS f32x4* w = (const GAS f32x4*)(F.in[I_WUK] + ((size_t)c * 8 + h) * 64); float a = 0.f;
#pragma unroll
        for (int d4 = 0; d4 < 16; ++d4) { const f32x4 wv4 = w[d4]; a += qi_s[h * 64 + 4 * d4] * wv4.x + qi_s[h * 64 + 4 * d4 + 1] * wv4.y + qi_s[h * 64 + 4 * d4 + 2] * wv4.z + qi_s[h * 64 + 4 * d4 + 3] * wv4.w; }
        qa_s[o] = a * 0.125f; }
    LDS_WAIT();
    for (int i = 0; i < 4; ++i) { const int kidx = lane + 64 * i; float lg[8];
        if (kidx < nsel) { const int s = sel_s[kidx]; const bf16* kr = F.KV + (size_t)(b * SEQ + s) * CL;
#pragma unroll
            for (int h = 0; h < 8; ++h) lg[h] = 0.f;
#pragma unroll 1
            for (int ch = 0; ch < 16; ++ch) { float k[8]; ld8bf(kr + 8 * ch, k);
#pragma unroll
                for (int h = 0; h < 8; ++h)
#pragma unroll
                    for (int e = 0; e < 8; ++e) lg[h] += qa_s[h * 128 + ch * 8 + e] * k[e]; }
            const float* rb = F.in[I_RELB] + rel_bucket(t - s) * 8;
#pragma unroll
            for (int h = 0; h < 8; ++h) lg[h] += rb[h];
        } else {
#pragma unroll
            for (int h = 0; h < 8; ++h) lg[h] = -INFINITY; }
#pragma unroll
        for (int h = 0; h < 8; ++h) p_s[h * 256 + kidx] = lg[h]; }
    LDS_WAIT();
    for (int h = 0; h < 8; ++h) { float v[4], mx = -INFINITY;
#pragma unroll
        for (int i = 0; i < 4; ++i) { v[i] = p_s[h * 256 + lane + 64 * i]; mx = fmaxf(mx, v[i]); }
        mx = wave_max(mx); float sm = 0.f;
#pragma unroll
        for (int i = 0; i < 4; ++i) { v[i] = __expf(v[i] - mx); sm += v[i]; }
        sm = wave_sum(sm); const float inv = 1.f / sm;
#pragma unroll
        for (int i = 0; i < 4; ++i) p_s[h * 256 + lane + 64 * i] = v[i] * inv; }
    LDS_WAIT();
    float cx[8][2];
#pragma unroll
    for (int h = 0; h < 8; ++h) { cx[h][0] = 0.f; cx[h][1] = 0.f; }
    for (int k = 0; k < nsel; ++k) { const int s = sel_s[k]; const unsigned w = *(const GAS unsigned*)(F.KV + (size_t)(b * SEQ + s) * CL + 2 * lane); const float k0 = bflo(w), k1 = bfhi(w);
#pragma unroll
        for (int h = 0; h < 8; ++h) { const float p = p_s[h * 256 + k]; cx[h][0] += p * k0; cx[h][1] += p * k1; } }
#pragma unroll
    for (int h = 0; h < 8; ++h) { qa_s[h * 128 + 2 * lane] = cx[h][0]; qa_s[h * 128 + 2 * lane + 1] = cx[h][1]; }
    LDS_WAIT();
    float o8[8]; float ss = 0.f;
#pragma unroll
    for (int h = 0; h < 8; ++h) { float a = 0.f; const float* w = F.in[I_WUV] + h * 64 + lane;
        for (int c = 0; c < 128; ++c) a += qa_s[h * 128 + c] * w[(size_t)c * 512];
        o8[h] = a; ss += a * a; }
    const float rstd = 1.f / sqrtf(wave_sum(ss) * (1.f / 512.f) + EPS);
#pragma unroll
    for (int h = 0; h < 8; ++h) F.MIX[(size_t)m * D + h * 64 + lane] = (bf16)f2bf(o8[h] * rstd * F.in[I_NATT][h * 64 + lane]);
    LDS_WAIT();
}
__device__ __forceinline__ void naive_attn_phase(Frame& F) {
    LAS float* L = (LAS float*)(F.lds + RING_OFF + F.wave * 16384);
    const int gw = F.vcu * NWAVES + F.wave, NGW = F.G * NWAVES;
    for (int idx = gw; idx < M; idx += NGW) { const int b = idx >> 11, tt = idx & (SEQ - 1), t = (b & 1) ? (SEQ - 1 - tt) : tt; naive_attn_query(F, b * SEQ + t, L); }
}

namespace idx {
typedef short bf16x8 __attribute__((ext_vector_type(8)));
typedef float f32x16 __attribute__((ext_vector_type(16)));
constexpr int CHUNK_KEYS = 256, CHUNK_BYTES = CHUNK_KEYS * 128;
__device__ __forceinline__ unsigned sortable(float s) { const unsigned u = __float_as_uint(s); return u ^ ((unsigned)((int)u >> 31) | 0x80000000u); }
__device__ __forceinline__ float relu_i(float x) { const int i = __float_as_int(x); return __int_as_float(i > 0 ? i : 0); }
__device__ __forceinline__ int half_sum(int v, int hi) {
    v += __builtin_amdgcn_update_dpp(0, v, 0x111, 0xf, 0xf, false);
    v += __builtin_amdgcn_update_dpp(0, v, 0x112, 0xf, 0xf, false);
    v += __builtin_amdgcn_update_dpp(0, v, 0x114, 0xf, 0xf, false);
    v += __builtin_amdgcn_update_dpp(0, v, 0x118, 0xf, 0xf, false);
    v += __builtin_amdgcn_update_dpp(0, v, 0x142, 0xa, 0xf, false);
    const int lo = __builtin_amdgcn_readlane(v, 31), up = __builtin_amdgcn_readlane(v, 63);
    return hi ? up : lo;
}
#define IDX_CNT4(x0, y0, x1, y1) do { unsigned long long t0_, t1_, t2_, t3_; asm volatile( \
        "v_cmp_ge_u32_e64 %2, %6, %10\n\tv_cmp_ge_u32_e64 %3, %7, %11\n\tv_cmp_ge_u32_e64 %4, %8, %10\n\tv_cmp_ge_u32_e64 %5, %9, %11\n\t" \
        "v_addc_co_u32_e64 %0, %2, 0, %0, %2\n\tv_addc_co_u32_e64 %1, %3, 0, %1, %3\n\tv_addc_co_u32_e64 %0, %4, 0, %0, %4\n\tv_addc_co_u32_e64 %1, %5, 0, %1, %5" \
        : "+v"(cnt0), "+v"(cnt1), "=&s"(t0_), "=&s"(t1_), "=&s"(t2_), "=&s"(t3_) : "v"(x0), "v"(y0), "v"(x1), "v"(y1), "v"(c0), "v"(c1)); } while (0)
#define IDX_WL(dst, val, ln) asm volatile("v_writelane_b32 %0, %1, %2" : "+v"(dst) : "s"(val), "i"(ln))
#define IDX_FOR_KB(...) _Pragma("unroll") for (int g_ = 0; g_ < 8; ++g_) { if (8 * g_ <= qb) { _Pragma("unroll") for (int k_ = 0; k_ < 8; ++k_) { const int kb = 8 * g_ + k_; __VA_ARGS__ } } }
#define IDX_FOR_KB2(...) _Pragma("unroll") for (int g_ = 0; g_ < 8; ++g_) { if (8 * g_ <= qb) { _Pragma("unroll") for (int k_ = 0; k_ < 8; k_ += 2) { const int kb = 8 * g_ + k_; __VA_ARGS__ } } }
__device__ __forceinline__ void idx_unit(Frame& F, int b, int qb, LAS unsigned char* lds) {
    const int tid = F.tid, lane = F.lane, w = F.wave, r32 = lane & 31, hi = lane >> 5;
    const int q0 = 32 * qb; const size_t rowbase = (size_t)b * SEQ;
    const int ri = (r32 & 3) + 4 * (r32 >> 3), hii = (r32 >> 2) & 1;
    const bf16* arow = F.PROJ + (rowbase + q0 + 4 * w + 2 * hii + (ri >> 3)) * NPROJ + PQI + (ri & 7) * 64 + 8 * hi;
    bf16x8 A[4];
#pragma unroll
    for (int s = 0; s < 4; ++s) A[s] = *(const GAS bf16x8*)(arow + 16 * s);
    float wv[2][8];
#pragma unroll
    for (int qq = 0; qq < 2; ++qq) { ld8bf(F.PROJ + (rowbase + q0 + 4 * w + 2 * hi + qq) * NPROJ + PWI, wv[qq]);
#pragma unroll
        for (int h = 0; h < 8; ++h) wv[qq][h] *= IDX_SCALE; }
    const int lim0 = 4 * w + 2 * hi;
    unsigned sc[64][2];
#pragma unroll
    for (int p = 0; p < 64; ++p) { sc[p][0] = 0u; sc[p][1] = 0u; }
    const bf16* kptr = F.PROJ + (rowbase + 32 * w + (lane >> 3)) * NPROJ + PKI;
    unsigned coff[4];
#pragma unroll
    for (int i = 0; i < 4; ++i) coff[i] = (unsigned)((((lane & 7) ^ ((4 * i + (lane >> 4)) & 7)) * 8) + 8 * i * NPROJ);
#define IDX_DMA(bufb) do { _Pragma("unroll") for (int i_ = 0; i_ < 4; ++i_) __builtin_amdgcn_global_load_lds((const unsigned*)(kptr + coff[i_]), (LAS unsigned*)(lds + (bufb) + (4 * w + i_) * 1024), 16, 0, 0); \
        kptr += (size_t)CHUNK_KEYS * NPROJ; } while (0)
    unsigned boff[4];
#pragma unroll
    for (int s = 0; s < 4; ++s) boff[s] = (unsigned)(r32 * 128 + (((2 * s + hi) ^ ((r32 >> 1) & 7)) << 4));
    IDX_DMA(0);
    const int nch = (qb >> 3) + 1;
#pragma unroll 1
    for (int ch = 0; ch < nch; ++ch) {
        asm volatile("s_waitcnt vmcnt(0)" ::: "memory");
        __syncthreads();
        const int cb = (ch & 1) * CHUNK_BYTES;
        if (ch + 1 < nch) IDX_DMA(CHUNK_BYTES - cb);
#pragma unroll
        for (int p = 63; p >= 8; --p) { sc[p][0] = sc[p - 8][0]; sc[p][1] = sc[p - 8][1]; }
#pragma unroll
        for (int k = 0; k < 8; ++k) {
            f32x16 acc = {};
#pragma unroll
            for (int s = 0; s < 4; ++s) { const bf16x8 B = *(const LAS bf16x8*)(lds + cb + boff[s] + k * 4096);
                acc = __builtin_amdgcn_mfma_f32_32x32x16_bf16(A[s], B, acc, 0, 0, 0); }
            float s0 = 0.f, s1 = 0.f;
#pragma unroll
            for (int h = 0; h < 8; ++h) { s0 = fmaf(relu_i(acc[h]), wv[0][h], s0); s1 = fmaf(relu_i(acc[8 + h]), wv[1][h], s1); }
            unsigned u0 = sortable(s0), u1 = sortable(s1);
            const int kb = 8 * ch + k;
            if (kb >= qb) { if (kb > qb || r32 > lim0) u0 = 0u; if (kb > qb || r32 > lim0 + 1) u1 = 0u; }
            sc[k][0] = u0; sc[k][1] = u1;
            __builtin_amdgcn_sched_barrier(0);
        }
    }
    __syncthreads();
    unsigned T0 = 1u, T1 = 1u; bool d0 = true, d1 = true;
    if (qb >= 8) {
        T0 = 0u; T1 = 0u; d0 = false; d1 = false;
#pragma unroll 1
        for (int bit = 31; bit >= 0; --bit) {
            const unsigned c0 = T0 | (1u << bit), c1 = T1 | (1u << bit); int cnt0 = 0, cnt1 = 0;
            IDX_FOR_KB2( IDX_CNT4(sc[kb][0], sc[kb][1], sc[kb + 1][0], sc[kb + 1][1]); )
            const int cnt = half_sum(cnt0 | (cnt1 << 16), hi);
            const int n0 = cnt & 0xffff, n1 = cnt >> 16;
            if (!d0 && n0 >= TOPK) { T0 = c0; d0 = (n0 == TOPK); }
            if (!d1 && n1 >= TOPK) { T1 = c1; d1 = (n1 == TOPK); }
            if (__all(d0 && d1)) break;
        }
    }
    unsigned mw0 = 0u, mw1 = 0u, mw2 = 0u, mw3 = 0u;
    if (__all(d0 && d1)) {
        IDX_FOR_KB( const unsigned long long m0 = __ballot(sc[kb][0] >= T0), m1 = __ballot(sc[kb][1] >= T1);
            IDX_WL(mw0, (unsigned)m0, kb); IDX_WL(mw2, (unsigned)(m0 >> 32), kb);
            IDX_WL(mw1, (unsigned)m1, kb); IDX_WL(mw3, (unsigned)(m1 >> 32), kb); )
    } else {
        int cg = 0;
        IDX_FOR_KB( cg += (sc[kb][0] > T0 ? 1 : 0) + (sc[kb][1] > T1 ? 65536 : 0); )
        cg = half_sum(cg, hi);
        const int need0 = d0 ? (1 << 20) : TOPK - (cg & 0xffff), need1 = d1 ? (1 << 20) : TOPK - (cg >> 16);
        int taken0 = 0, taken1 = 0; const unsigned lt = (1u << r32) - 1u;
#pragma unroll
        for (int g_ = 7; g_ >= 0; --g_) { if (g_ < nch) {
#pragma unroll
            for (int k_ = 0; k_ < 8; ++k_) { const int kb = 8 * g_ + k_;
                const bool e0 = sc[kb][0] == T0, e1 = sc[kb][1] == T1;
                const unsigned long long em0 = __ballot(e0), em1 = __ballot(e1);
                const unsigned h0 = hi ? (unsigned)(em0 >> 32) : (unsigned)em0, h1 = hi ? (unsigned)(em1 >> 32) : (unsigned)em1;
                const bool s0 = sc[kb][0] > T0 || (e0 && taken0 + __popc(h0 & lt) < need0), s1 = sc[kb][1] > T1 || (e1 && taken1 + __popc(h1 & lt) < need1);
                taken0 += __popc(h0); taken1 += __popc(h1);
                const unsigned long long m0 = __ballot(s0), m1 = __ballot(s1);
                IDX_WL(mw0, (unsigned)m0, kb); IDX_WL(mw2, (unsigned)(m0 >> 32), kb);
                IDX_WL(mw1, (unsigned)m1, kb); IDX_WL(mw3, (unsigned)(m1 >> 32), kb); } } }
    }
    const int kbl = (lane < 8 * nch) ? 8 * (nch - 1 - (lane >> 3)) + (lane & 7) : lane;
    unsigned* mrow = F.MASK + (rowbase + q0 + 4 * w) * 64 + kbl;
    mrow[0] = mw0; mrow[64] = mw1; mrow[128] = mw2; mrow[192] = mw3;
#undef IDX_DMA
}
#undef IDX_FOR_KB
#undef IDX_FOR_KB2
#undef IDX_WL
#undef IDX_CNT4
__device__ __forceinline__ void idx_phase(Frame& F) {
    for (int v2 = 2 * F.vcu; v2 < 512; v2 += 2 * F.G)
        for (int u = 0; u < 2 * (1 + ((REP_MASK >> 5) & 1)); ++u) { const int v = v2 >> 1, b = v >> 5, j = v & 31; idx_unit(F, b, (u & 1) ? j : 63 - j, F.lds + RING_OFF); }
}
}

namespace att {
typedef short bf16x8 __attribute__((ext_vector_type(8)));
typedef short s16x4 __attribute__((ext_vector_type(4)));
typedef float f32x16 __attribute__((ext_vector_type(16)));
typedef unsigned u32x4 __attribute__((ext_vector_type(4)));
typedef float f32x2_t __attribute__((ext_vector_type(2))); typedef __bf16 bf16x2_t __attribute__((ext_vector_type(2)));
constexpr float LOG2E = 1.4426950408889634f;
constexpr int L_K = 0, L_V = 32768, L_TBL = 65536, TBL_N = 320, L_MASK = L_TBL + 8 * TBL_N * 4, MROW = 66, L_RMS = L_MASK + 32 * MROW * 4, L_END = L_RMS + 8 * 32 * 4;
static_assert(L_END <= RING_BYTES, "attention LDS map");
#define ATT_KSWZ(row, colB) ((row) * 256 + ((colB) ^ (((row) & 7) << 4)))
#define ATT_SBAR() __builtin_amdgcn_sched_barrier(0)
__device__ __forceinline__ unsigned cvtpk(float lo, float hi) { f32x2_t v = {lo, hi}; bf16x2_t b = __builtin_convertvector(v, bf16x2_t); return __builtin_bit_cast(unsigned, b); }
__device__ __forceinline__ int v_st(int k, int c) { const int kk = (k & ~0xC) | ((k & 4) << 1) | ((k & 8) >> 1); return ((kk >> 3) * 4 + (c >> 5)) * 512 + ((kk & 7) * 32 + (c & 31)) * 2; }
__device__ __forceinline__ int v_rd_base(int lane) { return ((lane & 3) << 3) | (((lane >> 2) & 3) << 6) | (((lane >> 4) & 1) << 5) | (((lane >> 5) & 1) << 8); }
constexpr int v_rd_off(int d0, int ks, int half) { return d0 * 512 + ks * 4096 + half * 2048; }
template <int OFF> __device__ __forceinline__ s16x4 tr_read(int vb) { s16x4 r; asm volatile("ds_read_b64_tr_b16 %0, %1 offset:%2" : "=&v"(r) : "v"(vb), "i"(OFF) : "memory"); return r; }
template <int D0> __device__ __forceinline__ void pv_one(f32x16& od, int vb, bf16x8 pa0, bf16x8 pa1, bf16x8 pa2, bf16x8 pa3) {
    const s16x4 l0 = tr_read<v_rd_off(D0, 0, 0)>(vb), h0 = tr_read<v_rd_off(D0, 0, 1)>(vb), l1 = tr_read<v_rd_off(D0, 1, 0)>(vb), h1 = tr_read<v_rd_off(D0, 1, 1)>(vb);
    const s16x4 l2 = tr_read<v_rd_off(D0, 2, 0)>(vb), h2 = tr_read<v_rd_off(D0, 2, 1)>(vb), l3 = tr_read<v_rd_off(D0, 3, 0)>(vb), h3 = tr_read<v_rd_off(D0, 3, 1)>(vb);
    asm volatile("s_waitcnt lgkmcnt(0)" ::: "memory"); ATT_SBAR();
#define ATT_PK(L, H) (bf16x8){L[0], L[1], L[2], L[3], H[0], H[1], H[2], H[3]}
    od = __builtin_amdgcn_mfma_f32_32x32x16_bf16(ATT_PK(l0, h0), pa0, od, 0, 0, 0);
    od = __builtin_amdgcn_mfma_f32_32x32x16_bf16(ATT_PK(l1, h1), pa1, od, 0, 0, 0);
    od = __builtin_amdgcn_mfma_f32_32x32x16_bf16(ATT_PK(l2, h2), pa2, od, 0, 0, 0);
    od = __builtin_amdgcn_mfma_f32_32x32x16_bf16(ATT_PK(l3, h3), pa3, od, 0, 0, 0);
#undef ATT_PK
}
__device__ __forceinline__ bf16x8 pack8(const f32x16& x, int s, float sc) {
    u32x4 w = {cvtpk(x[8 * s] * sc, x[8 * s + 1] * sc), cvtpk(x[8 * s + 2] * sc, x[8 * s + 3] * sc), cvtpk(x[8 * s + 4] * sc, x[8 * s + 5] * sc), cvtpk(x[8 * s + 6] * sc, x[8 * s + 7] * sc)};
    return __builtin_bit_cast(bf16x8, w);
}
__device__ __forceinline__ void attn_tables(Frame& F, LAS unsigned char* lds) {
    LAS float* tbl = (LAS float*)(lds + L_TBL);
    for (int i = F.tid; i < 8 * TBL_N; i += NWAVES * 64) { const int h = i / TBL_N, dist = 255 - (i % TBL_N); tbl[i] = dist >= 0 ? F.in[I_RELB][rel_bucket(dist) * 8 + h] * LOG2E : 0.f; }
    __syncthreads();
}
__device__ __forceinline__ void attn_unit(Frame& F, int b, int qb, LAS unsigned char* lds) {
    const int tid = F.tid, lane = F.lane, h = F.wave, r32 = lane & 31, hi = lane >> 5;
    const int q0 = 32 * qb, NT = (qb >> 1) + 1; const size_t rowbase = (size_t)b * SEQ;
    LAS unsigned* msk = (LAS unsigned*)(lds + L_MASK); const LAS float* tbl = (const LAS float*)(lds + L_TBL); LAS float* rms = (LAS float*)(lds + L_RMS);
#pragma unroll
    for (int i = 0; i < 4; ++i) { const int wd = tid + 512 * i; msk[(wd >> 6) * MROW + (wd & 63)] = F.MASK[(rowbase + q0 + (wd >> 6)) * 64 + (wd & 63)]; }
    bf16x8 qr[8];
    {
        bf16x8 Bq[4];
        const bf16* qrow = F.PROJ + (rowbase + q0 + r32) * NPROJ + PQ + h * 64 + 8 * hi;
#pragma unroll
        for (int s = 0; s < 4; ++s) Bq[s] = *(const GAS bf16x8*)(qrow + 16 * s);
        const int ri = (r32 & 3) + 4 * (r32 >> 3), hii = (r32 >> 2) & 1;
#pragma unroll
        for (int cb = 0; cb < 4; ++cb) { const int c = 32 * cb + 16 * (ri >> 3) + 8 * hii + (ri & 7); const bf16* wrow = F.Wuk + ((size_t)c * 8 + h) * 64 + 8 * hi;
            f32x16 acc = {};
#pragma unroll
            for (int s = 0; s < 4; ++s) acc = __builtin_amdgcn_mfma_f32_32x32x16_bf16(*(const GAS bf16x8*)(wrow + 16 * s), Bq[s], acc, 0, 0, 0);
            qr[2 * cb] = pack8(acc, 0, 0.125f * LOG2E); qr[2 * cb + 1] = pack8(acc, 1, 0.125f * LOG2E); }
    }
    const float b31 = F.in[I_RELB][31 * 8 + h] * LOG2E;
    const int sr = tid >> 4, scol = (tid & 15) * 8, vst0 = v_st(sr, scol), vst1 = v_st(32 + sr, scol);
    const int vb0 = (int)(unsigned)(uintptr_t)(lds + L_V) + v_rd_base(lane);
    const bf16* kvb = F.KV + rowbase * CL + (size_t)sr * CL + scol;
    v4u st0, st1;
#define ATT_SLOAD(k0) do { st0 = *(const GAS v4u*)(kvb + (size_t)(k0) * CL); st1 = *(const GAS v4u*)(kvb + (size_t)((k0) + 32) * CL); } while (0)
#define ATT_SWRITE(bf) do { *(LAS v4u*)(lds + L_V + (bf) * 16384 + vst0) = st0; *(LAS v4u*)(lds + L_V + (bf) * 16384 + vst1) = st1; \
        *(LAS v4u*)(lds + L_K + (bf) * 16384 + ATT_KSWZ(sr, scol * 2)) = st0; *(LAS v4u*)(lds + L_K + (bf) * 16384 + ATT_KSWZ(32 + sr, scol * 2)) = st1; } while (0)
    float m_run = -INFINITY, l_run = 0.f; f32x16 o[4] = {};
    ATT_SLOAD(0); ATT_SWRITE(0); __syncthreads();
    for (int j = 0; j < NT; ++j) {
        const int buf = j & 1, k0 = 64 * j;
        if (j + 1 < NT) ATT_SLOAD(k0 + 64);
        f32x16 p0 = {}, p1 = {};
        { const LAS unsigned char* Ks = lds + L_K + buf * 16384;
#pragma unroll
          for (int d0 = 0; d0 < 8; ++d0) { const int cbyte = (d0 * 16 + hi * 8) * 2;
              const bf16x8 k0f = *(const LAS bf16x8*)(Ks + ATT_KSWZ(r32, cbyte)), k1f = *(const LAS bf16x8*)(Ks + ATT_KSWZ(32 + r32, cbyte));
              p0 = __builtin_amdgcn_mfma_f32_32x32x16_bf16(k0f, qr[d0], p0, 0, 0, 0); p1 = __builtin_amdgcn_mfma_f32_32x32x16_bf16(k1f, qr[d0], p1, 0, 0, 0); } }
        const unsigned long long mwd = *(const LAS unsigned long long*)(msk + r32 * MROW + 2 * j);
        const unsigned w0 = (unsigned)mwd >> (4 * hi), w1 = (unsigned)(mwd >> 32) >> (4 * hi);
        const bool far = (k0 + 176 <= q0);
        if (!far) { const LAS float* tb = tbl + h * TBL_N + (255 - (q0 + r32) + k0 + 4 * hi);
#pragma unroll
            for (int r = 0; r < 16; ++r) { p0[r] += tb[(r & 3) + 8 * (r >> 2)]; p1[r] += tb[32 + (r & 3) + 8 * (r >> 2)]; } }
        float rm = fmaxf(p0[0], p1[0]);
#pragma unroll
        for (int r = 1; r < 16; ++r) rm = fmaxf(rm, fmaxf(p0[r], p1[r]));
        { auto rr = __builtin_amdgcn_permlane32_swap(__float_as_uint(rm), __float_as_uint(rm), false, false); rm = fmaxf(__uint_as_float(rr[0]), __uint_as_float(rr[1])); }
        const float boff = far ? b31 : 0.f, mnew = fmaxf(m_run, rm + boff), alpha = __builtin_amdgcn_exp2f(m_run - mnew), off = mnew - boff;
        m_run = mnew;
        float ps = 0.f;
#pragma unroll
        for (int r = 0; r < 16; ++r) { const int pos = (r & 3) + 8 * (r >> 2);
            const unsigned e0 = __float_as_uint(__builtin_amdgcn_exp2f(p0[r] - off)) & (unsigned)(((int)(w0 << (31 - pos))) >> 31);
            const unsigned e1 = __float_as_uint(__builtin_amdgcn_exp2f(p1[r] - off)) & (unsigned)(((int)(w1 << (31 - pos))) >> 31);
            p0[r] = __uint_as_float(e0); p1[r] = __uint_as_float(e1); ps += p0[r] + p1[r]; }
        { auto rr = __builtin_amdgcn_permlane32_swap(__float_as_uint(ps), __float_as_uint(ps), false, false); ps = __uint_as_float(rr[0]) + __uint_as_float(rr[1]); }
        l_run = l_run * alpha + ps;
        if (__any(alpha < 1.f)) {
#pragma unroll
            for (int d = 0; d < 4; ++d)
#pragma unroll
                for (int r = 0; r < 16; ++r) o[d][r] *= alpha; }
        bf16x8 pa0, pa1, pa2, pa3;
#define ATT_PK4(P, BASE, OUT) do { unsigned a0 = cvtpk(P[BASE + 0], P[BASE + 1]), a1 = cvtpk(P[BASE + 2], P[BASE + 3]);   \
        unsigned b0 = cvtpk(P[BASE + 4], P[BASE + 5]), b1 = cvtpk(P[BASE + 6], P[BASE + 7]);                              \
        auto r0 = __builtin_amdgcn_permlane32_swap(a0, b0, false, false); auto r1 = __builtin_amdgcn_permlane32_swap(a1, b1, false, false); \
        u32x4 w_ = {r0[0], r1[0], r0[1], r1[1]}; OUT = __builtin_bit_cast(bf16x8, w_); } while (0)
        ATT_PK4(p0, 0, pa0); ATT_PK4(p0, 8, pa1); ATT_PK4(p1, 0, pa2); ATT_PK4(p1, 8, pa3);
#undef ATT_PK4
        ATT_SBAR();
        { const int vb = vb0 + buf * 16384;
          pv_one<0>(o[0], vb, pa0, pa1, pa2, pa3); pv_one<1>(o[1], vb, pa0, pa1, pa2, pa3); pv_one<2>(o[2], vb, pa0, pa1, pa2, pa3); pv_one<3>(o[3], vb, pa0, pa1, pa2, pa3); }
        if (j + 1 < NT) ATT_SWRITE(buf ^ 1);
        __syncthreads();
    }
    const float inv = 1.f / l_run;
    f32x16 ot[2] = {};
#pragma unroll
    for (int cb = 0; cb < 4; ++cb)
#pragma unroll
        for (int s = 0; s < 2; ++s) { const bf16x8 Bo = pack8(o[cb], s, inv);
#pragma unroll
            for (int db = 0; db < 2; ++db) { const bf16* wp = F.WuvT + ((size_t)(h * 64 + 32 * db + r32)) * CL + 32 * cb + 16 * s + 4 * hi;
                const s16x4 lo = *(const GAS s16x4*)wp, hi4 = *(const GAS s16x4*)(wp + 8);
                ot[db] = __builtin_amdgcn_mfma_f32_32x32x16_bf16((bf16x8){lo[0], lo[1], lo[2], lo[3], hi4[0], hi4[1], hi4[2], hi4[3]}, Bo, ot[db], 0, 0, 0); } }
    float ss = 0.f;
#pragma unroll
    for (int r = 0; r < 16; ++r) ss += ot[0][r] * ot[0][r] + ot[1][r] * ot[1][r];
    { auto rr = __builtin_amdgcn_permlane32_swap(__float_as_uint(ss), __float_as_uint(ss), false, false); ss = __uint_as_float(rr[0]) + __uint_as_float(rr[1]); }
    if (hi == 0) rms[h * 32 + r32] = ss;
    __syncthreads();
    float tot = 0.f;
#pragma unroll
    for (int hh = 0; hh < 8; ++hh) tot += rms[hh * 32 + r32];
    const float rstd = 1.f / sqrtf(tot * (1.f / 512.f) + EPS);
    bf16* orow = F.MIX + (rowbase + q0 + r32) * D + h * 64 + 4 * hi; const float* gn = F.in[I_NATT] + h * 64 + 4 * hi;
#pragma unroll
    for (int db = 0; db < 2; ++db)
#pragma unroll
        for (int g4 = 0; g4 < 4; ++g4) { const int dd = 32 * db + 8 * g4; const f32x4 gv = *(const GAS f32x4*)(gn + dd);
            const unsigned x0 = cvtpk(ot[db][4 * g4] * rstd * gv.x, ot[db][4 * g4 + 1] * rstd * gv.y), x1 = cvtpk(ot[db][4 * g4 + 2] * rstd * gv.z, ot[db][4 * g4 + 3] * rstd * gv.w);
            *(GAS unsigned long long*)(orow + dd) = (unsigned long long)x0 | ((unsigned long long)x1 << 32); }
    __syncthreads();
#undef ATT_SLOAD
#undef ATT_SWRITE
}
__device__ __forceinline__ void attn_phase(Frame& F) {
    attn_tables(F, F.lds + RING_OFF);
    for (int v2 = 2 * F.vcu; v2 < 512; v2 += 2 * F.G)
        for (int u = 0; u < 2 * (1 + ((REP_MASK >> 6) & 1)); ++u) { const int v = v2 >> 1, b = v >> 5, j = v & 31; attn_unit(F, b, (u & 1) ? j : 63 - j, F.lds + RING_OFF); }
}
#undef ATT_KSWZ
#undef ATT_SBAR
}

struct Args { const float* in[20]; float* out; unsigned char* ws; int ph_lo, ph_hi, li, pad; };
__global__ void __launch_bounds__(NWAVES * 64, 2) mk_fwd(Args args) {
    extern __shared__ __attribute__((aligned(16))) unsigned char lds[];
    Frame F;
    F.lds = (LAS unsigned char*)lds;
    F.MISC = (volatile LAS unsigned*)(F.lds + MISC_OFF);
    F.tid = threadIdx.x; F.lane = F.tid & 63; F.wave = __builtin_amdgcn_readfirstlane(F.tid >> 6);
    F.G = gridDim.x; { const int bx = blockIdx.x; F.vcu = (F.G % 8 == 0) ? (bx % 8) * (F.G / 8) + bx / 8 : bx; }
    unsigned char* ws = args.ws;
    F.ctl = (gu32*)(ws + WS_CTL);
#pragma unroll
    for (int i = 0; i < 20; ++i) F.in[i] = args.in[i];
    F.out = args.out;
    F.Wgu1 = (bf16*)(ws + WS_WGU1); F.Wd1 = (bf16*)(ws + WS_WD1); F.Win = (bf16*)(ws + WS_WIN); F.Wout = (bf16*)(ws + WS_WOUT); F.Wgu2 = (bf16*)(ws + WS_WGU2); F.Wd2 = (bf16*)(ws + WS_WD2);
    F.Wuk = (bf16*)(ws + WS_WUK); F.WuvT = (bf16*)(ws + WS_WUV);
    F.XN = (bf16*)(ws + WS_XN); F.MIX = (bf16*)(ws + WS_MIX); F.KV = (bf16*)(ws + WS_KV); F.ACT = (bf16*)(ws + WS_ACT); F.PROJ = (bf16*)(ws + WS_ACT); F.MASK = (unsigned*)(ws + WS_MASK); F.SS = (float*)(ws + WS_SS); F.HB = (bf16*)(ws + WS_HB);
    for (int u = F.tid; u < (LDS_BYTES - LDSCTL_OFF) / 4; u += NWAVES * 64) ((LAS unsigned*)(F.lds + LDSCTL_OFF))[u] = 0u;
    __syncthreads();
    XcdBarrier bar; bar.bar = (unsigned*)(F.ctl + CW_BAR); bar.x = 0; bar.st = nullptr;
    if (N_LAUNCHES != PER_PHASE) bar = xcd_barrier_post((unsigned*)(F.ctl + CW_BAR), F.MISC + 8);

    const int lo = args.ph_lo, hi = args.ph_hi;
#ifndef PH_MASK
#define PH_MASK 0xFFF
#endif
#define IN(k) (((PH_MASK >> (k)) & 1) && lo <= (k) && (k) < hi)
#define SEAM(k) do { if (IN(k) && (k) + 1 < hi) { xcd_barrier(bar); if (REP_MASK & 0x2000) xcd_barrier(bar); } } while (0)

    if (IN(0)) { p0_prologue(F); if (REP_MASK & 1) { VM_WAIT(); __syncthreads(); p0_prologue(F); } SEAM(0); }
    if (IN(1)) { pg8::Gemm g{F.XN, F.Wgu1, M, FF2, FFN1_FP8 ? D / 2 : D}; pg8::StaticOrder S; S.init(M, FF2, F.G, (int)blockIdx.x, 1 + ((REP_MASK >> 1) & 1));
        pg8::EpiSwiglu<FFN1_FP8 != 0> E{F.ACT, FF, F.SS, 1.0f / D, EPS, FFN1_FP8 ? 1.0f / WSC_GU : 1.0f};
        pg8::gemm_phase<pg8::EpiSwiglu<FFN1_FP8 != 0>, pg8::StaticOrder, PG8_ALIGN, PG8_SP2, FFN1_FP8 != 0>(F.lds + RING_OFF, g, S, E); SEAM(1); }
    if (IN(2)) { pg8::Gemm g{F.ACT, F.Wd1, M, D, FFN1_FP8 ? FF / 2 : FF}; pg8::StaticOrder S; S.init(M, D, F.G, (int)blockIdx.x, 1 + ((REP_MASK >> 2) & 1));
        pg8::EpiRes2<false, false, true> E{F.in[I_X], F.HB, nullptr, F.SS, D, FFN1_FP8 ? 0.5f / WSC_DN : 0.5f};
        pg8::gemm_phase<pg8::EpiRes2<false, false, true>, pg8::StaticOrder, PG8_ALIGN, PG8_SP2, FFN1_FP8 != 0>(F.lds + RING_OFF, g, S, E); SEAM(2); }
    if (IN(4)) { pg8::Gemm g{F.HB, F.Win, M, NPROJ, D}; pg8::StaticOrder S; S.init(M, NPROJ, F.G, (int)blockIdx.x, 1 + ((REP_MASK >> 4) & 1));
        pg8::EpiBf16Rs E{F.PROJ, NPROJ, F.SS, 1.0f / D, EPS};
        pg8::gemm_phase<pg8::EpiBf16Rs, pg8::StaticOrder, PG8_ALIGN, PG8_SP2>(F.lds + RING_OFF, g, S, E); SEAM(4); }
#ifndef USE_NAIVE_ATTN
#define USE_NAIVE_ATTN 0
#endif
    if (IN(5)) { prep_phase(F); if (REP_MASK & 0x1000) prep_phase(F); if (!USE_NAIVE_ATTN) idx::idx_phase(F); SEAM(5); }
    if (IN(6)) { if (USE_NAIVE_ATTN) naive_attn_phase(F); else att::attn_phase(F); SEAM(6); }
    if (IN(7)) { pg8::Gemm g{F.MIX, F.Wout, M, D, D}; pg8::StaticOrder S; S.init(M, D, F.G, (int)blockIdx.x);
        pg8::EpiRes2<true, true, true> E{F.HB, F.HB, (unsigned char*)F.XN, F.SS, D, 1.0f};
        pg8::gemm_phase<pg8::EpiRes2<true, true, true>, pg8::StaticOrder, PG8_ALIGN, PG8_SP2>(F.lds + RING_OFF, g, S, E); SEAM(7); }
    if (IN(9)) { pg8::Gemm g{F.XN, F.Wgu2, M, FF2, D / 2}; pg8::StaticOrder S; S.init(M, FF2, F.G, (int)blockIdx.x);
        pg8::EpiSwiglu<true> E{F.ACT, FF, F.SS, 1.0f / D, EPS, 1.0f / WSC_GU};
        pg8::gemm_phase<pg8::EpiSwiglu<true>, pg8::StaticOrder, PG8_ALIGN, PG8_SP2, true>(F.lds + RING_OFF, g, S, E); SEAM(9); }
    if (IN(10)) { pg8::Gemm g{F.ACT, F.Wd2, M, D, FF / 2}; pg8::StaticOrder S; S.init(M, D, F.G, (int)blockIdx.x);
        pg8::EpiRes2<true, false, false> E{F.HB, F.HB, nullptr, nullptr, D, 0.5f / WSC_DN};
        pg8::gemm_phase<pg8::EpiRes2<true, false, false>, pg8::StaticOrder, PG8_ALIGN, PG8_SP2, true>(F.lds + RING_OFF, g, S, E); SEAM(10); }
    if (IN(11)) { const bool poison = __hip_atomic_load((gu32*)(F.ctl + CW_BAR + XB_TMO), RLX_AGENT) != 0u;
        const int gw = F.vcu * NWAVES + F.wave, NGW = F.G * NWAVES;
        for (int m = gw; m < M; m += NGW) rms_row_bf16_to_f32(F.lane, F.HB + (size_t)m * D, F.in[I_NF], F.out + (size_t)m * D, poison); }
#undef IN
#undef SEAM
}

extern "C" void kernel_launch(void* const* d_in, const int* in_sizes, int n_in, void* d_out, int out_size, void* d_ws, size_t ws_size, hipStream_t stream) {
    static int grid = 0;
    if (grid == 0) {
        if (n_in != 20 || in_sizes[0] != M * D || out_size != M * D || ws_size < WS_END) { fprintf(stderr, "kernel_launch: shape mismatch (n_in %d, in0 %d, out %d, ws %zu); nothing launched\n", n_in, n_in > 0 ? in_sizes[0] : -1, out_size, ws_size); grid = -1; return; }
        int dev = 0, cus = 0, per_cu = 0;
        if (hipGetDevice(&dev) != hipSuccess || hipDeviceGetAttribute(&cus, hipDeviceAttributeMultiprocessorCount, dev) != hipSuccess) { fprintf(stderr, "kernel_launch: hipGetDevice / hipDeviceGetAttribute failed\n"); grid = -1; return; }
        if (hipFuncSetAttribute((const void*)mk_fwd, hipFuncAttributeMaxDynamicSharedMemorySize, LDS_BYTES) != hipSuccess) { fprintf(stderr, "kernel_launch: hipFuncSetAttribute failed\n"); grid = -1; return; }
        if (hipOccupancyMaxActiveBlocksPerMultiprocessor(&per_cu, (const void*)mk_fwd, NWAVES * 64, LDS_BYTES) != hipSuccess || per_cu < 1)
            fprintf(stderr, "kernel_launch: note: occupancy query reports %d workgroups per CU\n", per_cu);
        (void)hipGetLastError();
        grid = cus;
    }
    if (grid < 0) return;
    if (hipMemsetAsync((char*)d_ws + WS_CTL, 0, CTL_ZERO_BYTES, stream) != hipSuccess) { fprintf(stderr, "kernel_launch: hipMemsetAsync failed\n"); return; }
    Args a{};
    for (int i = 0; i < 20; ++i) a.in[i] = (const float*)d_in[i];
    a.out = (float*)d_out; a.ws = (unsigned char*)d_ws;
    for (int li = 0; li < N_LAUNCHES; ++li) {
        a.ph_lo = (N_LAUNCHES == PER_PHASE) ? li : 0; a.ph_hi = (N_LAUNCHES == PER_PHASE) ? li + 1 : PER_PHASE; a.li = li;
        hipLaunchKernelGGL(mk_fwd, dim3(grid), dim3(NWAVES * 64), LDS_BYTES, stream, a);
        const hipError_t le = hipPeekAtLastError();
        if (le != hipSuccess) { fprintf(stderr, "kernel_launch: launch %d failed: %s\n", li, hipGetErrorName(le)); break; }
    }
}
```

```cpp
#include <hip/hip_runtime.h>
#include <cstdio>
#include <cstdint>
namespace pg8 {
#define PG8_LAS __attribute__((address_space(3)))
typedef unsigned short bf16_t;
typedef short bf16x8 __attribute__((ext_vector_type(8)));
typedef float f32x4 __attribute__((ext_vector_type(4)));
typedef unsigned u32x4 __attribute__((ext_vector_type(4)));
constexpr int BM = 256, BK = 64, HALF = 128, HTB = HALF * BK * 2  , STAGE_BYTES = 8 * HTB, NXCD = 8, WGM = 8;

__host__ __device__ __forceinline__ int lds_byte(int r, int c) { const int st = (r >> 4) * 2 + (c >> 5), rr = r & 15, cc = c & 31, ob = rr * 64 + cc * 2; return st * 1024 + (ob ^ (((ob >> 9) & 1) << 5)); }
__host__ __device__ __forceinline__ void stage_rc(int b, int& R, int& C) { const int st = b / 1024, sb = b % 1024, swz = sb ^ (((sb >> 9) & 1) << 5); R = (st >> 1) * 16 + swz / 64; C = (st & 1) * 32 + (swz % 64) / 2; }
__host__ __device__ __forceinline__ int perm32(int rho) { const int n = rho >> 4, i = rho & 15; return 8 * (i >> 2) + 4 * n + (i & 3); }

struct Unit { int pm, pn; };
struct Gemm { const bf16_t* A; const bf16_t* Bt; int M, N, K; };

struct StaticOrder {
    int nM, nN, nwg, G, c, rep;
    __host__ __device__ void init(int M, int N, int G_, int c_, int rep_ = 1) { nM = M / BM; nN = N / BM; nwg = nM * nN; G = G_; c = c_; rep = rep_; }
    __host__ __device__ bool next(int i, Unit& u) const {
        const long L = (long)i * G + c; if (L >= (long)nwg * rep) return false;
        int wgid = (int)(L % nwg); { const int q = nwg / NXCD, r = nwg % NXCD, xcd = wgid % NXCD, off = wgid / NXCD; wgid = (xcd < r ? xcd * (q + 1) : r * (q + 1) + (xcd - r) * q) + off; }
        const int nig = WGM * nN, gid = wgid / nig, fm = gid * WGM, gsz = (nM - fm) < WGM ? (nM - fm) : WGM;
        u.pm = fm + ((wgid % nig) % gsz); u.pn = (wgid % nig) / gsz; return true;
    }
    __device__ __forceinline__ void a_ready(const Unit&) const {}
    __device__ __forceinline__ void done(const Unit&) const {}
};

__device__ __forceinline__ unsigned cvt_pk_bf16(float lo, float hi) { unsigned r; asm volatile("v_cvt_pk_bf16_f32 %0, %1, %2" : "=v"(r) : "v"(lo), "v"(hi)); return r; }
typedef float f32x2 __attribute__((ext_vector_type(2)));
__device__ __forceinline__ f32x2 gelu_pk(f32x2 v) {
    const f32x2 av = __builtin_elementwise_abs(v), d = av * 0.2316418882f + 1.0f;
    f32x2 t; t.x = __builtin_amdgcn_rcpf(d.x); t.y = __builtin_amdgcn_rcpf(d.y);
    f32x2 q = t * 0.5307027145f + (-0.7265760135f); q = q * t + 0.7107068705f; q = q * t + (-0.142248368f); q = q * t + 0.127414796f; q = q * t;
    const f32x2 s = (v * v) * (-0.72134752044f);
    f32x2 e; e.x = __builtin_amdgcn_exp2f(s.x); e.y = __builtin_amdgcn_exp2f(s.y);
    const f32x2 m = v * (q * e), r = v - m;
    f32x2 o; o.x = v.x < 0.f ? m.x : r.x; o.y = v.y < 0.f ? m.y : r.y; return o;
}

template <int ACT  > struct EpiBf16 {
    static constexpr bool PERM = true, AFTER_DRAIN = false, UI = false; static_assert(ACT == 0 || ACT == 1, "EpiBf16: ACT is 0 (none) or 1 (gelu_pk)");
    bf16_t* O; int ldc; const float* bias; int split_cols; size_t split_stride; float scale0;
    __device__ __forceinline__ void operator()(const f32x4 (&acc)[2][2][4][2], const Unit& u, int wr, int wc, int fr, int fq) const {
        const int row0 = u.pm * BM + wr * 64 + fr; int colt = u.pn * BM; bf16_t* base = O;
        float sc = 1.f; if (split_cols) { const int t = colt / split_cols; base += (size_t)t * split_stride; colt -= t * split_cols; if (t == 0) sc = scale0; }
        const int col0 = colt + wc * 32 + 8 * fq, bcol0 = u.pn * BM + wc * 32 + 8 * fq;
        f32x4 bv[2][2];
#pragma unroll
        for (int bj = 0; bj < 2; ++bj)
#pragma unroll
            for (int n = 0; n < 2; ++n) bv[bj][n] = bias ? *(const f32x4*)(bias + bcol0 + bj * HALF + 4 * n) : (f32x4){0.f, 0.f, 0.f, 0.f};
#pragma unroll
        for (int ai = 0; ai < 2; ++ai)
#pragma unroll
            for (int m = 0; m < 4; ++m) { bf16_t* rowp = base + (size_t)(row0 + ai * HALF + m * 16) * ldc + col0;
#pragma unroll
                for (int bj = 0; bj < 2; ++bj) { f32x4 v0 = acc[ai][bj][m][0] + bv[bj][0], v1 = acc[ai][bj][m][1] + bv[bj][1];
                    if (ACT == 1) { f32x2 a = gelu_pk((f32x2){v0[0], v0[1]}), b = gelu_pk((f32x2){v0[2], v0[3]}), c = gelu_pk((f32x2){v1[0], v1[1]}), d = gelu_pk((f32x2){v1[2], v1[3]});
                        v0 = (f32x4){a.x, a.y, b.x, b.y}; v1 = (f32x4){c.x, c.y, d.x, d.y}; }
                    v0 = v0 * sc; v1 = v1 * sc; u32x4 w; w.x = cvt_pk_bf16(v0[0], v0[1]); w.y = cvt_pk_bf16(v0[2], v0[3]); w.z = cvt_pk_bf16(v1[0], v1[1]); w.w = cvt_pk_bf16(v1[2], v1[3]);
                    *(u32x4*)(rowp + bj * HALF) = w; } }
    }
};


__device__ __forceinline__ unsigned cvt4_fp8(float a, float b, float c, float d) { int w = 0; w = __builtin_amdgcn_cvt_pk_fp8_f32(a, b, w, false); w = __builtin_amdgcn_cvt_pk_fp8_f32(c, d, w, true); return (unsigned)w; }
constexpr int RT_MAX = 12;
template <class Sched> __device__ __forceinline__ void rstd_table(PG8_LAS float* tab, const Sched& S, const float* ss, float inv_n, float eps) {
    const int t = threadIdx.x; Unit u;
    for (int i = t >> 8; i < RT_MAX && S.next(i, u); i += 2) { const f32x4* p = (const f32x4*)(ss + (size_t)(u.pm * BM + (t & 255)) * 16);
        const f32x4 a = p[0], b = p[1], c = p[2], d = p[3]; const float q = ((a[0] + a[1]) + (a[2] + a[3])) + ((b[0] + b[1]) + (b[2] + b[3])) + ((c[0] + c[1]) + (c[2] + c[3])) + ((d[0] + d[1]) + (d[2] + d[3]));
        tab[i * BM + (t & 255)] = 1.0f / sqrtf(q * inv_n + eps); }
    __syncthreads();
}
__device__ __forceinline__ void row_rstd8(const float* ss, int row0, int fq, float inv_n, float eps, float (&rs)[2][4]) {
#pragma unroll
    for (int ai = 0; ai < 2; ++ai)
#pragma unroll
        for (int m = 0; m < 4; ++m) { const f32x4 v = *(const f32x4*)(ss + (size_t)(row0 + ai * HALF + m * 16) * 16 + 4 * fq); float t = (v[0] + v[1]) + (v[2] + v[3]);
            t += __shfl_xor(t, 16); t += __shfl_xor(t, 32); rs[ai][m] = 1.0f / sqrtf(t * inv_n + eps); }
}
__device__ __forceinline__ float silu_mul(float g, float u) { const float e = __builtin_amdgcn_exp2f(g * -1.4426950408889634f); return g * __builtin_amdgcn_rcpf(1.0f + e) * u; }
template <bool OUT8> struct EpiSwiglu {
    static constexpr bool PERM = true, AFTER_DRAIN = false, UI = true;
    bf16_t* O; int ldc; const PG8_LAS float* rtab; float ascale;
    __device__ __forceinline__ void operator()(const f32x4 (&acc)[2][2][4][2], const Unit& u, int wr, int wc, int fr, int fq, int ui) const {
        const int row0 = u.pm * BM + wr * 64 + fr, col0 = u.pn * HALF + wc * 32 + 8 * fq;
        float rs[2][4];
#pragma unroll
        for (int ai = 0; ai < 2; ++ai)
#pragma unroll
            for (int m = 0; m < 4; ++m) rs[ai][m] = rtab[ui * BM + ai * HALF + wr * 64 + m * 16 + fr];
#pragma unroll
        for (int ai = 0; ai < 2; ++ai)
#pragma unroll
            for (int m = 0; m < 4; ++m) { const float r = rs[ai][m] * ascale;
                const f32x4 g0 = acc[ai][0][m][0] * r, g1 = acc[ai][0][m][1] * r, u0 = acc[ai][1][m][0] * r, u1 = acc[ai][1][m][1] * r;
                if constexpr (OUT8) { typedef unsigned u32x2v __attribute__((ext_vector_type(2))); u32x2v w;
                    w.x = cvt4_fp8(silu_mul(g0[0], u0[0]), silu_mul(g0[1], u0[1]), silu_mul(g0[2], u0[2]), silu_mul(g0[3], u0[3]));
                    w.y = cvt4_fp8(silu_mul(g1[0], u1[0]), silu_mul(g1[1], u1[1]), silu_mul(g1[2], u1[2]), silu_mul(g1[3], u1[3]));
                    *(u32x2v*)((unsigned char*)O + (size_t)(row0 + ai * HALF + m * 16) * ldc + col0) = w; }
                else { bf16_t* rowp = O + (size_t)(row0 + ai * HALF + m * 16) * ldc + col0;
                u32x4 w; w.x = cvt_pk_bf16(silu_mul(g0[0], u0[0]), silu_mul(g0[1], u0[1])); w.y = cvt_pk_bf16(silu_mul(g0[2], u0[2]), silu_mul(g0[3], u0[3]));
                w.z = cvt_pk_bf16(silu_mul(g1[0], u1[0]), silu_mul(g1[1], u1[1])); w.w = cvt_pk_bf16(silu_mul(g1[2], u1[2]), silu_mul(g1[3], u1[3]));
                *(u32x4*)rowp = w; } }
    }
};
struct EpiBf16Rs {
    static constexpr bool PERM = true, AFTER_DRAIN = false, UI = true;
    bf16_t* O; int ldc; const PG8_LAS float* rtab;
    __device__ __forceinline__ void operator()(const f32x4 (&acc)[2][2][4][2], const Unit& u, int wr, int wc, int fr, int fq, int ui) const {
        const int row0 = u.pm * BM + wr * 64 + fr, col0 = u.pn * BM + wc * 32 + 8 * fq;
        float rs[2][4];
#pragma unroll
        for (int ai = 0; ai < 2; ++ai)
#pragma unroll
            for (int m = 0; m < 4; ++m) rs[ai][m] = rtab[ui * BM + ai * HALF + wr * 64 + m * 16 + fr];
#pragma unroll
        for (int ai = 0; ai < 2; ++ai)
#pragma unroll
            for (int m = 0; m < 4; ++m) { bf16_t* rowp = O + (size_t)(row0 + ai * HALF + m * 16) * ldc + col0; const float r = rs[ai][m];
#pragma unroll
                for (int bj = 0; bj < 2; ++bj) { const f32x4 v0 = acc[ai][bj][m][0] * r, v1 = acc[ai][bj][m][1] * r;
                    u32x4 w; w.x = cvt_pk_bf16(v0[0], v0[1]); w.y = cvt_pk_bf16(v0[2], v0[3]); w.z = cvt_pk_bf16(v1[0], v1[1]); w.w = cvt_pk_bf16(v1[2], v1[3]);
                    *(u32x4*)(rowp + bj * HALF) = w; } }
    }
};
template <bool BASE_BF16, bool OUT8, bool SS> struct EpiRes2 {
    static constexpr bool PERM = false, AFTER_DRAIN = false, UI = false;
    const void* base; bf16_t* hb; unsigned char* x8; float* ss; int ldc; float scale;
    __device__ __forceinline__ void operator()(const f32x4 (&acc)[2][2][4][2], const Unit& u, int wr, int wc, int fr, int fq) const {
        typedef unsigned u32x2v __attribute__((ext_vector_type(2)));
        const int row0 = u.pm * BM + wr * 64 + fr, col0 = u.pn * BM + wc * 32 + 4 * fq;
#pragma unroll
        for (int ai = 0; ai < 2; ++ai) {
            f32x4 pre[4][2][2];
#pragma unroll
            for (int m = 0; m < 4; ++m) { const size_t off = (size_t)(row0 + ai * HALF + m * 16) * ldc + col0;
#pragma unroll
                for (int bj = 0; bj < 2; ++bj)
#pragma unroll
                    for (int n = 0; n < 2; ++n) {
                        if constexpr (BASE_BF16) { const u32x2v w = *(const u32x2v*)((const bf16_t*)base + off + bj * HALF + n * 16);
                            pre[m][bj][n] = (f32x4){__uint_as_float(w.x << 16), __uint_as_float(w.x & 0xffff0000u), __uint_as_float(w.y << 16), __uint_as_float(w.y & 0xffff0000u)}; }
                        else pre[m][bj][n] = *(const f32x4*)((const float*)base + off + bj * HALF + n * 16); } }
#pragma unroll
            for (int m = 0; m < 4; ++m) { const int row = row0 + ai * HALF + m * 16; const size_t off = (size_t)row * ldc + col0; float q = 0.f;
#pragma unroll
                for (int bj = 0; bj < 2; ++bj)
#pragma unroll
                    for (int n = 0; n < 2; ++n) { const f32x4 o = pre[m][bj][n] + acc[ai][bj][m][n] * scale;
                        u32x2v w; w.x = cvt_pk_bf16(o[0], o[1]); w.y = cvt_pk_bf16(o[2], o[3]); *(u32x2v*)(hb + off + bj * HALF + n * 16) = w;
                        if constexpr (SS) q += (o[0] * o[0] + o[1] * o[1]) + (o[2] * o[2] + o[3] * o[3]);
                        if constexpr (OUT8) *(unsigned*)(x8 + off + bj * HALF + n * 16) = cvt4_fp8(o[0], o[1], o[2], o[3]); }
                if constexpr (SS) { q += __shfl_xor(q, 16); q += __shfl_xor(q, 32); if (fq == 0) ss[(size_t)row * 16 + u.pn * 4 + wc] = q; } }
        }
    }
};
template <bool XN8> struct EpiResNorm {
    static constexpr bool PERM = false, AFTER_DRAIN = false, UI = false;
    const float* base; float* out; int ldc; float scale; const float* gain; bf16_t* xn; float* ss;
    __device__ __forceinline__ void operator()(const f32x4 (&acc)[2][2][4][2], const Unit& u, int wr, int wc, int fr, int fq) const {
        const int row0 = u.pm * BM + wr * 64 + fr, col0 = u.pn * BM + wc * 32 + 4 * fq;
        f32x4 gv[2][2];
#pragma unroll
        for (int bj = 0; bj < 2; ++bj)
#pragma unroll
            for (int n = 0; n < 2; ++n) gv[bj][n] = *(const f32x4*)(gain + col0 + bj * HALF + n * 16);
#pragma unroll
        for (int ai = 0; ai < 2; ++ai) {
            f32x4 pre[4][2][2];
#pragma unroll
            for (int m = 0; m < 4; ++m) { const size_t off = (size_t)(row0 + ai * HALF + m * 16) * ldc + col0;
#pragma unroll
                for (int bj = 0; bj < 2; ++bj)
#pragma unroll
                    for (int n = 0; n < 2; ++n) pre[m][bj][n] = *(const f32x4*)(base + off + bj * HALF + n * 16); }
#pragma unroll
            for (int m = 0; m < 4; ++m) { const int row = row0 + ai * HALF + m * 16; const size_t off = (size_t)row * ldc + col0; float q = 0.f;
#pragma unroll
                for (int bj = 0; bj < 2; ++bj)
#pragma unroll
                    for (int n = 0; n < 2; ++n) { const f32x4 o = pre[m][bj][n] + acc[ai][bj][m][n] * scale; *(f32x4*)(out + off + bj * HALF + n * 16) = o;
                        q += (o[0] * o[0] + o[1] * o[1]) + (o[2] * o[2] + o[3] * o[3]); const f32x4 x = o * gv[bj][n];
                        if constexpr (XN8) *(unsigned*)((unsigned char*)xn + off + bj * HALF + n * 16) = cvt4_fp8(x[0], x[1], x[2], x[3]);
                        else { typedef unsigned u32x2v __attribute__((ext_vector_type(2))); u32x2v w; w.x = cvt_pk_bf16(x[0], x[1]); w.y = cvt_pk_bf16(x[2], x[3]); *(u32x2v*)(xn + off + bj * HALF + n * 16) = w; } }
                q += __shfl_xor(q, 16); q += __shfl_xor(q, 32);
                if (fq == 0) ss[(size_t)row * 16 + u.pn * 4 + wc] = q; }
        }
    }
};
struct EpiRes {
    static constexpr bool PERM = false, AFTER_DRAIN = false, UI = false;
    const float* base; float* out; int ldc; float scale;
    __device__ __forceinline__ void operator()(const f32x4 (&acc)[2][2][4][2], const Unit& u, int wr, int wc, int fr, int fq) const {
        const int row0 = u.pm * BM + wr * 64 + fr, col0 = u.pn * BM + wc * 32 + 4 * fq;
#pragma unroll
        for (int ai = 0; ai < 2; ++ai)
#pragma unroll
            for (int mp = 0; mp < 4; mp += 2) {
                f32x4 pre[2][2][2];
#pragma unroll
                for (int m = 0; m < 2; ++m) { const size_t off = (size_t)(row0 + ai * HALF + (mp + m) * 16) * ldc + col0;
#pragma unroll
                    for (int bj = 0; bj < 2; ++bj)
#pragma unroll
                        for (int n = 0; n < 2; ++n) pre[m][bj][n] = *(const f32x4*)(base + off + bj * HALF + n * 16); }
#pragma unroll
                for (int m = 0; m < 2; ++m) { const size_t off = (size_t)(row0 + ai * HALF + (mp + m) * 16) * ldc + col0;
#pragma unroll
                    for (int bj = 0; bj < 2; ++bj)
#pragma unroll
                        for (int n = 0; n < 2; ++n) *(f32x4*)(out + off + bj * HALF + n * 16) = pre[m][bj][n] + acc[ai][bj][mp + m][n] * scale; }
            }
    }
};

typedef int i32x4 __attribute__((ext_vector_type(4))); typedef int i32x8 __attribute__((ext_vector_type(8)));
template <class Epi, class Sched, bool ALIGN_EPI = false, bool SP2 = false, bool FP8 = false>
__device__ __forceinline__ void gemm_phase(PG8_LAS unsigned char* lds, const Gemm g, const Sched& S, const Epi& E) {
    const int tid = threadIdx.x, wid = __builtin_amdgcn_readfirstlane(tid >> 6), lane = tid & 63, wr = wid >> 2, wc = wid & 3, fr = lane & 15, fq = lane >> 4;
    const int K = g.K, nt = K / BK;
    unsigned voffA[2], voffB[2];
#pragma unroll
    for (int i = 0; i < 2; ++i) { int R, C; stage_rc(tid * 16 + i * 8192, R, C); const int Rb = Epi::PERM ? ((R & ~31) + perm32(R & 31)) : R;
        voffA[i] = (unsigned)(R * K + C) * 2u; voffB[i] = (unsigned)(Rb * K + C) * 2u; }
    const size_t kstep = (size_t)(BK * 2);
    const size_t hstep = (size_t)HALF * K * 2;
    const size_t tstep = 2 * hstep;
    const unsigned ldsw = (unsigned)wid * 1024u;
    const int aoff = lds_byte(wr * 64 + fr, fq * 8), boff = lds_byte(wc * 32 + fr, fq * 8);
#define PG8_SA(b, h) (((b) * 2 + (h)) * HTB)
#define PG8_SB(b, h) ((4 + (b) * 2 + (h)) * HTB)
#define PG8_STAGE(bufoff, gbase, voff) do { _Pragma("unroll") for (int _i = 0; _i < 2; ++_i) \
        __builtin_amdgcn_global_load_lds((const unsigned*)((const char*)(gbase) + (voff)[_i]), (PG8_LAS unsigned*)(lds + (bufoff) + ldsw + _i * 8192), 16, 0, 0); } while (0)
#define PG8_LDA(dst, b, h) do { _Pragma("unroll") for (int m = 0; m < 4; ++m) { dst[m].lo = *(const PG8_LAS i32x4*)(lds + PG8_SA(b, h) + aoff + m * 2048); dst[m].hi = *(const PG8_LAS i32x4*)(lds + PG8_SA(b, h) + aoff + m * 2048 + 1024); } } while (0)
#define PG8_LDB(dst, b, h) do { _Pragma("unroll") for (int n = 0; n < 2; ++n) { dst[n].lo = *(const PG8_LAS i32x4*)(lds + PG8_SB(b, h) + boff + n * 2048); dst[n].hi = *(const PG8_LAS i32x4*)(lds + PG8_SB(b, h) + boff + n * 2048 + 1024); } } while (0)
#define PG8_H(x, k) __builtin_bit_cast(bf16x8, (k) == 0 ? (x).lo : (x).hi)
#define PG8_MMA(ai, bj, At, Bt) do { __builtin_amdgcn_s_setprio(1); \
        if constexpr (FP8) { _Pragma("unroll") for (int m = 0; m < 4; ++m) _Pragma("unroll") for (int n = 0; n < 2; ++n) \
            asm volatile("v_mfma_scale_f32_16x16x128_f8f6f4 %0, %1, %2, %0, %3, %3 op_sel_hi:[0,0,0]" : "+v"(acc[ai][bj][m][n]) : "v"(Bt[n]), "v"(At[m]), "v"(sc8)); } \
        else { _Pragma("unroll") for (int m = 0; m < 4; ++m) _Pragma("unroll") for (int n = 0; n < 2; ++n) _Pragma("unroll") for (int k = 0; k < 2; ++k) \
            acc[ai][bj][m][n] = __builtin_amdgcn_mfma_f32_16x16x32_bf16(PG8_H(Bt[n], k), PG8_H(At[m], k), acc[ai][bj][m][n], 0, 0, 0); } \
        __builtin_amdgcn_s_setprio(0); } while (0)
#define PG8_WAIT_V(n) asm volatile("s_waitcnt vmcnt(" #n ")" ::: "memory")
#define PG8_WAIT_L(n) asm volatile("s_waitcnt lgkmcnt(" #n ")" ::: "memory")
#define PG8_BAR __builtin_amdgcn_s_barrier()
#define PG8_SCHED __builtin_amdgcn_sched_barrier(0)
    Unit cur, nxt; int ui = 0;
    if (!S.next(0, cur)) return;
    f32x4 acc[2][2][4][2];
#pragma unroll
    for (int a = 0; a < 2; ++a)
#pragma unroll
        for (int b = 0; b < 2; ++b)
#pragma unroll
            for (int m = 0; m < 4; ++m)
#pragma unroll
                for (int n = 0; n < 2; ++n) acc[a][b][m][n] = (f32x4){0.f, 0.f, 0.f, 0.f};
    i32x8 At[4], B0[2], B1[2]; int sc8 = 0x7f7f7f7f; asm volatile("" : "+v"(sc8));
    const char* cA = (const char*)g.A + (size_t)cur.pm * tstep; const char* cB = (const char*)g.Bt + (size_t)cur.pn * tstep;
    S.a_ready(cur);
    if constexpr (SP2) {
        PG8_STAGE(PG8_SB(0, 0), cB, voffB); PG8_STAGE(PG8_SB(0, 1), cB + hstep, voffB); PG8_STAGE(PG8_SA(0, 0), cA, voffA); PG8_STAGE(PG8_SA(0, 1), cA + hstep, voffA);
        if (wr == 1) PG8_BAR;
        PG8_WAIT_V(2); PG8_BAR;
        PG8_STAGE(PG8_SB(1, 0), cB + kstep, voffB); PG8_STAGE(PG8_SA(1, 0), cA + kstep, voffA); PG8_STAGE(PG8_SB(1, 1), cB + hstep + kstep, voffB);
        PG8_WAIT_V(6); PG8_BAR;
    } else {
        PG8_STAGE(PG8_SB(0, 0), cB, voffB); PG8_STAGE(PG8_SA(0, 0), cA, voffA); PG8_STAGE(PG8_SB(0, 1), cB + hstep, voffB); PG8_STAGE(PG8_SA(0, 1), cA + hstep, voffA);
        if (wr == 1) PG8_BAR;
        PG8_WAIT_V(4); PG8_BAR;
        PG8_STAGE(PG8_SB(1, 0), cB + kstep, voffB); PG8_STAGE(PG8_SA(1, 0), cA + kstep, voffA); PG8_STAGE(PG8_SB(1, 1), cB + hstep + kstep, voffB);
        PG8_WAIT_V(6); PG8_BAR;
    }
    for (;;) {
        const bool has_next = S.next(ui + 1, nxt);
        const char* nA = has_next ? (const char*)g.A + (size_t)nxt.pm * tstep : cA; const char* nB = has_next ? (const char*)g.Bt + (size_t)nxt.pn * tstep : cB;
#pragma unroll 1
        for (int t = 0; t < nt; t += 2) {
            const bool last = (t == nt - 2);
            const char* a1 = cA + (size_t)(t + 1) * kstep;
            const char* a2 = last ? nA : cA + (size_t)(t + 2) * kstep; const char* b2 = last ? nB : cB + (size_t)(t + 2) * kstep;
            const char* a3 = a2 + kstep; const char* b3 = b2 + kstep;
            if (last && has_next) S.a_ready(nxt);
            if constexpr (SP2) {
            PG8_LDB(B0, 0, 0); PG8_LDB(B1, 0, 1); PG8_SCHED; PG8_LDA(At, 0, 0); PG8_STAGE(PG8_SA(1, 1), a1 + hstep, voffA);
            PG8_WAIT_V(8); PG8_WAIT_L(0); PG8_BAR; PG8_MMA(0, 0, At, B0); PG8_MMA(0, 1, At, B1); PG8_BAR; PG8_SCHED;
            PG8_LDA(At, 0, 1); PG8_STAGE(PG8_SB(0, 0), b2, voffB); PG8_STAGE(PG8_SB(0, 1), b2 + hstep, voffB); PG8_STAGE(PG8_SA(0, 0), a2, voffA);
            PG8_WAIT_V(8); PG8_WAIT_L(0); PG8_BAR; PG8_MMA(1, 0, At, B0); PG8_MMA(1, 1, At, B1); PG8_BAR; PG8_SCHED;
            PG8_LDB(B0, 1, 0); PG8_LDB(B1, 1, 1); PG8_SCHED; PG8_LDA(At, 1, 0); PG8_STAGE(PG8_SA(0, 1), a2 + hstep, voffA);
            PG8_WAIT_V(8); PG8_WAIT_L(0); PG8_BAR; PG8_MMA(0, 0, At, B0); PG8_MMA(0, 1, At, B1); PG8_BAR; PG8_SCHED;
            PG8_LDA(At, 1, 1); PG8_STAGE(PG8_SB(1, 0), b3, voffB); PG8_STAGE(PG8_SB(1, 1), b3 + hstep, voffB); PG8_STAGE(PG8_SA(1, 0), a3, voffA);
            PG8_WAIT_V(8); PG8_WAIT_L(0); PG8_BAR; PG8_MMA(1, 0, At, B0); PG8_MMA(1, 1, At, B1); PG8_BAR; PG8_SCHED;
            } else {
            PG8_LDB(B0, 0, 0); PG8_SCHED; PG8_LDA(At, 0, 0); PG8_STAGE(PG8_SA(1, 1), a1 + hstep, voffA);
            PG8_WAIT_L(8); PG8_BAR; PG8_WAIT_L(0); PG8_MMA(0, 0, At, B0); PG8_BAR; PG8_SCHED;
            PG8_LDB(B1, 0, 1); PG8_STAGE(PG8_SB(0, 0), b2, voffB);
            PG8_BAR; PG8_WAIT_L(0); PG8_MMA(0, 1, At, B1); PG8_BAR;
            PG8_LDA(At, 0, 1); PG8_STAGE(PG8_SA(0, 0), a2, voffA);
            PG8_BAR; PG8_WAIT_L(0); PG8_MMA(1, 0, At, B0); PG8_BAR; PG8_SCHED;
            PG8_STAGE(PG8_SB(0, 1), b2 + hstep, voffB);
            PG8_WAIT_V(6); PG8_BAR; PG8_MMA(1, 1, At, B1); PG8_BAR;
            PG8_LDB(B0, 1, 0); PG8_SCHED; PG8_LDA(At, 1, 0); PG8_STAGE(PG8_SA(0, 1), a2 + hstep, voffA);
            PG8_WAIT_L(8); PG8_BAR; PG8_WAIT_L(0); PG8_MMA(0, 0, At, B0); PG8_BAR; PG8_SCHED;
            PG8_LDB(B1, 1, 1); PG8_STAGE(PG8_SB(1, 0), b3, voffB);
            PG8_BAR; PG8_WAIT_L(0); PG8_MMA(0, 1, At, B1); PG8_BAR;
            PG8_LDA(At, 1, 1); PG8_STAGE(PG8_SA(1, 0), a3, voffA);
            PG8_BAR; PG8_WAIT_L(0); PG8_MMA(1, 0, At, B0); PG8_BAR; PG8_SCHED;
            PG8_STAGE(PG8_SB(1, 1), b3 + hstep, voffB);
            PG8_WAIT_V(6); PG8_BAR; PG8_MMA(1, 1, At, B1); PG8_BAR;
            }
        }
        if constexpr (FP8) asm volatile("s_nop 15\n\ts_nop 15" ::: "memory");
        if constexpr (ALIGN_EPI) { if (wr == 0) PG8_BAR; }
        if constexpr (!Epi::AFTER_DRAIN) { if constexpr (Epi::UI) E(acc, cur, wr, wc, fr, fq, ui); else E(acc, cur, wr, wc, fr, fq); S.done(cur); }
        if (!has_next) break;
#pragma unroll
        for (int a = 0; a < 2; ++a)
#pragma unroll
            for (int b = 0; b < 2; ++b)
#pragma unroll
                for (int m = 0; m < 4; ++m)
#pragma unroll
                    for (int n = 0; n < 2; ++n) acc[a][b][m][n] = (f32x4){0.f, 0.f, 0.f, 0.f};
        cur = nxt; cA = nA; cB = nB; ++ui;
        if constexpr (ALIGN_EPI) { if (wr == 1) PG8_BAR; }
    }
    PG8_WAIT_V(0);
    if constexpr (!ALIGN_EPI) { if (wr == 0) PG8_BAR; }
    PG8_BAR;
    if constexpr (Epi::AFTER_DRAIN) { E.fused(acc, cur, wr, wc, fr, fq, lds, wid, lane); S.done(cur); }
#undef PG8_SA
#undef PG8_SB
#undef PG8_STAGE
#undef PG8_LDA
#undef PG8_LDB
#undef PG8_MMA
#undef PG8_H
#undef PG8_WAIT_V
#undef PG8_WAIT_L
#undef PG8_BAR
#undef PG8_SCHED
}
}

#ifndef PG8_SP2
#define PG8_SP2 true
#endif
#ifndef PG8_ALIGN
#define PG8_ALIGN true
#endif

constexpr int NWAVES = 8;
#ifndef MK_N_LAUNCHES
#define MK_N_LAUNCHES 1
#endif
#ifndef REP_MASK
#define REP_MASK 0
#endif
#ifndef FFN1_FP8
#define FFN1_FP8 1
#endif
constexpr int PER_PHASE = 12;
constexpr int N_LAUNCHES = MK_N_LAUNCHES;
static_assert(N_LAUNCHES == 1 || N_LAUNCHES == PER_PHASE, "MK_N_LAUNCHES is 1 or 12");

constexpr int BATCH = 8, SEQ = 2048, D = 1024, M = BATCH * SEQ;
constexpr int FF = 2816, FF2 = 2 * FF;
constexpr int NH = 8, HD = 64, CL = 128, TOPK = 256;
constexpr int NPROJ = 2816;
constexpr int PQ = 0, PQI = 512, PCKV = 1024, PKI = 1152, PWI = 1216, PGB = 1280, PGC = 1792, PXIN = 2304;
constexpr int WIN_N = 2760;
constexpr float EPS = 1e-6f;
constexpr float WSC_GU = 32.f, WSC_DN = 64.f;
constexpr float IDX_SCALE = 0.044194173824159216f;

constexpr size_t MiB = 1u << 20;
constexpr size_t WS_CTL = 0, CTL_ZERO_BYTES = 1 * MiB;
constexpr size_t WS_WUK = 1 * MiB, WS_WUV = 1 * MiB + 256 * 1024;
constexpr size_t WS_WGU1 = 2 * MiB, WS_WD1 = 14 * MiB, WS_WIN = 20 * MiB, WS_WOUT = 26 * MiB, WS_WGU2 = 28 * MiB, WS_WD2 = 40 * MiB;
constexpr size_t WS_XN = 48 * MiB;
constexpr size_t WS_MIX = 80 * MiB;
constexpr size_t WS_KV = 112 * MiB;
constexpr size_t WS_MASK = 116 * MiB;
constexpr size_t WS_SS = 120 * MiB;
constexpr size_t WS_ACT = 128 * MiB;
constexpr size_t WS_HB = 216 * MiB;
constexpr size_t WS_END = 248 * MiB;
static_assert(WS_WGU1 + (size_t)FF2 * D * 2 <= WS_WD1 && WS_WD1 + (size_t)D * FF * 2 <= WS_WIN && WS_WIN + (size_t)NPROJ * D * 2 <= WS_WOUT && WS_WOUT + (size_t)D * D * 2 <= WS_WGU2 &&
              WS_WGU2 + (size_t)FF2 * D * 2 <= WS_WD2 && WS_WD2 + (size_t)D * FF * 2 <= WS_XN && WS_ACT + (size_t)M * FF * 2 <= WS_HB && WS_HB + (size_t)M * D * 2 <= WS_END, "d_ws map");
constexpr int CW_BAR = 4096;

constexpr int RING_OFF = 0, RING_BYTES = 131072;
constexpr int LDSCTL_OFF = RING_BYTES, MISC_OFF = LDSCTL_OFF + 320, RTAB_OFF = LDSCTL_OFF + 1024;
constexpr int LDS_BYTES = 147456;
static_assert(MISC_OFF + 128 <= RTAB_OFF && RTAB_OFF + 12 * 256 * 4 <= LDS_BYTES, "LDS map");
#define GAS __attribute__((address_space(1)))
#define LAS __attribute__((address_space(3)))
typedef unsigned short bf16;
typedef unsigned v4u __attribute__((ext_vector_type(4)));
typedef float f32x4 __attribute__((ext_vector_type(4)));
typedef short bf16x8 __attribute__((ext_vector_type(8)));
typedef GAS unsigned gu32;
typedef GAS unsigned long long gu64;
#define RLX_AGENT __ATOMIC_RELAXED, __HIP_MEMORY_SCOPE_AGENT
#define LDS_WAIT() asm volatile("s_waitcnt lgkmcnt(0)" ::: "memory")
#define VM_WAIT() asm volatile("s_waitcnt vmcnt(0)" ::: "memory")
__device__ __forceinline__ unsigned long long rt() { return __builtin_amdgcn_s_memrealtime(); }
__device__ __forceinline__ unsigned f2bf(float f) { unsigned u = __builtin_bit_cast(unsigned, f); return (u + 0x7fffu + ((u >> 16) & 1u)) >> 16; }
__device__ __forceinline__ unsigned pk2(float lo, float hi) { return f2bf(lo) | (f2bf(hi) << 16); }

#define XB_TMO      128
#define XB_XCNT(j)  (256  + 64 * (j))
#define XB_XSUB(j)  (1280 + 64 * (j))
#define XB_XGEN(j)  (2304 + 64 * (j))
#define XB_TOP      3328
#define XB_TOPGEN   3392
#define XCD_BAR_WORDS 3456
#define XB_SPIN_CAP (1u << 18)

__device__ __forceinline__ unsigned xb_ld(unsigned* p)              { return __hip_atomic_load(p, __ATOMIC_RELAXED, __HIP_MEMORY_SCOPE_AGENT); }
__device__ __forceinline__ unsigned xb_add(unsigned* p, unsigned v) { return __hip_atomic_fetch_add(p, v, __ATOMIC_RELAXED, __HIP_MEMORY_SCOPE_AGENT); }
__device__ __forceinline__ unsigned xb_xcc_id() { return (unsigned)__builtin_amdgcn_s_getreg((3 << 11) | 20) & 0xFu; }
#define XB_SPIN(cond, bar) do { unsigned _sp = 0; while (cond) { __builtin_amdgcn_s_sleep(1); \
    if ((++_sp & 255u) == 0u) { if (xb_ld(&(bar)[XB_TMO])) break; if (_sp > XB_SPIN_CAP) { atomicAdd(&(bar)[XB_TMO], 1u); break; } } } } while (0)

struct XcdBarrier {
    unsigned* bar; unsigned x;
    volatile LAS unsigned* st;
};

__device__ __forceinline__ XcdBarrier xcd_barrier_post(unsigned* bar, volatile LAS unsigned* st) {
    XcdBarrier b; b.bar = bar; b.x = xb_xcc_id(); b.st = st;
    if (threadIdx.x == 0) (void)xb_add(&bar[XB_XCNT(b.x)], 1u);
    return b;
}
__device__ __forceinline__ void xcd_barrier_complete(unsigned* bar, unsigned x, unsigned& nloc, unsigned& nx) {
    const unsigned G = gridDim.x * gridDim.y * gridDim.z;
    unsigned sum, cnt, mine, sp = 0u;
    for (;;) {
        sum = 0u; cnt = 0u; mine = 0u;
#pragma unroll
        for (unsigned j = 0; j < 16; ++j) { const unsigned c = xb_ld(&bar[XB_XCNT(j)]); sum += c; cnt += (c > 0u) ? 1u : 0u; mine = (j == x) ? c : mine; }
        if (sum == G) break;
        __builtin_amdgcn_s_sleep(1);
        if ((++sp & 255u) == 0u) { if (xb_ld(&bar[XB_TMO])) break; if (sp > XB_SPIN_CAP) { atomicAdd(&bar[XB_TMO], 1u); break; } }
    }
    nloc = mine > 0u ? mine : 1u; nx = cnt > 0u ? cnt : 1u;
}

__device__ __forceinline__ void xcd_barrier(const XcdBarrier& b) {
    asm volatile("s_waitcnt vmcnt(0)" ::: "memory");
    __syncthreads();
    if (threadIdx.x == 0) {
        unsigned* bar = b.bar;
        __builtin_amdgcn_s_waitcnt(0);
        unsigned nloc = b.st[0], nx = b.st[1];
        if (nloc == 0u) { xcd_barrier_complete(bar, b.x, nloc, nx); b.st[0] = nloc; b.st[1] = nx; }
        const unsigned old = xb_add(&bar[XB_XSUB(b.x)], 1u);
        const unsigned gen = old / nloc;
        if (old + 1u == (gen + 1u) * nloc) {
            __builtin_amdgcn_fence(__ATOMIC_RELEASE, "agent");
            asm volatile("s_waitcnt vmcnt(0)" ::: "memory");
            const unsigned og = xb_add(&bar[XB_TOP], 1u);
            const unsigned tg = og / nx;
            if (og + 1u == (tg + 1u) * nx) xb_add(&bar[XB_TOPGEN], 1u);
            else XB_SPIN(xb_ld(&bar[XB_TOPGEN]) == tg, bar);
            __builtin_amdgcn_fence(__ATOMIC_ACQUIRE, "agent");
            xb_add(&bar[XB_XGEN(b.x)], 1u);
            asm volatile("s_waitcnt vmcnt(0)" ::: "memory");
        } else {
            XB_SPIN(xb_ld(&bar[XB_XGEN(b.x)]) == gen, bar);
            __builtin_amdgcn_fence(__ATOMIC_ACQUIRE, "agent");
            asm volatile("s_waitcnt vmcnt(0)" ::: "memory");
        }
    }
    __syncthreads();
}


struct Frame {
    LAS unsigned char* lds;
    volatile LAS unsigned* MISC;
    gu32* ctl;
    int tid, lane, wave;
    int vcu, G;
    const float* in[20]; float* out;
    bf16 *Wgu1, *Wd1, *Win, *Wout, *Wgu2, *Wd2, *Wuk, *WuvT;
    bf16 *XN, *MIX, *KV, *ACT, *PROJ; unsigned* MASK; float* SS; bf16* HB;
};
enum { I_X = 0, I_N1, I_G1, I_U1, I_D1, I_NMIX, I_WIN, I_NKV, I_WUK, I_WUV, I_RELB, I_CONVW, I_NATT, I_NCONV, I_WOUT, I_N2, I_G2, I_U2, I_D2, I_NF };

__device__ __forceinline__ float wave_sum(float v) {
#pragma unroll
    for (int o = 1; o < 64; o <<= 1) v += __shfl_xor(v, o);
    return v;
}
__device__ __forceinline__ float wave_max(float v) {
#pragma unroll
    for (int o = 1; o < 64; o <<= 1) v = fmaxf(v, __shfl_xor(v, o));
    return v;
}
__device__ __forceinline__ float bflo(unsigned w) { return __uint_as_float(w << 16); }
__device__ __forceinline__ float bfhi(unsigned w) { return __uint_as_float(w & 0xffff0000u); }

__device__ __forceinline__ void ld8bf(const bf16* p, float (&f)[8]) { const v4u w = *(const GAS v4u*)p; f[0] = bflo(w.x); f[1] = bfhi(w.x); f[2] = bflo(w.y); f[3] = bfhi(w.y); f[4] = bflo(w.z); f[5] = bfhi(w.z); f[6] = bflo(w.w); f[7] = bfhi(w.w); }
struct Src { const float* W; int N; int col; };
struct MapPlain { const float* W; int N; __device__ __forceinline__ Src operator()(int d) const { return Src{W, N, d}; } };
struct MapGU { const float* W; __device__ __forceinline__ Src operator()(int d) const { return Src{W, FF, (d >> 8) * 128 + (d & 127)}; } };
struct MapWin { const float* W; __device__ __forceinline__ Src operator()(int d) const { int c;
    if (d < 512) c = d;
    else if (d < 1024) c = 640 + (d - 512);
    else if (d < 1152) c = 512 + (d - 1024);
    else if (d < 1224) c = d;
    else if (d < 1280) c = -1;
    else if (d < 1792) c = 1224 + (d - 1280);
    else if (d < 2304) c = 1736 + (d - 1792);
    else c = 2248 + (d - 2304);
    return Src{W, WIN_N, c}; } };
template <class MAP>
__device__ __forceinline__ void p0_transpose_item(const MAP& map, int K, int ndg, bf16* WT, LAS float* scr, int item, int lane, const float* gk = nullptr) {
    const int kb = item / ndg, dg = item % ndg, k0 = 64 * kb, d0 = 32 * dg;
    const Src src = map(d0 + (lane & 31)); const int sc = src.col; const float* wp = src.W + (size_t)(k0 + (lane >> 5)) * src.N + (sc >= 0 ? sc : 0);
    const float live = sc >= 0 ? 1.f : 0.f;
    float wv_[32];
#pragma unroll
    for (int i = 0; i < 32; ++i) wv_[i] = wp[(size_t)(2 * i) * src.N];
    if (gk) {
#pragma unroll
        for (int i = 0; i < 32; ++i) wv_[i] *= gk[k0 + 2 * i + (lane >> 5)]; }
#pragma unroll
    for (int i = 0; i < 32; ++i) { const int kk = 2 * i + (lane >> 5); scr[kk * 33 + (lane & 31)] = wv_[i] * live; }
    LDS_WAIT(); asm volatile("" ::: "memory");
    const int c = lane & 7;
#pragma unroll
    for (int j = 0; j < 4; ++j) { const int n = (lane >> 3) + 8 * j; const LAS float* s = scr + (8 * c) * 33 + n;
        v4u o; o.x = pk2(s[0 * 33], s[1 * 33]); o.y = pk2(s[2 * 33], s[3 * 33]); o.z = pk2(s[4 * 33], s[5 * 33]); o.w = pk2(s[6 * 33], s[7 * 33]);
        *(GAS v4u*)(WT + (size_t)(d0 + n) * K + k0 + 8 * c) = o; }
    LDS_WAIT(); asm volatile("" ::: "memory");
}
template <class MAP>
__device__ __forceinline__ void p0_transpose_item8(const MAP& map, int K, int ndg, unsigned char* WT, LAS float* scr, int item, int lane, float wscale, const float* gk = nullptr) {
    const int kb = item / ndg, dg = item % ndg, k0 = 64 * kb, d0 = 32 * dg;
    const Src src = map(d0 + (lane & 31)); const int sc = src.col; const float* wp = src.W + (size_t)(k0 + (lane >> 5)) * src.N + (sc >= 0 ? sc : 0);
    const float live = sc >= 0 ? wscale : 0.f;
    float wv_[32];
#pragma unroll
    for (int i = 0; i < 32; ++i) wv_[i] = wp[(size_t)(2 * i) * src.N];
    if (gk) {
#pragma unroll
        for (int i = 0; i < 32; ++i) wv_[i] *= gk[k0 + 2 * i + (lane >> 5)]; }
#pragma unroll
    for (int i = 0; i < 32; ++i) { const int kk = 2 * i + (lane >> 5); scr[kk * 33 + (lane & 31)] = wv_[i] * live; }
    LDS_WAIT(); asm volatile("" ::: "memory");
    const int c = lane & 7;
#pragma unroll
    for (int j = 0; j < 4; ++j) { const int n = (lane >> 3) + 8 * j; const LAS float* s = scr + (8 * c) * 33 + n;
        typedef unsigned u32x2v __attribute__((ext_vector_type(2))); u32x2v o; o.x = pg8::cvt4_fp8(s[0 * 33], s[1 * 33], s[2 * 33], s[3 * 33]); o.y = pg8::cvt4_fp8(s[4 * 33], s[5 * 33], s[6 * 33], s[7 * 33]);
        *(GAS u32x2v*)(WT + (size_t)(d0 + n) * K + k0 + 8 * c) = o; }
    LDS_WAIT(); asm volatile("" ::: "memory");
}
__device__ __forceinline__ void rms_row_to_bf16(int lane, const float* xrow, const float* gain, bf16* orow) {
    const GAS f32x4* xr = (const GAS f32x4*)xrow + lane; const GAS f32x4* gr = (const GAS f32x4*)gain + lane;
    f32x4 v[4]; float s = 0.f;
#pragma unroll
    for (int j = 0; j < 4; ++j) { v[j] = xr[64 * j]; s += (v[j].x * v[j].x + v[j].y * v[j].y) + (v[j].z * v[j].z + v[j].w * v[j].w); }
    const float rstd = 1.f / sqrtf(wave_sum(s) * (1.f / D) + EPS);
    GAS unsigned long long* o8 = (GAS unsigned long long*)orow + lane;
#pragma unroll
    for (int j = 0; j < 4; ++j) { const f32x4 g = gr[64 * j]; o8[64 * j] = (unsigned long long)pk2(v[j].x * rstd * g.x, v[j].y * rstd * g.y) | ((unsigned long long)pk2(v[j].z * rstd * g.z, v[j].w * rstd * g.w) << 32); }
}
template <bool OUT8> __device__ __forceinline__ void rows4_to_xn(int lane, const float* x, unsigned char* xn, float* ss, const int (&rows)[4]) {
    f32x4 v[4][4];
#pragma unroll
    for (int r = 0; r < 4; ++r) { const GAS f32x4* xr = (const GAS f32x4*)(x + (size_t)rows[r] * D) + lane;
#pragma unroll
        for (int j = 0; j < 4; ++j) v[r][j] = xr[64 * j]; }
#pragma unroll
    for (int r = 0; r < 4; ++r) { float s = 0.f;
#pragma unroll
        for (int j = 0; j < 4; ++j) s += (v[r][j].x * v[r][j].x + v[r][j].y * v[r][j].y) + (v[r][j].z * v[r][j].z + v[r][j].w * v[r][j].w);
        s = wave_sum(s);
        if constexpr (OUT8) { GAS unsigned* o4 = (GAS unsigned*)(xn + (size_t)rows[r] * D) + lane;
#pragma unroll
            for (int j = 0; j < 4; ++j) o4[64 * j] = pg8::cvt4_fp8(v[r][j].x, v[r][j].y, v[r][j].z, v[r][j].w); }
        else { GAS unsigned long long* o8 = (GAS unsigned long long*)(xn + (size_t)rows[r] * D * 2) + lane;
#pragma unroll
            for (int j = 0; j < 4; ++j) o8[64 * j] = (unsigned long long)pk2(v[r][j].x, v[r][j].y) | ((unsigned long long)pk2(v[r][j].z, v[r][j].w) << 32); }
        if (lane < 16) ((GAS float*)(ss + (size_t)rows[r] * 16))[lane] = lane == 0 ? s : 0.f; }
}
__device__ __forceinline__ void rows4_bf16_to_f32(int lane, const bf16* x, const float* gain, float* out, const int (&rows)[4], bool poison) {
    v4u w[4][2];
#pragma unroll
    for (int r = 0; r < 4; ++r)
#pragma unroll
        for (int j = 0; j < 2; ++j) w[r][j] = *(const GAS v4u*)(x + (size_t)rows[r] * D + 512 * j + 8 * lane);
    f32x4 g[2][2];
#pragma unroll
    for (int j = 0; j < 2; ++j) { const GAS f32x4* gp = (const GAS f32x4*)(gain + 512 * j + 8 * lane); g[j][0] = gp[0]; g[j][1] = gp[1]; }
#pragma unroll
    for (int r = 0; r < 4; ++r) { float v[2][8]; float s = 0.f;
#pragma unroll
        for (int j = 0; j < 2; ++j) { v[j][0] = bflo(w[r][j].x); v[j][1] = bfhi(w[r][j].x); v[j][2] = bflo(w[r][j].y); v[j][3] = bfhi(w[r][j].y); v[j][4] = bflo(w[r][j].z); v[j][5] = bfhi(w[r][j].z); v[j][6] = bflo(w[r][j].w); v[j][7] = bfhi(w[r][j].w);
#pragma unroll
            for (int e = 0; e < 8; ++e) s += v[j][e] * v[j][e]; }
        float rstd = 1.f / sqrtf(wave_sum(s) * (1.f / D) + EPS); if (poison) rstd = __builtin_nanf("");
#pragma unroll
        for (int j = 0; j < 2; ++j) { GAS f32x4* o = (GAS f32x4*)(out + (size_t)rows[r] * D + 512 * j + 8 * lane);
            o[0] = (f32x4){v[j][0] * rstd * g[j][0].x, v[j][1] * rstd * g[j][0].y, v[j][2] * rstd * g[j][0].z, v[j][3] * rstd * g[j][0].w};
            o[1] = (f32x4){v[j][4] * rstd * g[j][1].x, v[j][5] * rstd * g[j][1].y, v[j][6] * rstd * g[j][1].z, v[j][7] * rstd * g[j][1].w}; } }
}
__device__ __forceinline__ void rms_row_to_f32(int lane, const float* xrow, const float* gain, float* orow, bool poison) {
    const GAS f32x4* xr = (const GAS f32x4*)xrow + lane; const GAS f32x4* gr = (const GAS f32x4*)gain + lane;
    f32x4 v[4]; float s = 0.f;
#pragma unroll
    for (int j = 0; j < 4; ++j) { v[j] = xr[64 * j]; s += (v[j].x * v[j].x + v[j].y * v[j].y) + (v[j].z * v[j].z + v[j].w * v[j].w); }
    float rstd = 1.f / sqrtf(wave_sum(s) * (1.f / D) + EPS); if (poison) rstd = __builtin_nanf("");
    GAS f32x4* o = (GAS f32x4*)orow + lane;
#pragma unroll
    for (int j = 0; j < 4; ++j) { const f32x4 g = gr[64 * j]; o[64 * j] = v[j] * rstd * g; }
}
__device__ __forceinline__ void p0_prologue(Frame& F) {
    LAS float* scr = (LAS float*)(F.lds + RING_OFF + F.wave * 16384);
    const int gw = F.vcu * NWAVES + F.wave, NGW = F.G * NWAVES;
    constexpr int I_GU = (D / 64) * (FF2 / 32), I_DN = (FF / 64) * (D / 32), I_IN = (D / 64) * (NPROJ / 32), I_OUT = (D / 64) * (D / 32);
    constexpr int NITEMS = 2 * I_GU + 2 * I_DN + I_IN + I_OUT;
    for (int it = gw; it < NITEMS; it += NGW) {
        int r = it;
        if (r < I_GU) { const float* wsrc = (((r % (FF2 / 32)) & 7) < 4) ? F.in[I_G1] : F.in[I_U1];
            if (FFN1_FP8) p0_transpose_item8(MapGU{wsrc}, D, FF2 / 32, (unsigned char*)F.Wgu1, scr, r, F.lane, WSC_GU, F.in[I_N1]); else p0_transpose_item(MapGU{wsrc}, D, FF2 / 32, F.Wgu1, scr, r, F.lane, F.in[I_N1]); continue; } r -= I_GU;
        if (r < I_GU) { if (((r % (FF2 / 32)) & 7) < 4) p0_transpose_item8(MapGU{F.in[I_G2]}, D, FF2 / 32, (unsigned char*)F.Wgu2, scr, r, F.lane, WSC_GU, F.in[I_N2]); else p0_transpose_item8(MapGU{F.in[I_U2]}, D, FF2 / 32, (unsigned char*)F.Wgu2, scr, r, F.lane, WSC_GU, F.in[I_N2]); continue; } r -= I_GU;
        if (r < I_DN) { if (FFN1_FP8) p0_transpose_item8(MapPlain{F.in[I_D1], D}, FF, D / 32, (unsigned char*)F.Wd1, scr, r, F.lane, WSC_DN); else p0_transpose_item(MapPlain{F.in[I_D1], D}, FF, D / 32, F.Wd1, scr, r, F.lane); continue; } r -= I_DN;
        if (r < I_DN) { p0_transpose_item8(MapPlain{F.in[I_D2], D}, FF, D / 32, (unsigned char*)F.Wd2, scr, r, F.lane, WSC_DN); continue; } r -= I_DN;
        if (r < I_IN) { p0_transpose_item(MapWin{F.in[I_WIN]}, D, NPROJ / 32, F.Win, scr, r, F.lane, F.in[I_NMIX]); continue; } r -= I_IN;
        p0_transpose_item(MapPlain{F.in[I_WOUT], D}, D, D / 32, F.Wout, scr, r, F.lane);
    }
    for (int i = F.vcu * NWAVES * 64 + F.tid; i < CL * NH * HD; i += F.G * NWAVES * 64) {
        F.Wuk[i] = (bf16)f2bf(F.in[I_WUK][i]); const int h = i >> 13, d = (i >> 7) & 63, c = i & 127; F.WuvT[i] = (bf16)f2bf(F.in[I_WUV][((size_t)c * NH + h) * HD + d]); }
    for (int m = gw; m < M; m += 4 * NGW) { const int rows[4] = {m, min(m + NGW, M - 1), min(m + 2 * NGW, M - 1), min(m + 3 * NGW, M - 1)}; rows4_to_xn<FFN1_FP8 != 0>(F.lane, F.in[I_X], (unsigned char*)F.XN, F.SS, rows); }
}
__device__ __forceinline__ void norm_phase(Frame& F, const float* src, const float* gain) {
    const int gw = F.vcu * NWAVES + F.wave, NGW = F.G * NWAVES;
    for (int m = gw; m < M; m += NGW) rms_row_to_bf16(F.lane, src + (size_t)m * D, gain, F.XN + (size_t)m * D);
}

__device__ __forceinline__ void prep_phase(Frame& F) {
    const int gw = F.vcu * NWAVES + F.wave, NGW = F.G * NWAVES, lane = F.lane;
    const float* cw = F.in[I_CONVW];
    for (int m = gw; m < M; m += NGW) {
        const bf16* prow = F.PROJ + (size_t)m * NPROJ; const int t = m & (SEQ - 1);
        {
            const unsigned w = *(const GAS unsigned*)(prow + PCKV + 2 * lane); const float a = bflo(w), b = bfhi(w);
            const float rstd = 1.f / sqrtf(wave_sum(a * a + b * b) * (1.f / CL) + EPS);
            const float g0 = F.in[I_NKV][2 * lane], g1 = F.in[I_NKV][2 * lane + 1];
            *(GAS unsigned*)(F.KV + (size_t)m * CL + 2 * lane) = pk2(a * rstd * g0, b * rstd * g1);
        }
        {
            const int c0 = 8 * lane; float gb[8], gc[8], xi[8], gc1[8], xi1[8], gc2[8], xi2[8], y[8];
            const bf16* p1 = t >= 1 ? prow - NPROJ : prow; const bf16* p2 = t >= 2 ? prow - 2 * NPROJ : prow; const float f1 = t >= 1 ? 1.f : 0.f, f2 = t >= 2 ? 1.f : 0.f;
            ld8bf(prow + PGB + c0, gb); ld8bf(prow + PGC + c0, gc); ld8bf(prow + PXIN + c0, xi); ld8bf(p1 + PGC + c0, gc1); ld8bf(p1 + PXIN + c0, xi1); ld8bf(p2 + PGC + c0, gc2); ld8bf(p2 + PXIN + c0, xi2);
            const GAS f32x4* cw4 = (const GAS f32x4*)(cw + c0);
            const f32x4 wa0 = cw4[0], wa1 = cw4[1], wb0 = cw4[128], wb1 = cw4[129], wc0 = cw4[256], wc1 = cw4[257];
            const float w0[8] = {wa0.x, wa0.y, wa0.z, wa0.w, wa1.x, wa1.y, wa1.z, wa1.w}, w1[8] = {wb0.x, wb0.y, wb0.z, wb0.w, wb1.x, wb1.y, wb1.z, wb1.w}, w2[8] = {wc0.x, wc0.y, wc0.z, wc0.w, wc1.x, wc1.y, wc1.z, wc1.w};
#pragma unroll
            for (int e = 0; e < 8; ++e) y[e] = w2[e] * (gc[e] * xi[e]) + f1 * (w1[e] * (gc1[e] * xi1[e])) + f2 * (w0[e] * (gc2[e] * xi2[e]));
            float ss = 0.f;
#pragma unroll
            for (int e = 0; e < 8; ++e) { y[e] *= gb[e]; ss += y[e] * y[e]; }
            const float rstd = 1.f / sqrtf(wave_sum(ss) * (1.f / 512.f) + EPS);
            const float* g = F.in[I_NCONV] + c0;
            v4u o; o.x = pk2(y[0] * rstd * g[0], y[1] * rstd * g[1]); o.y = pk2(y[2] * rstd * g[2], y[3] * rstd * g[3]); o.z = pk2(y[4] * rstd * g[4], y[5] * rstd * g[5]); o.w = pk2(y[6] * rstd * g[6], y[7] * rstd * g[7]);
            *(GAS v4u*)(F.MIX + (size_t)m * D + 512 + c0) = o;
        }
    }
}

__device__ __forceinline__ int wave_sum_i(int v) {
#pragma unroll
    for (int o = 1; o < 64; o <<= 1) v += __shfl_xor(v, o);
    return v;
}
__device__ __forceinline__ int rel_bucket(int d) {
    if (d < 16) return d;
    return 16 + (d >= 19) + (d >= 21) + (d >= 24) + (d >= 27) + (d >= 31) + (d >= 35) + (d >= 40) + (d >= 46) + (d >= 52) + (d >= 59) + (d >= 67) + (d >= 77) + (d >= 87) + (d >= 99) + (d >= 113);
}
__device__ __forceinline__ void naive_attn_query(Frame& F, int m, LAS float* L) {
    const int lane = F.lane, b = m >> 11, t = m & (SEQ - 1);
    LAS float* qi_s = L;
    LAS float* qa_s = L + 512;
    LAS int* sel_s = (LAS int*)(L + 1536);
    LAS unsigned* sc_s = (LAS unsigned*)(L + 1792);
    LAS float* p_s = L + 1792;
    const bf16* prow = F.PROJ + (size_t)m * NPROJ;
    const bf16* pb = F.PROJ + (size_t)(b * SEQ) * NPROJ;
    float f8[8];
    ld8bf(prow + PQI + 8 * lane, f8);
#pragma unroll
    for (int e = 0; e < 8; ++e) qi_s[8 * lane + e] = f8[e];
    float wv[8]; ld8bf(prow + PWI, wv);
#pragma unroll
    for (int h = 0; h < 8; ++h) wv[h] *= IDX_SCALE;
    LDS_WAIT();
    for (int s = lane; s <= t; s += 64) {
        const bf16* kr = pb + (size_t)s * NPROJ + PKI; float dot[8];
#pragma unroll
        for (int h = 0; h < 8; ++h) dot[h] = 0.f;
#pragma unroll 1
        for (int ch = 0; ch < 8; ++ch) { float k[8]; ld8bf(kr + 8 * ch, k);
#pragma unroll
            for (int h = 0; h < 8; ++h)
#pragma unroll
                for (int e = 0; e < 8; ++e) dot[h] += qi_s[h * 64 + ch * 8 + e] * k[e]; }
        float score = 0.f;
#pragma unroll
        for (int h = 0; h < 8; ++h) score += wv[h] * fmaxf(dot[h], 0.f);
        unsigned u = __float_as_uint(score); u = (u & 0x80000000u) ? ~u : (u | 0x80000000u);
        sc_s[s] = u;
    }
    LDS_WAIT();
    int nsel;
    if (t < TOPK) { nsel = t + 1; for (int i = lane; i < nsel; i += 64) sel_s[i] = i; }
    else {
        unsigned T = 0u;
        for (int bit = 31; bit >= 0; --bit) { const unsigned cand = T | (1u << bit); int cnt = 0;
            for (int s = lane; s <= t; s += 64) cnt += (sc_s[s] >= cand) ? 1 : 0;
            cnt = wave_sum_i(cnt); if (cnt >= TOPK) T = cand; }
        int cgt = 0; for (int s = lane; s <= t; s += 64) cgt += (sc_s[s] > T) ? 1 : 0;
        cgt = wave_sum_i(cgt);
        const int need = TOPK - cgt; int base = 0, taken = 0; const unsigned long long lt = (1ull << lane) - 1ull;
        for (int s0 = 0; s0 <= t; s0 += 64) { const int s = s0 + lane; const bool valid = s <= t; const unsigned key = valid ? sc_s[s] : 0u;
            const bool gt = valid && key > T, eq = valid && key == T;
            const unsigned long long eqm = __ballot(eq); const int eqrank = taken + __popcll(eqm & lt);
            const bool selb = gt || (eq && eqrank < need);
            const unsigned long long sm = __ballot(selb); const int pos = base + __popcll(sm & lt);
            if (selb) sel_s[pos] = s;
            base += __popcll(sm); taken += __popcll(eqm); }
        nsel = TOPK;
    }
    ld8bf(prow + PQ + 8 * lane, f8);
#pragma unroll
    for (int e = 0; e < 8; ++e) qi_s[8 * lane + e] = f8[e];
    LDS_WAIT();
    for (int i = 0; i < 16; ++i) { const int o = lane + 64 * i, h = o >> 7, c = o & 127; const GAS f32x4* w = (const GAS f32x4*)(F.in[I_WUK] + ((size_t)c * 8 + h) * 64); float a = 0.f;
#pragma unroll
        for (int d4 = 0; d4 < 16; ++d4) { const f32x4 wv4 = w[d4]; a += qi_s[h * 64 + 4 * d4] * wv4.x + qi_s[h * 64 + 4 * d4 + 1] * wv4.y + qi_s[h * 64 + 4 * d4 + 2] * wv4.z + qi_s[h * 64 + 4 * d4 + 3] * wv4.w; }
        qa_s[o] = a * 0.125f; }
    LDS_WAIT();
    for (int i = 0; i < 4; ++i) { const int kidx = lane + 64 * i; float lg[8];
        if (kidx < nsel) { const int s = sel_s[kidx]; const bf16* kr = F.KV + (size_t)(b * SEQ + s) * CL;
#pragma unroll
            for (int h = 0; h < 8; ++h) lg[h] = 0.f;
#pragma unroll 1
            for (int ch = 0; ch < 16; ++ch) { float k[8]; ld8bf(kr + 8 * ch, k);
#pragma unroll
                for (int h = 0; h < 8; ++h)
#pragma unroll
                    for (int e = 0; e < 8; ++e) lg[h] += qa_s[h * 128 + ch * 8 + e] * k[e]; }
            const float* rb = F.in[I_RELB] + rel_bucket(t - s) * 8;
#pragma unroll
            for (int h = 0; h < 8; ++h) lg[h] += rb[h];
        } else {
#pragma unroll
            for (int h = 0; h < 8; ++h) lg[h] = -INFINITY; }
#pragma unroll
        for (int h = 0; h < 8; ++h) p_s[h * 256 + kidx] = lg[h]; }
    LDS_WAIT();
    for (int h = 0; h < 8; ++h) { float v[4], mx = -INFINITY;
#pragma unroll
        for (int i = 0; i < 4; ++i) { v[i] = p_s[h * 256 + lane + 64 * i]; mx = fmaxf(mx, v[i]); }
        mx = wave_max(mx); float sm = 0.f;
#pragma unroll
        for (int i = 0; i < 4; ++i) { v[i] = __expf(v[i] - mx); sm += v[i]; }
        sm = wave_sum(sm); const float inv = 1.f / sm;
#pragma unroll
        for (int i = 0; i < 4; ++i) p_s[h * 256 + lane + 64 * i] = v[i] * inv; }
    LDS_WAIT();
    float cx[8][2];
#pragma unroll
    for (int h = 0; h < 8; ++h) { cx[h][0] = 0.f; cx[h][1] = 0.f; }
    for (int k = 0; k < nsel; ++k) { const int s = sel_s[k]; const unsigned w = *(const GAS unsigned*)(F.KV + (size_t)(b * SEQ + s) * CL + 2 * lane); const float k0 = bflo(w), k1 = bfhi(w);
#pragma unroll
        for (int h = 0; h < 8; ++h) { const float p = p_s[h * 256 + k]; cx[h][0] += p * k0; cx[h][1] += p * k1; } }
#pragma unroll
    for (int h = 0; h < 8; ++h) { qa_s[h * 128 + 2 * lane] = cx[h][0]; qa_s[h * 128 + 2 * lane + 1] = cx[h][1]; }
    LDS_WAIT();
    float o8[8]; float ss = 0.f;
#pragma unroll
    for (int h = 0; h < 8; ++h) { float a = 0.f; const float* w = F.in[I_WUV] + h * 64 + lane;
        for (int c = 0; c < 128; ++c) a += qa_s[h * 128 + c] * w[(size_t)c * 512];
        o8[h] = a; ss += a * a; }
    const float rstd = 1.f / sqrtf(wave_sum(ss) * (1.f / 512.f) + EPS);
#pragma unroll
    for (int h = 0; h < 8; ++h) F.MIX[(size_t)m * D + h * 64 + lane] = (bf16)f2bf(o8[h] * rstd * F.in[I_NATT][h * 64 + lane]);
    LDS_WAIT();
}
__device__ __forceinline__ void naive_attn_phase(Frame& F) {
    LAS float* L = (LAS float*)(F.lds + RING_OFF + F.wave * 16384);
    const int gw = F.vcu * NWAVES + F.wave, NGW = F.G * NWAVES;
    for (int idx = gw; idx < M; idx += NGW) { const int b = idx >> 11, tt = idx & (SEQ - 1), t = (b & 1) ? (SEQ - 1 - tt) : tt; naive_attn_query(F, b * SEQ + t, L); }
}

namespace idx {
typedef short bf16x8 __attribute__((ext_vector_type(8)));
typedef float f32x16 __attribute__((ext_vector_type(16)));
constexpr int CHUNK_KEYS = 256, CHUNK_BYTES = CHUNK_KEYS * 128;
__device__ __forceinline__ unsigned sortable(float s) { const unsigned u = __float_as_uint(s); return u ^ ((unsigned)((int)u >> 31) | 0x80000000u); }
__device__ __forceinline__ float relu_i(float x) { const int i = __float_as_int(x); return __int_as_float(i > 0 ? i : 0); }
__device__ __forceinline__ int half_sum(int v, int hi) {
    v += __builtin_amdgcn_update_dpp(0, v, 0x111, 0xf, 0xf, false);
    v += __builtin_amdgcn_update_dpp(0, v, 0x112, 0xf, 0xf, false);
    v += __builtin_amdgcn_update_dpp(0, v, 0x114, 0xf, 0xf, false);
    v += __builtin_amdgcn_update_dpp(0, v, 0x118, 0xf, 0xf, false);
    v += __builtin_amdgcn_update_dpp(0, v, 0x142, 0xa, 0xf, false);
    const int lo = __builtin_amdgcn_readlane(v, 31), up = __builtin_amdgcn_readlane(v, 63);
    return hi ? up : lo;
}
#define IDX_CNT4(x0, y0, x1, y1) do { unsigned long long t0_, t1_, t2_, t3_; asm volatile( \
        "v_cmp_ge_u32_e64 %2, %6, %10\n\tv_cmp_ge_u32_e64 %3, %7, %11\n\tv_cmp_ge_u32_e64 %4, %8, %10\n\tv_cmp_ge_u32_e64 %5, %9, %11\n\t" \
        "v_addc_co_u32_e64 %0, %2, 0, %0, %2\n\tv_addc_co_u32_e64 %1, %3, 0, %1, %3\n\tv_addc_co_u32_e64 %0, %4, 0, %0, %4\n\tv_addc_co_u32_e64 %1, %5, 0, %1, %5" \
        : "+v"(cnt0), "+v"(cnt1), "=&s"(t0_), "=&s"(t1_), "=&s"(t2_), "=&s"(t3_) : "v"(x0), "v"(y0), "v"(x1), "v"(y1), "v"(c0), "v"(c1)); } while (0)
#define IDX_WL(dst, val, ln) asm volatile("v_writelane_b32 %0, %1, %2" : "+v"(dst) : "s"(val), "i"(ln))
#define IDX_FOR_KB(...) _Pragma("unroll") for (int g_ = 0; g_ < 8; ++g_) { if (8 * g_ <= qb) { _Pragma("unroll") for (int k_ = 0; k_ < 8; ++k_) { const int kb = 8 * g_ + k_; __VA_ARGS__ } } }
#define IDX_FOR_KB2(...) _Pragma("unroll") for (int g_ = 0; g_ < 8; ++g_) { if (8 * g_ <= qb) { _Pragma("unroll") for (int k_ = 0; k_ < 8; k_ += 2) { const int kb = 8 * g_ + k_; __VA_ARGS__ } } }
__device__ __forceinline__ void idx_unit(Frame& F, int b, int qb, LAS unsigned char* lds) {
    const int tid = F.tid, lane = F.lane, w = F.wave, r32 = lane & 31, hi = lane >> 5;
    const int q0 = 32 * qb; const size_t rowbase = (size_t)b * SEQ;
    const int ri = (r32 & 3) + 4 * (r32 >> 3), hii = (r32 >> 2) & 1;
    const bf16* arow = F.PROJ + (rowbase + q0 + 4 * w + 2 * hii + (ri >> 3)) * NPROJ + PQI + (ri & 7) * 64 + 8 * hi;
    bf16x8 A[4];
#pragma unroll
    for (int s = 0; s < 4; ++s) A[s] = *(const GAS bf16x8*)(arow + 16 * s);
    float wv[2][8];
#pragma unroll
    for (int qq = 0; qq < 2; ++qq) { ld8bf(F.PROJ + (rowbase + q0 + 4 * w + 2 * hi + qq) * NPROJ + PWI, wv[qq]);
#pragma unroll
        for (int h = 0; h < 8; ++h) wv[qq][h] *= IDX_SCALE; }
    const int lim0 = 4 * w + 2 * hi;
    unsigned sc[64][2];
#pragma unroll
    for (int p = 0; p < 64; ++p) { sc[p][0] = 0u; sc[p][1] = 0u; }
    const bf16* kptr = F.PROJ + (rowbase + 32 * w + (lane >> 3)) * NPROJ + PKI;
    unsigned coff[4];
#pragma unroll
    for (int i = 0; i < 4; ++i) coff[i] = (unsigned)((((lane & 7) ^ ((4 * i + (lane >> 4)) & 7)) * 8) + 8 * i * NPROJ);
#define IDX_DMA(bufb) do { _Pragma("unroll") for (int i_ = 0; i_ < 4; ++i_) __builtin_amdgcn_global_load_lds((const unsigned*)(kptr + coff[i_]), (LAS unsigned*)(lds + (bufb) + (4 * w + i_) * 1024), 16, 0, 0); \
        kptr += (size_t)CHUNK_KEYS * NPROJ; } while (0)
    unsigned boff[4];
#pragma unroll
    for (int s = 0; s < 4; ++s) boff[s] = (unsigned)(r32 * 128 + (((2 * s + hi) ^ ((r32 >> 1) & 7)) << 4));
    IDX_DMA(0);
    const int nch = (qb >> 3) + 1;
#pragma unroll 1
    for (int ch = 0; ch < nch; ++ch) {
        asm volatile("s_waitcnt vmcnt(0)" ::: "memory");
        __syncthreads();
        const int cb = (ch & 1) * CHUNK_BYTES;
        if (ch + 1 < nch) IDX_DMA(CHUNK_BYTES - cb);
#pragma unroll
        for (int p = 63; p >= 8; --p) { sc[p][0] = sc[p - 8][0]; sc[p][1] = sc[p - 8][1]; }
#pragma unroll
        for (int k = 0; k < 8; ++k) {
            f32x16 acc = {};
#pragma unroll
            for (int s = 0; s < 4; ++s) { const bf16x8 B = *(const LAS bf16x8*)(lds + cb + boff[s] + k * 4096);
                acc = __builtin_amdgcn_mfma_f32_32x32x16_bf16(A[s], B, acc, 0, 0, 0); }
            float s0 = 0.f, s1 = 0.f;
#pragma unroll
            for (int h = 0; h < 8; ++h) { s0 = fmaf(relu_i(acc[h]), wv[0][h], s0); s1 = fmaf(relu_i(acc[8 + h]), wv[1][h], s1); }
            unsigned u0 = sortable(s0), u1 = sortable(s1);
            const int kb = 8 * ch + k;
            if (kb >= qb) { if (kb > qb || r32 > lim0) u0 = 0u; if (kb > qb || r32 > lim0 + 1) u1 = 0u; }
            sc[k][0] = u0; sc[k][1] = u1;
            __builtin_amdgcn_sched_barrier(0);
        }
    }
    __syncthreads();
    unsigned T0 = 1u, T1 = 1u; bool d0 = true, d1 = true;
    if (qb >= 8) {
        T0 = 0u; T1 = 0u; d0 = false; d1 = false;
#pragma unroll 1
        for (int bit = 31; bit >= 0; --bit) {
            const unsigned c0 = T0 | (1u << bit), c1 = T1 | (1u << bit); int cnt0 = 0, cnt1 = 0;
            IDX_FOR_KB2( IDX_CNT4(sc[kb][0], sc[kb][1], sc[kb + 1][0], sc[kb + 1][1]); )
            const int cnt = half_sum(cnt0 | (cnt1 << 16), hi);
            const int n0 = cnt & 0xffff, n1 = cnt >> 16;
            if (!d0 && n0 >= TOPK) { T0 = c0; d0 = (n0 == TOPK); }
            if (!d1 && n1 >= TOPK) { T1 = c1; d1 = (n1 == TOPK); }
            if (__all(d0 && d1)) break;
        }
    }
    unsigned mw0 = 0u, mw1 = 0u, mw2 = 0u, mw3 = 0u;
    if (__all(d0 && d1)) {
        IDX_FOR_KB( const unsigned long long m0 = __ballot(sc[kb][0] >= T0), m1 = __ballot(sc[kb][1] >= T1);
            IDX_WL(mw0, (unsigned)m0, kb); IDX_WL(mw2, (unsigned)(m0 >> 32), kb);
            IDX_WL(mw1, (unsigned)m1, kb); IDX_WL(mw3, (unsigned)(m1 >> 32), kb); )
    } else {
        int cg = 0;
        IDX_FOR_KB( cg += (sc[kb][0] > T0 ? 1 : 0) + (sc[kb][1] > T1 ? 65536 : 0); )
        cg = half_sum(cg, hi);
        const int need0 = d0 ? (1 << 20) : TOPK - (cg & 0xffff), need1 = d1 ? (1 << 20) : TOPK - (cg >> 16);
        int taken0 = 0, taken1 = 0; const unsigned lt = (1u << r32) - 1u;
#pragma unroll
        for (int g_ = 7; g_ >= 0; --g_) { if (g_ < nch) {
#pragma unroll
            for (int k_ = 0; k_ < 8; ++k_) { const int kb = 8 * g_ + k_;
                const bool e0 = sc[kb][0] == T0, e1 = sc[kb][1] == T1;
                const unsigned long long em0 = __ballot(e0), em1 = __ballot(e1);
                const unsigned h0 = hi ? (unsigned)(em0 >> 32) : (unsigned)em0, h1 = hi ? (unsigned)(em1 >> 32) : (unsigned)em1;
                const bool s0 = sc[kb][0] > T0 || (e0 && taken0 + __popc(h0 & lt) < need0), s1 = sc[kb][1] > T1 || (e1 && taken1 + __popc(h1 & lt) < need1);
                taken0 += __popc(h0); taken1 += __popc(h1);
                const unsigned long long m0 = __ballot(s0), m1 = __ballot(s1);
                IDX_WL(mw0, (unsigned)m0, kb); IDX_WL(mw2, (unsigned)(m0 >> 32), kb);
                IDX_WL(mw1, (unsigned)m1, kb); IDX_WL(mw3, (unsigned)(m1 >> 32), kb); } } }
    }
    const int kbl = (lane < 8 * nch) ? 8 * (nch - 1 - (lane >> 3)) + (lane & 7) : lane;
    unsigned* mrow = F.MASK + (rowbase + q0 + 4 * w) * 64 + kbl;
    mrow[0] = mw0; mrow[64] = mw1; mrow[128] = mw2; mrow[192] = mw3;
#undef IDX_DMA
}
#undef IDX_FOR_KB
#undef IDX_FOR_KB2
#undef IDX_WL
#undef IDX_CNT4
__device__ __forceinline__ void idx_phase(Frame& F) {
    for (int v2 = 2 * F.vcu; v2 < 512; v2 += 2 * F.G)
        for (int u = 0; u < 2 * (1 + ((REP_MASK >> 5) & 1)); ++u) { const int v = v2 >> 1, b = v >> 5, j = v & 31; idx_unit(F, b, (u & 1) ? j : 63 - j, F.lds + RING_OFF); }
}
}

namespace att {
typedef short bf16x8 __attribute__((ext_vector_type(8)));
typedef short s16x4 __attribute__((ext_vector_type(4)));
typedef float f32x16 __attribute__((ext_vector_type(16)));
typedef unsigned u32x4 __attribute__((ext_vector_type(4)));
typedef float f32x2_t __attribute__((ext_vector_type(2))); typedef __bf16 bf16x2_t __attribute__((ext_vector_type(2)));
constexpr float LOG2E = 1.4426950408889634f;
constexpr int NBUF = 3, L_K = 0, L_V = NBUF * 16384, L_TBL = 2 * NBUF * 16384, TBL_N = 320, L_MASK = L_TBL + 8 * TBL_N * 4, MROW = 66, L_RMS = L_MASK + 32 * MROW * 4, L_END = L_RMS + 8 * 32 * 4;
static_assert(L_END <= RING_BYTES, "attention LDS map");
#define ATT_KSWZ(row, colB) ((row) * 256 + ((colB) ^ (((row) & 7) << 4)))
#define ATT_SBAR() __builtin_amdgcn_sched_barrier(0)
__device__ __forceinline__ unsigned cvtpk(float lo, float hi) { f32x2_t v = {lo, hi}; bf16x2_t b = __builtin_convertvector(v, bf16x2_t); return __builtin_bit_cast(unsigned, b); }
__device__ __forceinline__ int v_st(int k, int c) { const int kk = (k & ~0xC) | ((k & 4) << 1) | ((k & 8) >> 1); return ((kk >> 3) * 4 + (c >> 5)) * 512 + ((kk & 7) * 32 + (c & 31)) * 2; }
__device__ __forceinline__ int v_rd_base(int lane) { return ((lane & 3) << 3) | (((lane >> 2) & 3) << 6) | (((lane >> 4) & 1) << 5) | (((lane >> 5) & 1) << 8); }
constexpr int v_rd_off(int d0, int ks, int half) { return d0 * 512 + ks * 4096 + half * 2048; }
template <int OFF> __device__ __forceinline__ s16x4 tr_read(int vb) { s16x4 r; asm volatile("ds_read_b64_tr_b16 %0, %1 offset:%2" : "=&v"(r) : "v"(vb), "i"(OFF) : "memory"); return r; }
template <int D0> __device__ __forceinline__ void pv_rd(s16x4 (&l)[4], s16x4 (&h)[4], int vb) {
    l[0] = tr_read<v_rd_off(D0, 0, 0)>(vb); h[0] = tr_read<v_rd_off(D0, 0, 1)>(vb); l[1] = tr_read<v_rd_off(D0, 1, 0)>(vb); h[1] = tr_read<v_rd_off(D0, 1, 1)>(vb);
    l[2] = tr_read<v_rd_off(D0, 2, 0)>(vb); h[2] = tr_read<v_rd_off(D0, 2, 1)>(vb); l[3] = tr_read<v_rd_off(D0, 3, 0)>(vb); h[3] = tr_read<v_rd_off(D0, 3, 1)>(vb);
}
#define ATT_PK(L, H) (bf16x8){L[0], L[1], L[2], L[3], H[0], H[1], H[2], H[3]}
__device__ __forceinline__ void pv_mm(f32x16& od, const s16x4 (&l)[4], const s16x4 (&h)[4], bf16x8 pa0, bf16x8 pa1, bf16x8 pa2, bf16x8 pa3) {
    od = __builtin_amdgcn_mfma_f32_32x32x16_bf16(ATT_PK(l[0], h[0]), pa0, od, 0, 0, 0);
    od = __builtin_amdgcn_mfma_f32_32x32x16_bf16(ATT_PK(l[1], h[1]), pa1, od, 0, 0, 0);
    od = __builtin_amdgcn_mfma_f32_32x32x16_bf16(ATT_PK(l[2], h[2]), pa2, od, 0, 0, 0);
    od = __builtin_amdgcn_mfma_f32_32x32x16_bf16(ATT_PK(l[3], h[3]), pa3, od, 0, 0, 0);
}
#undef ATT_PK
#define ATT_LWAIT(n) do { asm volatile("s_waitcnt lgkmcnt(" #n ")" ::: "memory"); ATT_SBAR(); } while (0)
__device__ __forceinline__ void pv_all(f32x16 (&o)[4], int vb, bf16x8 pa0, bf16x8 pa1, bf16x8 pa2, bf16x8 pa3) {
    s16x4 la[4], ha[4], lb[4], hb[4];
    asm volatile("s_waitcnt lgkmcnt(0)" ::: "memory");
    pv_rd<0>(la, ha, vb); pv_rd<1>(lb, hb, vb);
    ATT_LWAIT(8); pv_mm(o[0], la, ha, pa0, pa1, pa2, pa3);
    pv_rd<2>(la, ha, vb);
    ATT_LWAIT(8); pv_mm(o[1], lb, hb, pa0, pa1, pa2, pa3);
    pv_rd<3>(lb, hb, vb);
    ATT_LWAIT(8); pv_mm(o[2], la, ha, pa0, pa1, pa2, pa3);
    ATT_LWAIT(0); pv_mm(o[3], lb, hb, pa0, pa1, pa2, pa3);
}
#undef ATT_LWAIT
__device__ __forceinline__ float max3f(float a, float b, float c) { float r; asm("v_max3_f32 %0, %1, %2, %3" : "=v"(r) : "v"(a), "v"(b), "v"(c)); return r; }
__device__ __forceinline__ float and_f(float p, int m) { float r; asm("v_and_b32 %0, %1, %2" : "=v"(r) : "v"(p), "v"(m)); return r; }
__device__ __forceinline__ bf16x8 pack8(const f32x16& x, int s, float sc) {
    u32x4 w = {cvtpk(x[8 * s] * sc, x[8 * s + 1] * sc), cvtpk(x[8 * s + 2] * sc, x[8 * s + 3] * sc), cvtpk(x[8 * s + 4] * sc, x[8 * s + 5] * sc), cvtpk(x[8 * s + 6] * sc, x[8 * s + 7] * sc)};
    return __builtin_bit_cast(bf16x8, w);
}
__device__ __forceinline__ void attn_tables(Frame& F, LAS unsigned char* lds) {
    LAS float* tbl = (LAS float*)(lds + L_TBL);
    for (int i = F.tid; i < 8 * TBL_N; i += NWAVES * 64) { const int h = i / TBL_N, dist = 255 - (i % TBL_N); tbl[i] = dist >= 0 ? F.in[I_RELB][rel_bucket(dist) * 8 + h] * LOG2E : 0.f; }
    __syncthreads();
}
__device__ __forceinline__ void attn_unit(Frame& F, int b, int qb, LAS unsigned char* lds) {
    const int tid = F.tid, lane = F.lane, h = F.wave, r32 = lane & 31, hi = lane >> 5;
    const int q0 = 32 * qb, NT = (qb >> 1) + 1; const size_t rowbase = (size_t)b * SEQ;
    LAS unsigned* msk = (LAS unsigned*)(lds + L_MASK); const LAS float* tbl = (const LAS float*)(lds + L_TBL); LAS float* rms = (LAS float*)(lds + L_RMS);
#pragma unroll
    for (int i = 0; i < 4; ++i) { const int wd = tid + 512 * i; msk[(wd >> 6) * MROW + (wd & 63)] = F.MASK[(rowbase + q0 + (wd >> 6)) * 64 + (wd & 63)]; }
    bf16x8 qr[8];
    {
        bf16x8 Bq[4];
        const bf16* qrow = F.PROJ + (rowbase + q0 + r32) * NPROJ + PQ + h * 64 + 8 * hi;
#pragma unroll
        for (int s = 0; s < 4; ++s) Bq[s] = *(const GAS bf16x8*)(qrow + 16 * s);
        const int ri = (r32 & 3) + 4 * (r32 >> 3), hii = (r32 >> 2) & 1;
#pragma unroll
        for (int cb = 0; cb < 4; ++cb) { const int c = 32 * cb + 16 * (ri >> 3) + 8 * hii + (ri & 7); const bf16* wrow = F.Wuk + ((size_t)c * 8 + h) * 64 + 8 * hi;
            f32x16 acc = {};
#pragma unroll
            for (int s = 0; s < 4; ++s) acc = __builtin_amdgcn_mfma_f32_32x32x16_bf16(*(const GAS bf16x8*)(wrow + 16 * s), Bq[s], acc, 0, 0, 0);
            qr[2 * cb] = pack8(acc, 0, 0.125f * LOG2E); qr[2 * cb + 1] = pack8(acc, 1, 0.125f * LOG2E); }
    }
    const float b31 = F.in[I_RELB][31 * 8 + h] * LOG2E;
    const int sr = tid >> 4, scol = (tid & 15) * 8, vst0 = v_st(sr, scol), vst1 = v_st(32 + sr, scol);
    const int vb0 = (int)(unsigned)(uintptr_t)(lds + L_V) + v_rd_base(lane);
    const bf16* kvb = F.KV + rowbase * CL + (size_t)sr * CL + scol;
    v4u st0, st1;
#define ATT_SLOAD(k0) do { st0 = *(const GAS v4u*)(kvb + (size_t)(k0) * CL); st1 = *(const GAS v4u*)(kvb + (size_t)((k0) + 32) * CL); } while (0)
#define ATT_SWRITE(bf) do { *(LAS v4u*)(lds + L_V + (bf) * 16384 + vst0) = st0; *(LAS v4u*)(lds + L_V + (bf) * 16384 + vst1) = st1; \
        *(LAS v4u*)(lds + L_K + (bf) * 16384 + ATT_KSWZ(sr, scol * 2)) = st0; *(LAS v4u*)(lds + L_K + (bf) * 16384 + ATT_KSWZ(32 + sr, scol * 2)) = st1; } while (0)
    float m_run = -INFINITY, l_run = 0.f; f32x16 o[4] = {};
    const bool stag = h >= 4;
    bf16x8 pa0 = {}, pa1 = {}, pa2 = {}, pa3 = {};
    ATT_SLOAD(0); ATT_SWRITE(0); __syncthreads();
    int buf = 0, pbuf = 0;
#pragma unroll 1
    for (int j = 0; j < NT; ++j) {
        const int k0 = 64 * j;
        if (j + 1 < NT) ATT_SLOAD(k0 + 64);
        if (stag && j > 0) { const int vb = vb0 + pbuf * 16384;
            pv_all(o, vb, pa0, pa1, pa2, pa3); }
        f32x16 p0 = {}, p1 = {};
        { const LAS unsigned char* Ks = lds + L_K + buf * 16384; bf16x8 kf[8];
#pragma unroll
          for (int hf = 0; hf < 2; ++hf) {
#pragma unroll
              for (int d = 0; d < 4; ++d) { const int cbyte = ((4 * hf + d) * 16 + hi * 8) * 2; kf[2 * d] = *(const LAS bf16x8*)(Ks + ATT_KSWZ(r32, cbyte)); kf[2 * d + 1] = *(const LAS bf16x8*)(Ks + ATT_KSWZ(32 + r32, cbyte)); }
              ATT_SBAR();
#pragma unroll
              for (int d = 0; d < 4; ++d) { p0 = __builtin_amdgcn_mfma_f32_32x32x16_bf16(kf[2 * d], qr[4 * hf + d], p0, 0, 0, 0); p1 = __builtin_amdgcn_mfma_f32_32x32x16_bf16(kf[2 * d + 1], qr[4 * hf + d], p1, 0, 0, 0); }
              ATT_SBAR(); } }
        const unsigned long long mwd = *(const LAS unsigned long long*)(msk + r32 * MROW + 2 * j);
        const int w0 = (int)((unsigned)mwd >> (4 * hi)), w1 = (int)((unsigned)(mwd >> 32) >> (4 * hi));
        const bool far = (k0 + 176 <= q0);
        if (!far) { const LAS float* tb = tbl + h * TBL_N + (255 - (q0 + r32) + k0 + 4 * hi);
#pragma unroll
            for (int r = 0; r < 16; ++r) { p0[r] += tb[(r & 3) + 8 * (r >> 2)]; p1[r] += tb[32 + (r & 3) + 8 * (r >> 2)]; } }
        asm volatile("s_nop 15\n\ts_nop 7" : "+v"(p0), "+v"(p1));
        float rm = max3f(p0[0], p1[0], p0[1]); rm = max3f(rm, p1[1], p0[2]); rm = max3f(rm, p1[2], p0[3]); rm = max3f(rm, p1[3], p0[4]);
#pragma unroll
        for (int r = 4; r < 15; r += 2) { rm = max3f(rm, p1[r], p0[r + 1]); rm = max3f(rm, p1[r + 1], r + 2 < 16 ? p0[r + 2] : p1[15]); }
        { auto rr = __builtin_amdgcn_permlane32_swap(__float_as_uint(rm), __float_as_uint(rm), false, false); rm = max3f(__uint_as_float(rr[0]), __uint_as_float(rr[1]), __uint_as_float(rr[1])); }
        const float boff = far ? b31 : 0.f, mnew = max3f(m_run, rm + boff, rm + boff), alpha = __builtin_amdgcn_exp2f(m_run - mnew), off = mnew - boff;
        m_run = mnew;
        float ps = 0.f;
#pragma unroll
        for (int r = 0; r < 16; ++r) { const int pos = (r & 3) + 8 * (r >> 2);
            p0[r] = and_f(__builtin_amdgcn_exp2f(p0[r] - off), __builtin_amdgcn_sbfe(w0, pos, 1));
            p1[r] = and_f(__builtin_amdgcn_exp2f(p1[r] - off), __builtin_amdgcn_sbfe(w1, pos, 1));
            ps += p0[r] + p1[r]; }
        { auto rr = __builtin_amdgcn_permlane32_swap(__float_as_uint(ps), __float_as_uint(ps), false, false); ps = __uint_as_float(rr[0]) + __uint_as_float(rr[1]); }
        l_run = l_run * alpha + ps;
        if (__any(alpha < 1.f)) {
#pragma unroll
            for (int d = 0; d < 4; ++d)
#pragma unroll
                for (int r = 0; r < 16; ++r) o[d][r] *= alpha; }
#define ATT_PK4(P, BASE, OUT) do { unsigned a0 = cvtpk(P[BASE + 0], P[BASE + 1]), a1 = cvtpk(P[BASE + 2], P[BASE + 3]);   \
        unsigned b0 = cvtpk(P[BASE + 4], P[BASE + 5]), b1 = cvtpk(P[BASE + 6], P[BASE + 7]);                              \
        auto r0 = __builtin_amdgcn_permlane32_swap(a0, b0, false, false); auto r1 = __builtin_amdgcn_permlane32_swap(a1, b1, false, false); \
        u32x4 w_ = {r0[0], r1[0], r0[1], r1[1]}; OUT = __builtin_bit_cast(bf16x8, w_); } while (0)
        ATT_PK4(p0, 0, pa0); ATT_PK4(p0, 8, pa1); ATT_PK4(p1, 0, pa2); ATT_PK4(p1, 8, pa3);
#undef ATT_PK4
        ATT_SBAR();
        if (!stag) { const int vb = vb0 + buf * 16384;
          pv_all(o, vb, pa0, pa1, pa2, pa3); }
        pbuf = buf; buf = buf == NBUF - 1 ? 0 : buf + 1;
        if (j + 1 < NT) ATT_SWRITE(buf);
        __syncthreads();
    }
    if (stag) { const int vb = vb0 + pbuf * 16384;
        pv_all(o, vb, pa0, pa1, pa2, pa3); }
    const float inv = 1.f / l_run;
    f32x16 ot[2] = {};
#pragma unroll
    for (int cb = 0; cb < 4; ++cb)
#pragma unroll
        for (int s = 0; s < 2; ++s) { const bf16x8 Bo = pack8(o[cb], s, inv);
#pragma unroll
            for (int db = 0; db < 2; ++db) { const bf16* wp = F.WuvT + ((size_t)(h * 64 + 32 * db + r32)) * CL + 32 * cb + 16 * s + 4 * hi;
                const s16x4 lo = *(const GAS s16x4*)wp, hi4 = *(const GAS s16x4*)(wp + 8);
                ot[db] = __builtin_amdgcn_mfma_f32_32x32x16_bf16((bf16x8){lo[0], lo[1], lo[2], lo[3], hi4[0], hi4[1], hi4[2], hi4[3]}, Bo, ot[db], 0, 0, 0); } }
    float ss = 0.f;
#pragma unroll
    for (int r = 0; r < 16; ++r) ss += ot[0][r] * ot[0][r] + ot[1][r] * ot[1][r];
    { auto rr = __builtin_amdgcn_permlane32_swap(__float_as_uint(ss), __float_as_uint(ss), false, false); ss = __uint_as_float(rr[0]) + __uint_as_float(rr[1]); }
    if (hi == 0) rms[h * 32 + r32] = ss;
    __syncthreads();
    float tot = 0.f;
#pragma unroll
    for (int hh = 0; hh < 8; ++hh) tot += rms[hh * 32 + r32];
    const float rstd = 1.f / sqrtf(tot * (1.f / 512.f) + EPS);
    bf16* orow = F.MIX + (rowbase + q0 + r32) * D + h * 64 + 4 * hi; const float* gn = F.in[I_NATT] + h * 64 + 4 * hi;
#pragma unroll
    for (int db = 0; db < 2; ++db)
#pragma unroll
        for (int g4 = 0; g4 < 4; ++g4) { const int dd = 32 * db + 8 * g4; const f32x4 gv = *(const GAS f32x4*)(gn + dd);
            const unsigned x0 = cvtpk(ot[db][4 * g4] * rstd * gv.x, ot[db][4 * g4 + 1] * rstd * gv.y), x1 = cvtpk(ot[db][4 * g4 + 2] * rstd * gv.z, ot[db][4 * g4 + 3] * rstd * gv.w);
            *(GAS unsigned long long*)(orow + dd) = (unsigned long long)x0 | ((unsigned long long)x1 << 32); }
    __syncthreads();
#undef ATT_SLOAD
#undef ATT_SWRITE
}
__device__ __forceinline__ void attn_phase(Frame& F) {
    attn_tables(F, F.lds + RING_OFF);
    for (int v2 = 2 * F.vcu; v2 < 512; v2 += 2 * F.G)
        for (int u = 0; u < 2 * (1 + ((REP_MASK >> 6) & 1)); ++u) { const int v = v2 >> 1, b = v >> 5, j = v & 31; attn_unit(F, b, (u & 1) ? j : 63 - j, F.lds + RING_OFF); }
}
#undef ATT_KSWZ
#undef ATT_SBAR
}

struct Args { const float* in[20]; float* out; unsigned char* ws; int ph_lo, ph_hi, li, pad; };
__global__ void __launch_bounds__(NWAVES * 64, 2) mk_fwd(Args args) {
    extern __shared__ __attribute__((aligned(16))) unsigned char lds[];
    Frame F;
    F.lds = (LAS unsigned char*)lds;
    F.MISC = (volatile LAS unsigned*)(F.lds + MISC_OFF);
    F.tid = threadIdx.x; F.lane = F.tid & 63; F.wave = __builtin_amdgcn_readfirstlane(F.tid >> 6);
    F.G = gridDim.x; { const int bx = blockIdx.x; F.vcu = (F.G % 8 == 0) ? (bx % 8) * (F.G / 8) + bx / 8 : bx; }
    unsigned char* ws = args.ws;
    F.ctl = (gu32*)(ws + WS_CTL);
#pragma unroll
    for (int i = 0; i < 20; ++i) F.in[i] = args.in[i];
    F.out = args.out;
    F.Wgu1 = (bf16*)(ws + WS_WGU1); F.Wd1 = (bf16*)(ws + WS_WD1); F.Win = (bf16*)(ws + WS_WIN); F.Wout = (bf16*)(ws + WS_WOUT); F.Wgu2 = (bf16*)(ws + WS_WGU2); F.Wd2 = (bf16*)(ws + WS_WD2);
    F.Wuk = (bf16*)(ws + WS_WUK); F.WuvT = (bf16*)(ws + WS_WUV);
    F.XN = (bf16*)(ws + WS_XN); F.MIX = (bf16*)(ws + WS_MIX); F.KV = (bf16*)(ws + WS_KV); F.ACT = (bf16*)(ws + WS_ACT); F.PROJ = (bf16*)(ws + WS_ACT); F.MASK = (unsigned*)(ws + WS_MASK); F.SS = (float*)(ws + WS_SS); F.HB = (bf16*)(ws + WS_HB);
    for (int u = F.tid; u < (LDS_BYTES - LDSCTL_OFF) / 4; u += NWAVES * 64) ((LAS unsigned*)(F.lds + LDSCTL_OFF))[u] = 0u;
    __syncthreads();
    XcdBarrier bar; bar.bar = (unsigned*)(F.ctl + CW_BAR); bar.x = 0; bar.st = nullptr;
    if (N_LAUNCHES != PER_PHASE) bar = xcd_barrier_post((unsigned*)(F.ctl + CW_BAR), F.MISC + 8);

    const int lo = args.ph_lo, hi = args.ph_hi;
#ifndef PH_MASK
#define PH_MASK 0xFFF
#endif
#define IN(k) (((PH_MASK >> (k)) & 1) && lo <= (k) && (k) < hi)
#define SEAM(k) do { if (IN(k) && (k) + 1 < hi) { xcd_barrier(bar); if (REP_MASK & 0x2000) xcd_barrier(bar); } } while (0)

    if (IN(0)) { p0_prologue(F); if (REP_MASK & 1) { VM_WAIT(); __syncthreads(); p0_prologue(F); } SEAM(0); }
    if (IN(1)) { pg8::Gemm g{F.XN, F.Wgu1, M, FF2, FFN1_FP8 ? D / 2 : D}; pg8::StaticOrder S; S.init(M, FF2, F.G, (int)blockIdx.x, 1 + ((REP_MASK >> 1) & 1));
        pg8::rstd_table((LAS float*)(F.lds + RTAB_OFF), S, F.SS, 1.0f / D, EPS);
        pg8::EpiSwiglu<FFN1_FP8 != 0> E{F.ACT, FF, (const LAS float*)(F.lds + RTAB_OFF), FFN1_FP8 ? 1.0f / WSC_GU : 1.0f};
        pg8::gemm_phase<pg8::EpiSwiglu<FFN1_FP8 != 0>, pg8::StaticOrder, PG8_ALIGN, PG8_SP2, FFN1_FP8 != 0>(F.lds + RING_OFF, g, S, E); SEAM(1); }
    if (IN(2)) { pg8::Gemm g{F.ACT, F.Wd1, M, D, FFN1_FP8 ? FF / 2 : FF}; pg8::StaticOrder S; S.init(M, D, F.G, (int)blockIdx.x, 1 + ((REP_MASK >> 2) & 1));
        pg8::EpiRes2<false, false, true> E{F.in[I_X], F.HB, nullptr, F.SS, D, FFN1_FP8 ? 0.5f / WSC_DN : 0.5f};
        pg8::gemm_phase<pg8::EpiRes2<false, false, true>, pg8::StaticOrder, PG8_ALIGN, PG8_SP2, FFN1_FP8 != 0>(F.lds + RING_OFF, g, S, E); SEAM(2); }
    if (IN(4)) { pg8::Gemm g{F.HB, F.Win, M, NPROJ, D}; pg8::StaticOrder S; S.init(M, NPROJ, F.G, (int)blockIdx.x, 1 + ((REP_MASK >> 4) & 1));
        pg8::rstd_table((LAS float*)(F.lds + RTAB_OFF), S, F.SS, 1.0f / D, EPS);
        pg8::EpiBf16Rs E{F.PROJ, NPROJ, (const LAS float*)(F.lds + RTAB_OFF)};
        pg8::gemm_phase<pg8::EpiBf16Rs, pg8::StaticOrder, PG8_ALIGN, PG8_SP2>(F.lds + RING_OFF, g, S, E); SEAM(4); }
#ifndef USE_NAIVE_ATTN
#define USE_NAIVE_ATTN 0
#endif
    if (IN(5)) { prep_phase(F); if (REP_MASK & 0x1000) prep_phase(F); if (!USE_NAIVE_ATTN) idx::idx_phase(F); SEAM(5); }
    if (IN(6)) { if (USE_NAIVE_ATTN) naive_attn_phase(F); else att::attn_phase(F); SEAM(6); }
    if (IN(7)) { pg8::Gemm g{F.MIX, F.Wout, M, D, D}; pg8::StaticOrder S; S.init(M, D, F.G, (int)blockIdx.x);
        pg8::EpiRes2<true, true, true> E{F.HB, F.HB, (unsigned char*)F.XN, F.SS, D, 1.0f};
        pg8::gemm_phase<pg8::EpiRes2<true, true, true>, pg8::StaticOrder, PG8_ALIGN, PG8_SP2>(F.lds + RING_OFF, g, S, E); SEAM(7); }
    if (IN(9)) { pg8::Gemm g{F.XN, F.Wgu2, M, FF2, D / 2}; pg8::StaticOrder S; S.init(M, FF2, F.G, (int)blockIdx.x);
        pg8::rstd_table((LAS float*)(F.lds + RTAB_OFF), S, F.SS, 1.0f / D, EPS);
        pg8::EpiSwiglu<true> E{F.ACT, FF, (const LAS float*)(F.lds + RTAB_OFF), 1.0f / WSC_GU};
        pg8::gemm_phase<pg8::EpiSwiglu<true>, pg8::StaticOrder, PG8_ALIGN, PG8_SP2, true>(F.lds + RING_OFF, g, S, E); SEAM(9); }
    if (IN(10)) { pg8::Gemm g{F.ACT, F.Wd2, M, D, FF / 2}; pg8::StaticOrder S; S.init(M, D, F.G, (int)blockIdx.x);
        pg8::EpiRes2<true, false, false> E{F.HB, F.HB, nullptr, nullptr, D, 0.5f / WSC_DN};
        pg8::gemm_phase<pg8::EpiRes2<true, false, false>, pg8::StaticOrder, PG8_ALIGN, PG8_SP2, true>(F.lds + RING_OFF, g, S, E); SEAM(10); }
    if (IN(11)) { const bool poison = __hip_atomic_load((gu32*)(F.ctl + CW_BAR + XB_TMO), RLX_AGENT) != 0u;
        const int gw = F.vcu * NWAVES + F.wave, NGW = F.G * NWAVES;
        for (int m = gw; m < M; m += 4 * NGW) { const int rows[4] = {m, min(m + NGW, M - 1), min(m + 2 * NGW, M - 1), min(m + 3 * NGW, M - 1)}; rows4_bf16_to_f32(F.lane, F.HB, F.in[I_NF], F.out, rows, poison); } }
#undef IN
#undef SEAM
}

extern "C" void kernel_launch(void* const* d_in, const int* in_sizes, int n_in, void* d_out, int out_size, void* d_ws, size_t ws_size, hipStream_t stream) {
    static int grid = 0;
    if (grid == 0) {
        if (n_in != 20 || in_sizes[0] != M * D || out_size != M * D || ws_size < WS_END) { fprintf(stderr, "kernel_launch: shape mismatch (n_in %d, in0 %d, out %d, ws %zu); nothing launched\n", n_in, n_in > 0 ? in_sizes[0] : -1, out_size, ws_size); grid = -1; return; }
        int dev = 0, cus = 0, per_cu = 0;
        if (hipGetDevice(&dev) != hipSuccess || hipDeviceGetAttribute(&cus, hipDeviceAttributeMultiprocessorCount, dev) != hipSuccess) { fprintf(stderr, "kernel_launch: hipGetDevice / hipDeviceGetAttribute failed\n"); grid = -1; return; }
        if (hipFuncSetAttribute((const void*)mk_fwd, hipFuncAttributeMaxDynamicSharedMemorySize, LDS_BYTES) != hipSuccess) { fprintf(stderr, "kernel_launch: hipFuncSetAttribute failed\n"); grid = -1; return; }
        if (hipOccupancyMaxActiveBlocksPerMultiprocessor(&per_cu, (const void*)mk_fwd, NWAVES * 64, LDS_BYTES) != hipSuccess || per_cu < 1)
            fprintf(stderr, "kernel_launch: note: occupancy query reports %d workgroups per CU\n", per_cu);
        (void)hipGetLastError();
        grid = cus;
    }
    if (grid < 0) return;
    if (hipMemsetAsync((char*)d_ws + WS_CTL, 0, CTL_ZERO_BYTES, stream) != hipSuccess) { fprintf(stderr, "kernel_launch: hipMemsetAsync failed\n"); return; }
    Args a{};
    for (int i = 0; i < 20; ++i) a.in[i] = (const float*)d_in[i];
    a.out = (float*)d_out; a.ws = (unsigned char*)d_ws;
    for (int li = 0; li < N_LAUNCHES; ++li) {
        a.ph_lo = (N_LAUNCHES == PER_PHASE) ? li : 0; a.ph_hi = (N_LAUNCHES == PER_PHASE) ? li + 1 : PER_PHASE; a.li = li;
        hipLaunchKernelGGL(mk_fwd, dim3(grid), dim3(NWAVES * 64), LDS_BYTES, stream, a);
        const hipError_t le = hipPeekAtLastError();
        if (le != hipSuccess) { fprintf(stderr, "kernel_launch: launch %d failed: %s\n", li, hipGetErrorName(le)); break; }
    }
}
```

```cpp
#include <hip/hip_runtime.h>
#include <cstdio>
#include <cstdint>

__device__ __forceinline__ int lane_now() { int l = (int)__builtin_amdgcn_mbcnt_hi(~0u, __builtin_amdgcn_mbcnt_lo(~0u, 0u)); asm volatile("" : "+v"(l)); return l; }
namespace pg8 {
#define PG8_LAS __attribute__((address_space(3)))
typedef unsigned short bf16_t;
typedef short bf16x8 __attribute__((ext_vector_type(8)));
typedef float f32x4 __attribute__((ext_vector_type(4)));
typedef unsigned u32x4 __attribute__((ext_vector_type(4)));
constexpr int BM = 256, BK = 64, HALF = 128, HTB = HALF * BK * 2  , STAGE_BYTES = 8 * HTB, NXCD = 8, WGM = 8;

__host__ __device__ __forceinline__ int lds_byte(int r, int c) { const int st = (r >> 4) * 2 + (c >> 5), rr = r & 15, cc = c & 31, ob = rr * 64 + cc * 2; return st * 1024 + (ob ^ (((ob >> 9) & 1) << 5)); }
__host__ __device__ __forceinline__ void stage_rc(int b, int& R, int& C) { const int st = b / 1024, sb = b % 1024, swz = sb ^ (((sb >> 9) & 1) << 5); R = (st >> 1) * 16 + swz / 64; C = (st & 1) * 32 + (swz % 64) / 2; }
__host__ __device__ __forceinline__ int perm32(int rho) { const int n = rho >> 4, i = rho & 15; return 8 * (i >> 2) + 4 * n + (i & 3); }

struct Unit { int pm, pn; };
struct Gemm { const bf16_t* A; const bf16_t* Bt; int M, N, K; };

struct StaticOrder {
    int nM, nN, nwg, G, c, rep;
    __host__ __device__ void init(int M, int N, int G_, int c_, int rep_ = 1) { nM = M / BM; nN = N / BM; nwg = nM * nN; G = G_; c = c_; rep = rep_; }
    __host__ __device__ bool next(int i, Unit& u) const {
        const long L = (long)i * G + c; if (L >= (long)nwg * rep) return false;
        int wgid = (int)(L % nwg); { const int q = nwg / NXCD, r = nwg % NXCD, xcd = wgid % NXCD, off = wgid / NXCD; wgid = (xcd < r ? xcd * (q + 1) : r * (q + 1) + (xcd - r) * q) + off; }
        const int nig = WGM * nN, gid = wgid / nig, fm = gid * WGM, gsz = (nM - fm) < WGM ? (nM - fm) : WGM;
        u.pm = fm + ((wgid % nig) % gsz); u.pn = (wgid % nig) / gsz; return true;
    }
    __device__ __forceinline__ void a_ready(const Unit&) const {}
    __device__ __forceinline__ void done(const Unit&) const {}
};

__device__ __forceinline__ unsigned cvt_pk_bf16(float lo, float hi) { unsigned r; asm volatile("v_cvt_pk_bf16_f32 %0, %1, %2" : "=v"(r) : "v"(lo), "v"(hi)); return r; }
typedef float f32x2 __attribute__((ext_vector_type(2)));
__device__ __forceinline__ f32x2 gelu_pk(f32x2 v) {
    const f32x2 av = __builtin_elementwise_abs(v), d = av * 0.2316418882f + 1.0f;
    f32x2 t; t.x = __builtin_amdgcn_rcpf(d.x); t.y = __builtin_amdgcn_rcpf(d.y);
    f32x2 q = t * 0.5307027145f + (-0.7265760135f); q = q * t + 0.7107068705f; q = q * t + (-0.142248368f); q = q * t + 0.127414796f; q = q * t;
    const f32x2 s = (v * v) * (-0.72134752044f);
    f32x2 e; e.x = __builtin_amdgcn_exp2f(s.x); e.y = __builtin_amdgcn_exp2f(s.y);
    const f32x2 m = v * (q * e), r = v - m;
    f32x2 o; o.x = v.x < 0.f ? m.x : r.x; o.y = v.y < 0.f ? m.y : r.y; return o;
}

template <int ACT  > struct EpiBf16 {
    static constexpr bool PERM = true, AFTER_DRAIN = false, UI = false; static_assert(ACT == 0 || ACT == 1, "EpiBf16: ACT is 0 (none) or 1 (gelu_pk)");
    bf16_t* O; int ldc; const float* bias; int split_cols; size_t split_stride; float scale0;
    __device__ __forceinline__ void operator()(const f32x4 (&acc)[2][2][4][2], const Unit& u, int wr, int wc, int fr, int fq) const {
        const int row0 = u.pm * BM + wr * 64 + fr; int colt = u.pn * BM; bf16_t* base = O;
        float sc = 1.f; if (split_cols) { const int t = colt / split_cols; base += (size_t)t * split_stride; colt -= t * split_cols; if (t == 0) sc = scale0; }
        const int col0 = colt + wc * 32 + 8 * fq, bcol0 = u.pn * BM + wc * 32 + 8 * fq;
        f32x4 bv[2][2];
#pragma unroll
        for (int bj = 0; bj < 2; ++bj)
#pragma unroll
            for (int n = 0; n < 2; ++n) bv[bj][n] = bias ? *(const f32x4*)(bias + bcol0 + bj * HALF + 4 * n) : (f32x4){0.f, 0.f, 0.f, 0.f};
#pragma unroll
        for (int ai = 0; ai < 2; ++ai)
#pragma unroll
            for (int m = 0; m < 4; ++m) { bf16_t* rowp = base + (size_t)(row0 + ai * HALF + m * 16) * ldc + col0;
#pragma unroll
                for (int bj = 0; bj < 2; ++bj) { f32x4 v0 = acc[ai][bj][m][0] + bv[bj][0], v1 = acc[ai][bj][m][1] + bv[bj][1];
                    if (ACT == 1) { f32x2 a = gelu_pk((f32x2){v0[0], v0[1]}), b = gelu_pk((f32x2){v0[2], v0[3]}), c = gelu_pk((f32x2){v1[0], v1[1]}), d = gelu_pk((f32x2){v1[2], v1[3]});
                        v0 = (f32x4){a.x, a.y, b.x, b.y}; v1 = (f32x4){c.x, c.y, d.x, d.y}; }
                    v0 = v0 * sc; v1 = v1 * sc; u32x4 w; w.x = cvt_pk_bf16(v0[0], v0[1]); w.y = cvt_pk_bf16(v0[2], v0[3]); w.z = cvt_pk_bf16(v1[0], v1[1]); w.w = cvt_pk_bf16(v1[2], v1[3]);
                    *(u32x4*)(rowp + bj * HALF) = w; } }
    }
};


__device__ __forceinline__ unsigned cvt4_fp8(float a, float b, float c, float d) { int w = 0; w = __builtin_amdgcn_cvt_pk_fp8_f32(a, b, w, false); w = __builtin_amdgcn_cvt_pk_fp8_f32(c, d, w, true); return (unsigned)w; }
constexpr int RT_MAX = 12;
template <class Sched> __device__ __forceinline__ void rstd_table(PG8_LAS float* tab, const Sched& S, const float* ss, float inv_n, float eps, int wave) {
    const int t = wave * 64 + lane_now(); Unit u;
    for (int i = t >> 8; i < RT_MAX && S.next(i, u); i += 2) { const f32x4* p = (const f32x4*)(ss + (size_t)(u.pm * BM + (t & 255)) * 16);
        const f32x4 a = p[0], b = p[1], c = p[2], d = p[3]; const float q = ((a[0] + a[1]) + (a[2] + a[3])) + ((b[0] + b[1]) + (b[2] + b[3])) + ((c[0] + c[1]) + (c[2] + c[3])) + ((d[0] + d[1]) + (d[2] + d[3]));
        tab[i * BM + (t & 255)] = 1.0f / sqrtf(q * inv_n + eps); }
    __syncthreads();
}
__device__ __forceinline__ void row_rstd8(const float* ss, int row0, int fq, float inv_n, float eps, float (&rs)[2][4]) {
#pragma unroll
    for (int ai = 0; ai < 2; ++ai)
#pragma unroll
        for (int m = 0; m < 4; ++m) { const f32x4 v = *(const f32x4*)(ss + (size_t)(row0 + ai * HALF + m * 16) * 16 + 4 * fq); float t = (v[0] + v[1]) + (v[2] + v[3]);
            t += __shfl_xor(t, 16); t += __shfl_xor(t, 32); rs[ai][m] = 1.0f / sqrtf(t * inv_n + eps); }
}
__device__ __forceinline__ float silu_mul(float g, float u) { const float e = __builtin_amdgcn_exp2f(g * -1.4426950408889634f); return g * __builtin_amdgcn_rcpf(1.0f + e) * u; }
template <bool OUT8> struct EpiSwiglu {
    static constexpr bool PERM = true, AFTER_DRAIN = false, UI = true;
    bf16_t* O; int ldc; const PG8_LAS float* rtab; float ascale;
    __device__ __forceinline__ void operator()(const f32x4 (&acc)[2][2][4][2], const Unit& u, int wr, int wc, int fr, int fq, int ui) const {
        const int row0 = u.pm * BM + wr * 64 + fr, col0 = u.pn * HALF + wc * 32 + 8 * fq;
        float rs[2][4];
#pragma unroll
        for (int ai = 0; ai < 2; ++ai)
#pragma unroll
            for (int m = 0; m < 4; ++m) rs[ai][m] = rtab[ui * BM + ai * HALF + wr * 64 + m * 16 + fr];
#pragma unroll
        for (int ai = 0; ai < 2; ++ai)
#pragma unroll
            for (int m = 0; m < 4; ++m) { const float r = rs[ai][m] * ascale;
                const f32x4 g0 = acc[ai][0][m][0] * r, g1 = acc[ai][0][m][1] * r, u0 = acc[ai][1][m][0] * r, u1 = acc[ai][1][m][1] * r;
                if constexpr (OUT8) { typedef unsigned u32x2v __attribute__((ext_vector_type(2))); u32x2v w;
                    w.x = cvt4_fp8(silu_mul(g0[0], u0[0]), silu_mul(g0[1], u0[1]), silu_mul(g0[2], u0[2]), silu_mul(g0[3], u0[3]));
                    w.y = cvt4_fp8(silu_mul(g1[0], u1[0]), silu_mul(g1[1], u1[1]), silu_mul(g1[2], u1[2]), silu_mul(g1[3], u1[3]));
                    *(u32x2v*)((unsigned char*)O + (size_t)(row0 + ai * HALF + m * 16) * ldc + col0) = w; }
                else { bf16_t* rowp = O + (size_t)(row0 + ai * HALF + m * 16) * ldc + col0;
                u32x4 w; w.x = cvt_pk_bf16(silu_mul(g0[0], u0[0]), silu_mul(g0[1], u0[1])); w.y = cvt_pk_bf16(silu_mul(g0[2], u0[2]), silu_mul(g0[3], u0[3]));
                w.z = cvt_pk_bf16(silu_mul(g1[0], u1[0]), silu_mul(g1[1], u1[1])); w.w = cvt_pk_bf16(silu_mul(g1[2], u1[2]), silu_mul(g1[3], u1[3]));
                *(u32x4*)rowp = w; } }
    }
};
struct EpiBf16Rs {
    static constexpr bool PERM = true, AFTER_DRAIN = false, UI = true;
    bf16_t* O; int ldc; const PG8_LAS float* rtab;
    __device__ __forceinline__ void operator()(const f32x4 (&acc)[2][2][4][2], const Unit& u, int wr, int wc, int fr, int fq, int ui) const {
        const int row0 = u.pm * BM + wr * 64 + fr, col0 = u.pn * BM + wc * 32 + 8 * fq;
        float rs[2][4];
#pragma unroll
        for (int ai = 0; ai < 2; ++ai)
#pragma unroll
            for (int m = 0; m < 4; ++m) rs[ai][m] = rtab[ui * BM + ai * HALF + wr * 64 + m * 16 + fr];
#pragma unroll
        for (int ai = 0; ai < 2; ++ai)
#pragma unroll
            for (int m = 0; m < 4; ++m) { bf16_t* rowp = O + (size_t)(row0 + ai * HALF + m * 16) * ldc + col0; const float r = rs[ai][m];
#pragma unroll
                for (int bj = 0; bj < 2; ++bj) { const f32x4 v0 = acc[ai][bj][m][0] * r, v1 = acc[ai][bj][m][1] * r;
                    u32x4 w; w.x = cvt_pk_bf16(v0[0], v0[1]); w.y = cvt_pk_bf16(v0[2], v0[3]); w.z = cvt_pk_bf16(v1[0], v1[1]); w.w = cvt_pk_bf16(v1[2], v1[3]);
                    *(u32x4*)(rowp + bj * HALF) = w; } }
    }
};
template <bool BASE_BF16, bool OUT8, bool SS> struct EpiRes2 {
    static constexpr bool PERM = false, AFTER_DRAIN = false, UI = false;
    const void* base; bf16_t* hb; unsigned char* x8; float* ss; int ldc; float scale;
    __device__ __forceinline__ void operator()(const f32x4 (&acc)[2][2][4][2], const Unit& u, int wr, int wc, int fr, int fq) const {
        typedef unsigned u32x2v __attribute__((ext_vector_type(2)));
        const int row0 = u.pm * BM + wr * 64 + fr, col0 = u.pn * BM + wc * 32 + 4 * fq;
#pragma unroll
        for (int ai = 0; ai < 2; ++ai) {
            f32x4 pre[4][2][2];
#pragma unroll
            for (int m = 0; m < 4; ++m) { const size_t off = (size_t)(row0 + ai * HALF + m * 16) * ldc + col0;
#pragma unroll
                for (int bj = 0; bj < 2; ++bj)
#pragma unroll
                    for (int n = 0; n < 2; ++n) {
                        if constexpr (BASE_BF16) { const u32x2v w = *(const u32x2v*)((const bf16_t*)base + off + bj * HALF + n * 16);
                            pre[m][bj][n] = (f32x4){__uint_as_float(w.x << 16), __uint_as_float(w.x & 0xffff0000u), __uint_as_float(w.y << 16), __uint_as_float(w.y & 0xffff0000u)}; }
                        else pre[m][bj][n] = *(const f32x4*)((const float*)base + off + bj * HALF + n * 16); } }
#pragma unroll
            for (int m = 0; m < 4; ++m) { const int row = row0 + ai * HALF + m * 16; const size_t off = (size_t)row * ldc + col0; float q = 0.f;
#pragma unroll
                for (int bj = 0; bj < 2; ++bj)
#pragma unroll
                    for (int n = 0; n < 2; ++n) { const f32x4 o = pre[m][bj][n] + acc[ai][bj][m][n] * scale;
                        u32x2v w; w.x = cvt_pk_bf16(o[0], o[1]); w.y = cvt_pk_bf16(o[2], o[3]); *(u32x2v*)(hb + off + bj * HALF + n * 16) = w;
                        if constexpr (SS) q += (o[0] * o[0] + o[1] * o[1]) + (o[2] * o[2] + o[3] * o[3]);
                        if constexpr (OUT8) *(unsigned*)(x8 + off + bj * HALF + n * 16) = cvt4_fp8(o[0], o[1], o[2], o[3]); }
                if constexpr (SS) { q += __shfl_xor(q, 16); q += __shfl_xor(q, 32); if (fq == 0) ss[(size_t)row * 16 + u.pn * 4 + wc] = q; } }
        }
    }
};
template <bool XN8> struct EpiResNorm {
    static constexpr bool PERM = false, AFTER_DRAIN = false, UI = false;
    const float* base; float* out; int ldc; float scale; const float* gain; bf16_t* xn; float* ss;
    __device__ __forceinline__ void operator()(const f32x4 (&acc)[2][2][4][2], const Unit& u, int wr, int wc, int fr, int fq) const {
        const int row0 = u.pm * BM + wr * 64 + fr, col0 = u.pn * BM + wc * 32 + 4 * fq;
        f32x4 gv[2][2];
#pragma unroll
        for (int bj = 0; bj < 2; ++bj)
#pragma unroll
            for (int n = 0; n < 2; ++n) gv[bj][n] = *(const f32x4*)(gain + col0 + bj * HALF + n * 16);
#pragma unroll
        for (int ai = 0; ai < 2; ++ai) {
            f32x4 pre[4][2][2];
#pragma unroll
            for (int m = 0; m < 4; ++m) { const size_t off = (size_t)(row0 + ai * HALF + m * 16) * ldc + col0;
#pragma unroll
                for (int bj = 0; bj < 2; ++bj)
#pragma unroll
                    for (int n = 0; n < 2; ++n) pre[m][bj][n] = *(const f32x4*)(base + off + bj * HALF + n * 16); }
#pragma unroll
            for (int m = 0; m < 4; ++m) { const int row = row0 + ai * HALF + m * 16; const size_t off = (size_t)row * ldc + col0; float q = 0.f;
#pragma unroll
                for (int bj = 0; bj < 2; ++bj)
#pragma unroll
                    for (int n = 0; n < 2; ++n) { const f32x4 o = pre[m][bj][n] + acc[ai][bj][m][n] * scale; *(f32x4*)(out + off + bj * HALF + n * 16) = o;
                        q += (o[0] * o[0] + o[1] * o[1]) + (o[2] * o[2] + o[3] * o[3]); const f32x4 x = o * gv[bj][n];
                        if constexpr (XN8) *(unsigned*)((unsigned char*)xn + off + bj * HALF + n * 16) = cvt4_fp8(x[0], x[1], x[2], x[3]);
                        else { typedef unsigned u32x2v __attribute__((ext_vector_type(2))); u32x2v w; w.x = cvt_pk_bf16(x[0], x[1]); w.y = cvt_pk_bf16(x[2], x[3]); *(u32x2v*)(xn + off + bj * HALF + n * 16) = w; } }
                q += __shfl_xor(q, 16); q += __shfl_xor(q, 32);
                if (fq == 0) ss[(size_t)row * 16 + u.pn * 4 + wc] = q; }
        }
    }
};
struct EpiRes {
    static constexpr bool PERM = false, AFTER_DRAIN = false, UI = false;
    const float* base; float* out; int ldc; float scale;
    __device__ __forceinline__ void operator()(const f32x4 (&acc)[2][2][4][2], const Unit& u, int wr, int wc, int fr, int fq) const {
        const int row0 = u.pm * BM + wr * 64 + fr, col0 = u.pn * BM + wc * 32 + 4 * fq;
#pragma unroll
        for (int ai = 0; ai < 2; ++ai)
#pragma unroll
            for (int mp = 0; mp < 4; mp += 2) {
                f32x4 pre[2][2][2];
#pragma unroll
                for (int m = 0; m < 2; ++m) { const size_t off = (size_t)(row0 + ai * HALF + (mp + m) * 16) * ldc + col0;
#pragma unroll
                    for (int bj = 0; bj < 2; ++bj)
#pragma unroll
                        for (int n = 0; n < 2; ++n) pre[m][bj][n] = *(const f32x4*)(base + off + bj * HALF + n * 16); }
#pragma unroll
                for (int m = 0; m < 2; ++m) { const size_t off = (size_t)(row0 + ai * HALF + (mp + m) * 16) * ldc + col0;
#pragma unroll
                    for (int bj = 0; bj < 2; ++bj)
#pragma unroll
                        for (int n = 0; n < 2; ++n) *(f32x4*)(out + off + bj * HALF + n * 16) = pre[m][bj][n] + acc[ai][bj][mp + m][n] * scale; }
            }
    }
};

typedef int i32x4 __attribute__((ext_vector_type(4))); typedef int i32x8 __attribute__((ext_vector_type(8)));
template <class Epi, class Sched, bool ALIGN_EPI = false, bool SP2 = false, bool FP8 = false>
__device__ __forceinline__ void gemm_phase(PG8_LAS unsigned char* lds, const Gemm g, const Sched& S, const Epi& E, int wave) {
    const int wid = wave, lane = lane_now(), tid = wid * 64 + lane, wr = wid >> 2, wc = wid & 3, fr = lane & 15, fq = lane >> 4;
    const int K = g.K, nt = K / BK;
    unsigned voffA[2], voffB[2];
#pragma unroll
    for (int i = 0; i < 2; ++i) { int R, C; stage_rc(tid * 16 + i * 8192, R, C); const int Rb = Epi::PERM ? ((R & ~31) + perm32(R & 31)) : R;
        voffA[i] = (unsigned)(R * K + C) * 2u; voffB[i] = (unsigned)(Rb * K + C) * 2u; }
    const size_t kstep = (size_t)(BK * 2);
    const size_t hstep = (size_t)HALF * K * 2;
    const size_t tstep = 2 * hstep;
    const unsigned ldsw = (unsigned)wid * 1024u;
    const int aoff = lds_byte(wr * 64 + fr, fq * 8), boff = lds_byte(wc * 32 + fr, fq * 8);
#define PG8_SA(b, h) (((b) * 2 + (h)) * HTB)
#define PG8_SB(b, h) ((4 + (b) * 2 + (h)) * HTB)
#define PG8_STAGE(bufoff, gbase, voff) do { _Pragma("unroll") for (int _i = 0; _i < 2; ++_i) \
        __builtin_amdgcn_global_load_lds((const unsigned*)((const char*)(gbase) + (voff)[_i]), (PG8_LAS unsigned*)(lds + (bufoff) + ldsw + _i * 8192), 16, 0, 0); } while (0)
#define PG8_LDA(dst, b, h) do { _Pragma("unroll") for (int m = 0; m < 4; ++m) { dst[m].lo = *(const PG8_LAS i32x4*)(lds + PG8_SA(b, h) + aoff + m * 2048); dst[m].hi = *(const PG8_LAS i32x4*)(lds + PG8_SA(b, h) + aoff + m * 2048 + 1024); } } while (0)
#define PG8_LDB(dst, b, h) do { _Pragma("unroll") for (int n = 0; n < 2; ++n) { dst[n].lo = *(const PG8_LAS i32x4*)(lds + PG8_SB(b, h) + boff + n * 2048); dst[n].hi = *(const PG8_LAS i32x4*)(lds + PG8_SB(b, h) + boff + n * 2048 + 1024); } } while (0)
#define PG8_H(x, k) __builtin_bit_cast(bf16x8, (k) == 0 ? (x).lo : (x).hi)
#define PG8_MMA(ai, bj, At, Bt) do { __builtin_amdgcn_s_setprio(1); \
        if constexpr (FP8) { _Pragma("unroll") for (int m = 0; m < 4; ++m) _Pragma("unroll") for (int n = 0; n < 2; ++n) \
            asm volatile("v_mfma_scale_f32_16x16x128_f8f6f4 %0, %1, %2, %0, %3, %3 op_sel_hi:[0,0,0]" : "+v"(acc[ai][bj][m][n]) : "v"(Bt[n]), "v"(At[m]), "v"(sc8)); } \
        else { _Pragma("unroll") for (int m = 0; m < 4; ++m) _Pragma("unroll") for (int n = 0; n < 2; ++n) _Pragma("unroll") for (int k = 0; k < 2; ++k) \
            acc[ai][bj][m][n] = __builtin_amdgcn_mfma_f32_16x16x32_bf16(PG8_H(Bt[n], k), PG8_H(At[m], k), acc[ai][bj][m][n], 0, 0, 0); } \
        __builtin_amdgcn_s_setprio(0); } while (0)
#define PG8_WAIT_V(n) asm volatile("s_waitcnt vmcnt(" #n ")" ::: "memory")
#define PG8_WAIT_L(n) asm volatile("s_waitcnt lgkmcnt(" #n ")" ::: "memory")
#define PG8_BAR __builtin_amdgcn_s_barrier()
#define PG8_SCHED __builtin_amdgcn_sched_barrier(0)
    Unit cur, nxt; int ui = 0;
    if (!S.next(0, cur)) return;
    f32x4 acc[2][2][4][2];
#pragma unroll
    for (int a = 0; a < 2; ++a)
#pragma unroll
        for (int b = 0; b < 2; ++b)
#pragma unroll
            for (int m = 0; m < 4; ++m)
#pragma unroll
                for (int n = 0; n < 2; ++n) acc[a][b][m][n] = (f32x4){0.f, 0.f, 0.f, 0.f};
    i32x8 At[4], B0[2], B1[2]; int sc8 = 0x7f7f7f7f; asm volatile("" : "+v"(sc8));
    const char* cA = (const char*)g.A + (size_t)cur.pm * tstep; const char* cB = (const char*)g.Bt + (size_t)cur.pn * tstep;
    S.a_ready(cur);
    if constexpr (SP2) {
        PG8_STAGE(PG8_SB(0, 0), cB, voffB); PG8_STAGE(PG8_SB(0, 1), cB + hstep, voffB); PG8_STAGE(PG8_SA(0, 0), cA, voffA); PG8_STAGE(PG8_SA(0, 1), cA + hstep, voffA);
        if (wr == 1) PG8_BAR;
        PG8_WAIT_V(2); PG8_BAR;
        PG8_STAGE(PG8_SB(1, 0), cB + kstep, voffB); PG8_STAGE(PG8_SA(1, 0), cA + kstep, voffA); PG8_STAGE(PG8_SB(1, 1), cB + hstep + kstep, voffB);
        PG8_WAIT_V(6); PG8_BAR;
    } else {
        PG8_STAGE(PG8_SB(0, 0), cB, voffB); PG8_STAGE(PG8_SA(0, 0), cA, voffA); PG8_STAGE(PG8_SB(0, 1), cB + hstep, voffB); PG8_STAGE(PG8_SA(0, 1), cA + hstep, voffA);
        if (wr == 1) PG8_BAR;
        PG8_WAIT_V(4); PG8_BAR;
        PG8_STAGE(PG8_SB(1, 0), cB + kstep, voffB); PG8_STAGE(PG8_SA(1, 0), cA + kstep, voffA); PG8_STAGE(PG8_SB(1, 1), cB + hstep + kstep, voffB);
        PG8_WAIT_V(6); PG8_BAR;
    }
    for (;;) {
        const bool has_next = S.next(ui + 1, nxt);
        const char* nA = has_next ? (const char*)g.A + (size_t)nxt.pm * tstep : cA; const char* nB = has_next ? (const char*)g.Bt + (size_t)nxt.pn * tstep : cB;
#pragma unroll 1
        for (int t = 0; t < nt; t += 2) {
            const bool last = (t == nt - 2);
            const char* a1 = cA + (size_t)(t + 1) * kstep;
            const char* a2 = last ? nA : cA + (size_t)(t + 2) * kstep; const char* b2 = last ? nB : cB + (size_t)(t + 2) * kstep;
            const char* a3 = a2 + kstep; const char* b3 = b2 + kstep;
            if (last && has_next) S.a_ready(nxt);
            if constexpr (SP2) {
            PG8_LDB(B0, 0, 0); PG8_LDB(B1, 0, 1); PG8_SCHED; PG8_LDA(At, 0, 0); PG8_STAGE(PG8_SA(1, 1), a1 + hstep, voffA);
            PG8_WAIT_V(8); PG8_WAIT_L(0); PG8_BAR; PG8_MMA(0, 0, At, B0); PG8_MMA(0, 1, At, B1); PG8_BAR; PG8_SCHED;
            PG8_LDA(At, 0, 1); PG8_STAGE(PG8_SB(0, 0), b2, voffB); PG8_STAGE(PG8_SB(0, 1), b2 + hstep, voffB); PG8_STAGE(PG8_SA(0, 0), a2, voffA);
            PG8_WAIT_V(8); PG8_WAIT_L(0); PG8_BAR; PG8_MMA(1, 0, At, B0); PG8_MMA(1, 1, At, B1); PG8_BAR; PG8_SCHED;
            PG8_LDB(B0, 1, 0); PG8_LDB(B1, 1, 1); PG8_SCHED; PG8_LDA(At, 1, 0); PG8_STAGE(PG8_SA(0, 1), a2 + hstep, voffA);
            PG8_WAIT_V(8); PG8_WAIT_L(0); PG8_BAR; PG8_MMA(0, 0, At, B0); PG8_MMA(0, 1, At, B1); PG8_BAR; PG8_SCHED;
            PG8_LDA(At, 1, 1); PG8_STAGE(PG8_SB(1, 0), b3, voffB); PG8_STAGE(PG8_SB(1, 1), b3 + hstep, voffB); PG8_STAGE(PG8_SA(1, 0), a3, voffA);
            PG8_WAIT_V(8); PG8_WAIT_L(0); PG8_BAR; PG8_MMA(1, 0, At, B0); PG8_MMA(1, 1, At, B1); PG8_BAR; PG8_SCHED;
            } else {
            PG8_LDB(B0, 0, 0); PG8_SCHED; PG8_LDA(At, 0, 0); PG8_STAGE(PG8_SA(1, 1), a1 + hstep, voffA);
            PG8_WAIT_L(8); PG8_BAR; PG8_WAIT_L(0); PG8_MMA(0, 0, At, B0); PG8_BAR; PG8_SCHED;
            PG8_LDB(B1, 0, 1); PG8_STAGE(PG8_SB(0, 0), b2, voffB);
            PG8_BAR; PG8_WAIT_L(0); PG8_MMA(0, 1, At, B1); PG8_BAR;
            PG8_LDA(At, 0, 1); PG8_STAGE(PG8_SA(0, 0), a2, voffA);
            PG8_BAR; PG8_WAIT_L(0); PG8_MMA(1, 0, At, B0); PG8_BAR; PG8_SCHED;
            PG8_STAGE(PG8_SB(0, 1), b2 + hstep, voffB);
            PG8_WAIT_V(6); PG8_BAR; PG8_MMA(1, 1, At, B1); PG8_BAR;
            PG8_LDB(B0, 1, 0); PG8_SCHED; PG8_LDA(At, 1, 0); PG8_STAGE(PG8_SA(0, 1), a2 + hstep, voffA);
            PG8_WAIT_L(8); PG8_BAR; PG8_WAIT_L(0); PG8_MMA(0, 0, At, B0); PG8_BAR; PG8_SCHED;
            PG8_LDB(B1, 1, 1); PG8_STAGE(PG8_SB(1, 0), b3, voffB);
            PG8_BAR; PG8_WAIT_L(0); PG8_MMA(0, 1, At, B1); PG8_BAR;
            PG8_LDA(At, 1, 1); PG8_STAGE(PG8_SA(1, 0), a3, voffA);
            PG8_BAR; PG8_WAIT_L(0); PG8_MMA(1, 0, At, B0); PG8_BAR; PG8_SCHED;
            PG8_STAGE(PG8_SB(1, 1), b3 + hstep, voffB);
            PG8_WAIT_V(6); PG8_BAR; PG8_MMA(1, 1, At, B1); PG8_BAR;
            }
        }
        if constexpr (FP8) asm volatile("s_nop 15\n\ts_nop 15" ::: "memory");
        if constexpr (ALIGN_EPI) { if (wr == 0) PG8_BAR; }
        if constexpr (!Epi::AFTER_DRAIN) { if constexpr (Epi::UI) E(acc, cur, wr, wc, fr, fq, ui); else E(acc, cur, wr, wc, fr, fq); S.done(cur); }
        if (!has_next) break;
#pragma unroll
        for (int a = 0; a < 2; ++a)
#pragma unroll
            for (int b = 0; b < 2; ++b)
#pragma unroll
                for (int m = 0; m < 4; ++m)
#pragma unroll
                    for (int n = 0; n < 2; ++n) acc[a][b][m][n] = (f32x4){0.f, 0.f, 0.f, 0.f};
        cur = nxt; cA = nA; cB = nB; ++ui;
        if constexpr (ALIGN_EPI) { if (wr == 1) PG8_BAR; }
    }
    PG8_WAIT_V(0);
    if constexpr (!ALIGN_EPI) { if (wr == 0) PG8_BAR; }
    PG8_BAR;
    if constexpr (Epi::AFTER_DRAIN) { E.fused(acc, cur, wr, wc, fr, fq, lds, wid, lane); S.done(cur); }
#undef PG8_SA
#undef PG8_SB
#undef PG8_STAGE
#undef PG8_LDA
#undef PG8_LDB
#undef PG8_MMA
#undef PG8_H
#undef PG8_WAIT_V
#undef PG8_WAIT_L
#undef PG8_BAR
#undef PG8_SCHED
}
}

#ifndef PG8_SP2
#define PG8_SP2 true
#endif
#ifndef PG8_ALIGN
#define PG8_ALIGN true
#endif

constexpr int NWAVES = 8;
#ifndef MK_N_LAUNCHES
#define MK_N_LAUNCHES 1
#endif
#ifndef REP_MASK
#define REP_MASK 0
#endif
#ifndef FFN1_FP8
#define FFN1_FP8 1
#endif
constexpr int PER_PHASE = 12;
constexpr int N_LAUNCHES = MK_N_LAUNCHES;
static_assert(N_LAUNCHES == 1 || N_LAUNCHES == PER_PHASE, "MK_N_LAUNCHES is 1 or 12");

constexpr int BATCH = 8, SEQ = 2048, D = 1024, M = BATCH * SEQ;
constexpr int FF = 2816, FF2 = 2 * FF;
constexpr int NH = 8, HD = 64, CL = 128, TOPK = 256;
constexpr int NPROJ = 2816;
constexpr int PQ = 0, PQI = 512, PCKV = 1024, PKI = 1152, PWI = 1216, PGB = 1280, PGC = 1792, PXIN = 2304;
constexpr int WIN_N = 2760;
constexpr float EPS = 1e-6f;
constexpr float WSC_GU = 32.f, WSC_DN = 64.f;
constexpr float IDX_SCALE = 0.044194173824159216f;

constexpr size_t MiB = 1u << 20;
constexpr size_t WS_CTL = 0, CTL_ZERO_BYTES = 1 * MiB;
constexpr size_t WS_WUK = 1 * MiB, WS_WUV = 1 * MiB + 256 * 1024;
constexpr size_t WS_WGU1 = 2 * MiB, WS_WD1 = 14 * MiB, WS_WIN = 20 * MiB, WS_WOUT = 26 * MiB, WS_WGU2 = 28 * MiB, WS_WD2 = 40 * MiB;
constexpr size_t WS_XN = 48 * MiB;
constexpr size_t WS_MIX = 80 * MiB;
constexpr size_t WS_KV = 112 * MiB;
constexpr size_t WS_MASK = 116 * MiB;
constexpr size_t WS_SS = 120 * MiB;
constexpr size_t WS_ACT = 128 * MiB;
constexpr size_t WS_HB = 216 * MiB;
constexpr size_t WS_END = 248 * MiB;
static_assert(WS_WGU1 + (size_t)FF2 * D * 2 <= WS_WD1 && WS_WD1 + (size_t)D * FF * 2 <= WS_WIN && WS_WIN + (size_t)NPROJ * D * 2 <= WS_WOUT && WS_WOUT + (size_t)D * D * 2 <= WS_WGU2 &&
              WS_WGU2 + (size_t)FF2 * D * 2 <= WS_WD2 && WS_WD2 + (size_t)D * FF * 2 <= WS_XN && WS_ACT + (size_t)M * FF * 2 <= WS_HB && WS_HB + (size_t)M * D * 2 <= WS_END, "d_ws map");
constexpr int CW_BAR = 4096;

constexpr int RING_OFF = 0, RING_BYTES = 131072;
constexpr int LDSCTL_OFF = RING_BYTES, MISC_OFF = LDSCTL_OFF + 320, RTAB_OFF = LDSCTL_OFF + 1024;
constexpr int LDS_BYTES = 147456;
static_assert(MISC_OFF + 128 <= RTAB_OFF && RTAB_OFF + 12 * 256 * 4 <= LDS_BYTES, "LDS map");
#define GAS __attribute__((address_space(1)))
#define LAS __attribute__((address_space(3)))
typedef unsigned short bf16;
typedef unsigned v4u __attribute__((ext_vector_type(4)));
typedef float f32x4 __attribute__((ext_vector_type(4)));
typedef short bf16x8 __attribute__((ext_vector_type(8)));
typedef GAS unsigned gu32;
typedef GAS unsigned long long gu64;
#define RLX_AGENT __ATOMIC_RELAXED, __HIP_MEMORY_SCOPE_AGENT
#define LDS_WAIT() asm volatile("s_waitcnt lgkmcnt(0)" ::: "memory")
#define VM_WAIT() asm volatile("s_waitcnt vmcnt(0)" ::: "memory")
__device__ __forceinline__ unsigned long long rt() { return __builtin_amdgcn_s_memrealtime(); }
__device__ __forceinline__ unsigned f2bf(float f) { unsigned u = __builtin_bit_cast(unsigned, f); return (u + 0x7fffu + ((u >> 16) & 1u)) >> 16; }
__device__ __forceinline__ unsigned pk2(float lo, float hi) { return f2bf(lo) | (f2bf(hi) << 16); }

#define XB_TMO      128
#define XB_XCNT(j)  (256  + 64 * (j))
#define XB_XSUB(j)  (1280 + 64 * (j))
#define XB_XGEN(j)  (2304 + 64 * (j))
#define XB_TOP      3328
#define XB_TOPGEN   3392
#define XCD_BAR_WORDS 3456
#define XB_SPIN_CAP (1u << 18)

__device__ __forceinline__ unsigned xb_ld(unsigned* p)              { return __hip_atomic_load(p, __ATOMIC_RELAXED, __HIP_MEMORY_SCOPE_AGENT); }
__device__ __forceinline__ unsigned xb_add(unsigned* p, unsigned v) { return __hip_atomic_fetch_add(p, v, __ATOMIC_RELAXED, __HIP_MEMORY_SCOPE_AGENT); }
__device__ __forceinline__ unsigned xb_xcc_id() { return (unsigned)__builtin_amdgcn_s_getreg((3 << 11) | 20) & 0xFu; }
#define XB_SPIN(cond, bar) do { unsigned _sp = 0; while (cond) { __builtin_amdgcn_s_sleep(1); \
    if ((++_sp & 255u) == 0u) { if (xb_ld(&(bar)[XB_TMO])) break; if (_sp > XB_SPIN_CAP) { atomicAdd(&(bar)[XB_TMO], 1u); break; } } } } while (0)

struct XcdBarrier {
    unsigned* bar; unsigned x;
    volatile LAS unsigned* st;
};

__device__ __forceinline__ XcdBarrier xcd_barrier_post(unsigned* bar, volatile LAS unsigned* st) {
    XcdBarrier b; b.bar = bar; b.x = xb_xcc_id(); b.st = st;
    if (threadIdx.x == 0) (void)xb_add(&bar[XB_XCNT(b.x)], 1u);
    return b;
}
__device__ __forceinline__ void xcd_barrier_complete(unsigned* bar, unsigned x, unsigned& nloc, unsigned& nx) {
    const unsigned G = gridDim.x * gridDim.y * gridDim.z;
    unsigned sum, cnt, mine, sp = 0u;
    for (;;) {
        sum = 0u; cnt = 0u; mine = 0u;
#pragma unroll
        for (unsigned j = 0; j < 16; ++j) { const unsigned c = xb_ld(&bar[XB_XCNT(j)]); sum += c; cnt += (c > 0u) ? 1u : 0u; mine = (j == x) ? c : mine; }
        if (sum == G) break;
        __builtin_amdgcn_s_sleep(1);
        if ((++sp & 255u) == 0u) { if (xb_ld(&bar[XB_TMO])) break; if (sp > XB_SPIN_CAP) { atomicAdd(&bar[XB_TMO], 1u); break; } }
    }
    nloc = mine > 0u ? mine : 1u; nx = cnt > 0u ? cnt : 1u;
}

__device__ __forceinline__ void xcd_barrier(const XcdBarrier& b, int wave) {
    asm volatile("s_waitcnt vmcnt(0)" ::: "memory");
    __syncthreads();
    if (wave == 0 && lane_now() == 0) {
        unsigned* bar = b.bar;
        __builtin_amdgcn_s_waitcnt(0);
        unsigned nloc = b.st[0], nx = b.st[1];
        if (nloc == 0u) { xcd_barrier_complete(bar, b.x, nloc, nx); b.st[0] = nloc; b.st[1] = nx; }
        const unsigned old = xb_add(&bar[XB_XSUB(b.x)], 1u);
        const unsigned gen = old / nloc;
        if (old + 1u == (gen + 1u) * nloc) {
            __builtin_amdgcn_fence(__ATOMIC_RELEASE, "agent");
            asm volatile("s_waitcnt vmcnt(0)" ::: "memory");
            const unsigned og = xb_add(&bar[XB_TOP], 1u);
            const unsigned tg = og / nx;
            if (og + 1u == (tg + 1u) * nx) xb_add(&bar[XB_TOPGEN], 1u);
            else XB_SPIN(xb_ld(&bar[XB_TOPGEN]) == tg, bar);
            __builtin_amdgcn_fence(__ATOMIC_ACQUIRE, "agent");
            xb_add(&bar[XB_XGEN(b.x)], 1u);
            asm volatile("s_waitcnt vmcnt(0)" ::: "memory");
        } else {
            XB_SPIN(xb_ld(&bar[XB_XGEN(b.x)]) == gen, bar);
            __builtin_amdgcn_fence(__ATOMIC_ACQUIRE, "agent");
            asm volatile("s_waitcnt vmcnt(0)" ::: "memory");
        }
    }
    __syncthreads();
}


struct Frame {
    LAS unsigned char* lds;
    volatile LAS unsigned* MISC;
    gu32* ctl;
    int tid, lane, wave;
    int vcu, G;
    const float* in[20]; float* out;
    bf16 *Wgu1, *Wd1, *Win, *Wout, *Wgu2, *Wd2, *Wuk, *WuvT;
    bf16 *XN, *MIX, *KV, *ACT, *PROJ; unsigned* MASK; float* SS; bf16* HB;
};
enum { I_X = 0, I_N1, I_G1, I_U1, I_D1, I_NMIX, I_WIN, I_NKV, I_WUK, I_WUV, I_RELB, I_CONVW, I_NATT, I_NCONV, I_WOUT, I_N2, I_G2, I_U2, I_D2, I_NF };

__device__ __forceinline__ float wave_sum(float v) {
#pragma unroll
    for (int o = 1; o < 64; o <<= 1) v += __shfl_xor(v, o);
    return v;
}
__device__ __forceinline__ float wave_max(float v) {
#pragma unroll
    for (int o = 1; o < 64; o <<= 1) v = fmaxf(v, __shfl_xor(v, o));
    return v;
}
__device__ __forceinline__ float bflo(unsigned w) { return __uint_as_float(w << 16); }
__device__ __forceinline__ float bfhi(unsigned w) { return __uint_as_float(w & 0xffff0000u); }

__device__ __forceinline__ void ld8bf(const bf16* p, float (&f)[8]) { const v4u w = *(const GAS v4u*)p; f[0] = bflo(w.x); f[1] = bfhi(w.x); f[2] = bflo(w.y); f[3] = bfhi(w.y); f[4] = bflo(w.z); f[5] = bfhi(w.z); f[6] = bflo(w.w); f[7] = bfhi(w.w); }
struct Src { const float* W; int N; int col; };
struct MapPlain { const float* W; int N; __device__ __forceinline__ Src operator()(int d) const { return Src{W, N, d}; } };
struct MapGU { const float* W; __device__ __forceinline__ Src operator()(int d) const { return Src{W, FF, (d >> 8) * 128 + (d & 127)}; } };
struct MapWin { const float* W; __device__ __forceinline__ Src operator()(int d) const { int c;
    if (d < 512) c = d;
    else if (d < 1024) c = 640 + (d - 512);
    else if (d < 1152) c = 512 + (d - 1024);
    else if (d < 1224) c = d;
    else if (d < 1280) c = -1;
    else if (d < 1792) c = 1224 + (d - 1280);
    else if (d < 2304) c = 1736 + (d - 1792);
    else c = 2248 + (d - 2304);
    return Src{W, WIN_N, c}; } };
template <class MAP>
__device__ __forceinline__ void p0_transpose_item(const MAP& map, int K, int ndg, bf16* WT, LAS float* scr, int item, int lane, const float* gk = nullptr) {
    const int kb = item / ndg, dg = item % ndg, k0 = 64 * kb, d0 = 32 * dg;
    const Src src = map(d0 + (lane & 31)); const int sc = src.col; const float* wp = src.W + (size_t)(k0 + (lane >> 5)) * src.N + (sc >= 0 ? sc : 0);
    const float live = sc >= 0 ? 1.f : 0.f;
    float wv_[32];
#pragma unroll
    for (int i = 0; i < 32; ++i) wv_[i] = wp[(size_t)(2 * i) * src.N];
    if (gk) {
#pragma unroll
        for (int i = 0; i < 32; ++i) wv_[i] *= gk[k0 + 2 * i + (lane >> 5)]; }
#pragma unroll
    for (int i = 0; i < 32; ++i) { const int kk = 2 * i + (lane >> 5); scr[kk * 33 + (lane & 31)] = wv_[i] * live; }
    LDS_WAIT(); asm volatile("" ::: "memory");
    const int c = lane & 7;
#pragma unroll
    for (int j = 0; j < 4; ++j) { const int n = (lane >> 3) + 8 * j; const LAS float* s = scr + (8 * c) * 33 + n;
        v4u o; o.x = pk2(s[0 * 33], s[1 * 33]); o.y = pk2(s[2 * 33], s[3 * 33]); o.z = pk2(s[4 * 33], s[5 * 33]); o.w = pk2(s[6 * 33], s[7 * 33]);
        *(GAS v4u*)(WT + (size_t)(d0 + n) * K + k0 + 8 * c) = o; }
    LDS_WAIT(); asm volatile("" ::: "memory");
}
template <class MAP>
__device__ __forceinline__ void p0_transpose_item8(const MAP& map, int K, int ndg, unsigned char* WT, LAS float* scr, int item, int lane, float wscale, const float* gk = nullptr) {
    const int kb = item / ndg, dg = item % ndg, k0 = 64 * kb, d0 = 32 * dg;
    const Src src = map(d0 + (lane & 31)); const int sc = src.col; const float* wp = src.W + (size_t)(k0 + (lane >> 5)) * src.N + (sc >= 0 ? sc : 0);
    const float live = sc >= 0 ? wscale : 0.f;
    float wv_[32];
#pragma unroll
    for (int i = 0; i < 32; ++i) wv_[i] = wp[(size_t)(2 * i) * src.N];
    if (gk) {
#pragma unroll
        for (int i = 0; i < 32; ++i) wv_[i] *= gk[k0 + 2 * i + (lane >> 5)]; }
#pragma unroll
    for (int i = 0; i < 32; ++i) { const int kk = 2 * i + (lane >> 5); scr[kk * 33 + (lane & 31)] = wv_[i] * live; }
    LDS_WAIT(); asm volatile("" ::: "memory");
    const int c = lane & 7;
#pragma unroll
    for (int j = 0; j < 4; ++j) { const int n = (lane >> 3) + 8 * j; const LAS float* s = scr + (8 * c) * 33 + n;
        typedef unsigned u32x2v __attribute__((ext_vector_type(2))); u32x2v o; o.x = pg8::cvt4_fp8(s[0 * 33], s[1 * 33], s[2 * 33], s[3 * 33]); o.y = pg8::cvt4_fp8(s[4 * 33], s[5 * 33], s[6 * 33], s[7 * 33]);
        *(GAS u32x2v*)(WT + (size_t)(d0 + n) * K + k0 + 8 * c) = o; }
    LDS_WAIT(); asm volatile("" ::: "memory");
}
__device__ __forceinline__ void rms_row_to_bf16(int lane, const float* xrow, const float* gain, bf16* orow) {
    const GAS f32x4* xr = (const GAS f32x4*)xrow + lane; const GAS f32x4* gr = (const GAS f32x4*)gain + lane;
    f32x4 v[4]; float s = 0.f;
#pragma unroll
    for (int j = 0; j < 4; ++j) { v[j] = xr[64 * j]; s += (v[j].x * v[j].x + v[j].y * v[j].y) + (v[j].z * v[j].z + v[j].w * v[j].w); }
    const float rstd = 1.f / sqrtf(wave_sum(s) * (1.f / D) + EPS);
    GAS unsigned long long* o8 = (GAS unsigned long long*)orow + lane;
#pragma unroll
    for (int j = 0; j < 4; ++j) { const f32x4 g = gr[64 * j]; o8[64 * j] = (unsigned long long)pk2(v[j].x * rstd * g.x, v[j].y * rstd * g.y) | ((unsigned long long)pk2(v[j].z * rstd * g.z, v[j].w * rstd * g.w) << 32); }
}
template <bool OUT8> __device__ __forceinline__ void rows4_to_xn(int lane, const float* x, unsigned char* xn, float* ss, const int (&rows)[4]) {
    f32x4 v[4][4];
#pragma unroll
    for (int r = 0; r < 4; ++r) { const GAS f32x4* xr = (const GAS f32x4*)(x + (size_t)rows[r] * D) + lane;
#pragma unroll
        for (int j = 0; j < 4; ++j) v[r][j] = xr[64 * j]; }
#pragma unroll
    for (int r = 0; r < 4; ++r) { float s = 0.f;
#pragma unroll
        for (int j = 0; j < 4; ++j) s += (v[r][j].x * v[r][j].x + v[r][j].y * v[r][j].y) + (v[r][j].z * v[r][j].z + v[r][j].w * v[r][j].w);
        s = wave_sum(s);
        if constexpr (OUT8) { GAS unsigned* o4 = (GAS unsigned*)(xn + (size_t)rows[r] * D) + lane;
#pragma unroll
            for (int j = 0; j < 4; ++j) o4[64 * j] = pg8::cvt4_fp8(v[r][j].x, v[r][j].y, v[r][j].z, v[r][j].w); }
        else { GAS unsigned long long* o8 = (GAS unsigned long long*)(xn + (size_t)rows[r] * D * 2) + lane;
#pragma unroll
            for (int j = 0; j < 4; ++j) o8[64 * j] = (unsigned long long)pk2(v[r][j].x, v[r][j].y) | ((unsigned long long)pk2(v[r][j].z, v[r][j].w) << 32); }
        if (lane < 16) ((GAS float*)(ss + (size_t)rows[r] * 16))[lane] = lane == 0 ? s : 0.f; }
}
__device__ __forceinline__ void rows4_bf16_to_f32(int lane, const bf16* x, const float* gain, float* out, const int (&rows)[4], bool poison) {
    v4u w[4][2];
#pragma unroll
    for (int r = 0; r < 4; ++r)
#pragma unroll
        for (int j = 0; j < 2; ++j) w[r][j] = *(const GAS v4u*)(x + (size_t)rows[r] * D + 512 * j + 8 * lane);
    f32x4 g[2][2];
#pragma unroll
    for (int j = 0; j < 2; ++j) { const GAS f32x4* gp = (const GAS f32x4*)(gain + 512 * j + 8 * lane); g[j][0] = gp[0]; g[j][1] = gp[1]; }
#pragma unroll
    for (int r = 0; r < 4; ++r) { float v[2][8]; float s = 0.f;
#pragma unroll
        for (int j = 0; j < 2; ++j) { v[j][0] = bflo(w[r][j].x); v[j][1] = bfhi(w[r][j].x); v[j][2] = bflo(w[r][j].y); v[j][3] = bfhi(w[r][j].y); v[j][4] = bflo(w[r][j].z); v[j][5] = bfhi(w[r][j].z); v[j][6] = bflo(w[r][j].w); v[j][7] = bfhi(w[r][j].w);
#pragma unroll
            for (int e = 0; e < 8; ++e) s += v[j][e] * v[j][e]; }
        float rstd = 1.f / sqrtf(wave_sum(s) * (1.f / D) + EPS); if (poison) rstd = __builtin_nanf("");
#pragma unroll
        for (int j = 0; j < 2; ++j) { GAS f32x4* o = (GAS f32x4*)(out + (size_t)rows[r] * D + 512 * j + 8 * lane);
            o[0] = (f32x4){v[j][0] * rstd * g[j][0].x, v[j][1] * rstd * g[j][0].y, v[j][2] * rstd * g[j][0].z, v[j][3] * rstd * g[j][0].w};
            o[1] = (f32x4){v[j][4] * rstd * g[j][1].x, v[j][5] * rstd * g[j][1].y, v[j][6] * rstd * g[j][1].z, v[j][7] * rstd * g[j][1].w}; } }
}
__device__ __forceinline__ void rms_row_to_f32(int lane, const float* xrow, const float* gain, float* orow, bool poison) {
    const GAS f32x4* xr = (const GAS f32x4*)xrow + lane; const GAS f32x4* gr = (const GAS f32x4*)gain + lane;
    f32x4 v[4]; float s = 0.f;
#pragma unroll
    for (int j = 0; j < 4; ++j) { v[j] = xr[64 * j]; s += (v[j].x * v[j].x + v[j].y * v[j].y) + (v[j].z * v[j].z + v[j].w * v[j].w); }
    float rstd = 1.f / sqrtf(wave_sum(s) * (1.f / D) + EPS); if (poison) rstd = __builtin_nanf("");
    GAS f32x4* o = (GAS f32x4*)orow + lane;
#pragma unroll
    for (int j = 0; j < 4; ++j) { const f32x4 g = gr[64 * j]; o[64 * j] = v[j] * rstd * g; }
}
template <int SET> __device__ __forceinline__ void weight_items(Frame& F, int worker, int nw) {
    LAS float* scr = (LAS float*)(F.lds + RING_OFF + F.wave * 16384);
    constexpr int I_GU = (D / 64) * (FF2 / 32), I_DN = (FF / 64) * (D / 32), I_IN = (D / 64) * (NPROJ / 32), I_OUT = (D / 64) * (D / 32);
    if constexpr (SET == 0) {
        for (int it = worker; it < I_GU + I_DN; it += nw) {
            int r = it;
            if (r < I_GU) { const float* wsrc = (((r % (FF2 / 32)) & 7) < 4) ? F.in[I_G1] : F.in[I_U1];
                if (FFN1_FP8) p0_transpose_item8(MapGU{wsrc}, D, FF2 / 32, (unsigned char*)F.Wgu1, scr, r, F.lane, WSC_GU, F.in[I_N1]); else p0_transpose_item(MapGU{wsrc}, D, FF2 / 32, F.Wgu1, scr, r, F.lane, F.in[I_N1]); continue; } r -= I_GU;
            if (FFN1_FP8) p0_transpose_item8(MapPlain{F.in[I_D1], D}, FF, D / 32, (unsigned char*)F.Wd1, scr, r, F.lane, WSC_DN); else p0_transpose_item(MapPlain{F.in[I_D1], D}, FF, D / 32, F.Wd1, scr, r, F.lane);
        }
    } else {
        for (int it = worker; it < I_GU + I_DN + I_IN + I_OUT; it += nw) {
            int r = it;
            if (r < I_IN) { p0_transpose_item(MapWin{F.in[I_WIN]}, D, NPROJ / 32, F.Win, scr, r, F.lane, F.in[I_NMIX]); continue; } r -= I_IN;
            if (r < I_OUT) { p0_transpose_item(MapPlain{F.in[I_WOUT], D}, D, D / 32, F.Wout, scr, r, F.lane); continue; } r -= I_OUT;
            if (r < I_GU) { if (((r % (FF2 / 32)) & 7) < 4) p0_transpose_item8(MapGU{F.in[I_G2]}, D, FF2 / 32, (unsigned char*)F.Wgu2, scr, r, F.lane, WSC_GU, F.in[I_N2]); else p0_transpose_item8(MapGU{F.in[I_U2]}, D, FF2 / 32, (unsigned char*)F.Wgu2, scr, r, F.lane, WSC_GU, F.in[I_N2]); continue; } r -= I_GU;
            p0_transpose_item8(MapPlain{F.in[I_D2], D}, FF, D / 32, (unsigned char*)F.Wd2, scr, r, F.lane, WSC_DN);
        }
    }
}
#ifndef LATE_WEIGHTS
#define LATE_WEIGHTS 1
#endif
__device__ __forceinline__ bool late_weights(const Frame& F) { return LATE_WEIGHTS && F.G == 256; }
__device__ __forceinline__ void p0_prologue(Frame& F) {
    const int gw = F.vcu * NWAVES + F.wave, NGW = F.G * NWAVES;
    weight_items<0>(F, gw, NGW);
    if (!late_weights(F)) weight_items<1>(F, gw, NGW);
    for (int i = F.vcu * NWAVES * 64 + F.tid; i < CL * NH * HD; i += F.G * NWAVES * 64) {
        F.Wuk[i] = (bf16)f2bf(F.in[I_WUK][i]);
        const int j_ = i & 7, ln_ = (i >> 3) & 63, s_ = (i >> 9) & 1, cb_ = (i >> 10) & 3, db_ = (i >> 12) & 1, h_ = i >> 13;
        F.WuvT[i] = (bf16)f2bf(F.in[I_WUV][((size_t)(32 * cb_ + 16 * s_ + 8 * (j_ >> 2) + 4 * (ln_ >> 5) + (j_ & 3)) * NH + h_) * HD + 32 * db_ + (ln_ & 31)]); }
    for (int m = gw; m < M; m += 4 * NGW) { const int rows[4] = {m, min(m + NGW, M - 1), min(m + 2 * NGW, M - 1), min(m + 3 * NGW, M - 1)}; rows4_to_xn<FFN1_FP8 != 0>(F.lane, F.in[I_X], (unsigned char*)F.XN, F.SS, rows); }
}
__device__ __forceinline__ void norm_phase(Frame& F, const float* src, const float* gain) {
    const int gw = F.vcu * NWAVES + F.wave, NGW = F.G * NWAVES;
    for (int m = gw; m < M; m += NGW) rms_row_to_bf16(F.lane, src + (size_t)m * D, gain, F.XN + (size_t)m * D);
}

__device__ __forceinline__ void prep_phase(Frame& F) {
    const int gw = F.vcu * NWAVES + F.wave, NGW = F.G * NWAVES, lane = F.lane;
    const float* cw = F.in[I_CONVW];
    for (int m = gw; m < M; m += NGW) {
        const bf16* prow = F.PROJ + (size_t)m * NPROJ; const int t = m & (SEQ - 1);
        {
            const unsigned w = *(const GAS unsigned*)(prow + PCKV + 2 * lane); const float a = bflo(w), b = bfhi(w);
            const float rstd = 1.f / sqrtf(wave_sum(a * a + b * b) * (1.f / CL) + EPS);
            const float g0 = F.in[I_NKV][2 * lane], g1 = F.in[I_NKV][2 * lane + 1];
            *(GAS unsigned*)(F.KV + (size_t)m * CL + 2 * lane) = pk2(a * rstd * g0, b * rstd * g1);
        }
        {
            const int c0 = 8 * lane; float gb[8], gc[8], xi[8], gc1[8], xi1[8], gc2[8], xi2[8], y[8];
            const bf16* p1 = t >= 1 ? prow - NPROJ : prow; const bf16* p2 = t >= 2 ? prow - 2 * NPROJ : prow; const float f1 = t >= 1 ? 1.f : 0.f, f2 = t >= 2 ? 1.f : 0.f;
            ld8bf(prow + PGB + c0, gb); ld8bf(prow + PGC + c0, gc); ld8bf(prow + PXIN + c0, xi); ld8bf(p1 + PGC + c0, gc1); ld8bf(p1 + PXIN + c0, xi1); ld8bf(p2 + PGC + c0, gc2); ld8bf(p2 + PXIN + c0, xi2);
            const GAS f32x4* cw4 = (const GAS f32x4*)(cw + c0);
            const f32x4 wa0 = cw4[0], wa1 = cw4[1], wb0 = cw4[128], wb1 = cw4[129], wc0 = cw4[256], wc1 = cw4[257];
            const float w0[8] = {wa0.x, wa0.y, wa0.z, wa0.w, wa1.x, wa1.y, wa1.z, wa1.w}, w1[8] = {wb0.x, wb0.y, wb0.z, wb0.w, wb1.x, wb1.y, wb1.z, wb1.w}, w2[8] = {wc0.x, wc0.y, wc0.z, wc0.w, wc1.x, wc1.y, wc1.z, wc1.w};
#pragma unroll
            for (int e = 0; e < 8; ++e) y[e] = w2[e] * (gc[e] * xi[e]) + f1 * (w1[e] * (gc1[e] * xi1[e])) + f2 * (w0[e] * (gc2[e] * xi2[e]));
            float ss = 0.f;
#pragma unroll
            for (int e = 0; e < 8; ++e) { y[e] *= gb[e]; ss += y[e] * y[e]; }
            const float rstd = 1.f / sqrtf(wave_sum(ss) * (1.f / 512.f) + EPS);
            const float* g = F.in[I_NCONV] + c0;
            v4u o; o.x = pk2(y[0] * rstd * g[0], y[1] * rstd * g[1]); o.y = pk2(y[2] * rstd * g[2], y[3] * rstd * g[3]); o.z = pk2(y[4] * rstd * g[4], y[5] * rstd * g[5]); o.w = pk2(y[6] * rstd * g[6], y[7] * rstd * g[7]);
            *(GAS v4u*)(F.MIX + (size_t)m * D + 512 + c0) = o;
        }
    }
}

__device__ __forceinline__ int wave_sum_i(int v) {
#pragma unroll
    for (int o = 1; o < 64; o <<= 1) v += __shfl_xor(v, o);
    return v;
}
__device__ __forceinline__ int rel_bucket(int d) {
    if (d < 16) return d;
    return 16 + (d >= 19) + (d >= 21) + (d >= 24) + (d >= 27) + (d >= 31) + (d >= 35) + (d >= 40) + (d >= 46) + (d >= 52) + (d >= 59) + (d >= 67) + (d >= 77) + (d >= 87) + (d >= 99) + (d >= 113);
}
__device__ __forceinline__ void naive_attn_query(Frame& F, int m, LAS float* L) {
    const int lane = F.lane, b = m >> 11, t = m & (SEQ - 1);
    LAS float* qi_s = L;
    LAS float* qa_s = L + 512;
    LAS int* sel_s = (LAS int*)(L + 1536);
    LAS unsigned* sc_s = (LAS unsigned*)(L + 1792);
    LAS float* p_s = L + 1792;
    const bf16* prow = F.PROJ + (size_t)m * NPROJ;
    const bf16* pb = F.PROJ + (size_t)(b * SEQ) * NPROJ;
    float f8[8];
    ld8bf(prow + PQI + 8 * lane, f8);
#pragma unroll
    for (int e = 0; e < 8; ++e) qi_s[8 * lane + e] = f8[e];
    float wv[8]; ld8bf(prow + PWI, wv);
#pragma unroll
    for (int h = 0; h < 8; ++h) wv[h] *= IDX_SCALE;
    LDS_WAIT();
    for (int s = lane; s <= t; s += 64) {
        const bf16* kr = pb + (size_t)s * NPROJ + PKI; float dot[8];
#pragma unroll
        for (int h = 0; h < 8; ++h) dot[h] = 0.f;
#pragma unroll 1
        for (int ch = 0; ch < 8; ++ch) { float k[8]; ld8bf(kr + 8 * ch, k);
#pragma unroll
            for (int h = 0; h < 8; ++h)
#pragma unroll
                for (int e = 0; e < 8; ++e) dot[h] += qi_s[h * 64 + ch * 8 + e] * k[e]; }
        float score = 0.f;
#pragma unroll
        for (int h = 0; h < 8; ++h) score += wv[h] * fmaxf(dot[h], 0.f);
        unsigned u = __float_as_uint(score); u = (u & 0x80000000u) ? ~u : (u | 0x80000000u);
        sc_s[s] = u;
    }
    LDS_WAIT();
    int nsel;
    if (t < TOPK) { nsel = t + 1; for (int i = lane; i < nsel; i += 64) sel_s[i] = i; }
    else {
        unsigned T = 0u;
        for (int bit = 31; bit >= 0; --bit) { const unsigned cand = T | (1u << bit); int cnt = 0;
            for (int s = lane; s <= t; s += 64) cnt += (sc_s[s] >= cand) ? 1 : 0;
            cnt = wave_sum_i(cnt); if (cnt >= TOPK) T = cand; }
        int cgt = 0; for (int s = lane; s <= t; s += 64) cgt += (sc_s[s] > T) ? 1 : 0;
        cgt = wave_sum_i(cgt);
        const int need = TOPK - cgt; int base = 0, taken = 0; const unsigned long long lt = (1ull << lane) - 1ull;
        for (int s0 = 0; s0 <= t; s0 += 64) { const int s = s0 + lane; const bool valid = s <= t; const unsigned key = valid ? sc_s[s] : 0u;
            const bool gt = valid && key > T, eq = valid && key == T;
            const unsigned long long eqm = __ballot(eq); const int eqrank = taken + __popcll(eqm & lt);
            const bool selb = gt || (eq && eqrank < need);
            const unsigned long long sm = __ballot(selb); const int pos = base + __popcll(sm & lt);
            if (selb) sel_s[pos] = s;
            base += __popcll(sm); taken += __popcll(eqm); }
        nsel = TOPK;
    }
    ld8bf(prow + PQ + 8 * lane, f8);
#pragma unroll
    for (int e = 0; e < 8; ++e) qi_s[8 * lane + e] = f8[e];
    LDS_WAIT();
    for (int i = 0; i < 16; ++i) { const int o = lane + 64 * i, h = o >> 7, c = o & 127; const GAS f32x4* w = (const GAS f32x4*)(F.in[I_WUK] + ((size_t)c * 8 + h) * 64); float a = 0.f;
#pragma unroll
        for (int d4 = 0; d4 < 16; ++d4) { const f32x4 wv4 = w[d4]; a += qi_s[h * 64 + 4 * d4] * wv4.x + qi_s[h * 64 + 4 * d4 + 1] * wv4.y + qi_s[h * 64 + 4 * d4 + 2] * wv4.z + qi_s[h * 64 + 4 * d4 + 3] * wv4.w; }
        qa_s[o] = a * 0.125f; }
    LDS_WAIT();
    for (int i = 0; i < 4; ++i) { const int kidx = lane + 64 * i; float lg[8];
        if (kidx < nsel) { const int s = sel_s[kidx]; const bf16* kr = F.KV + (size_t)(b * SEQ + s) * CL;
#pragma unroll
            for (int h = 0; h < 8; ++h) lg[h] = 0.f;
#pragma unroll 1
            for (int ch = 0; ch < 16; ++ch) { float k[8]; ld8bf(kr + 8 * ch, k);
#pragma unroll
                for (int h = 0; h < 8; ++h)
#pragma unroll
                    for (int e = 0; e < 8; ++e) lg[h] += qa_s[h * 128 + ch * 8 + e] * k[e]; }
            const float* rb = F.in[I_RELB] + rel_bucket(t - s) * 8;
#pragma unroll
            for (int h = 0; h < 8; ++h) lg[h] += rb[h];
        } else {
#pragma unroll
            for (int h = 0; h < 8; ++h) lg[h] = -INFINITY; }
#pragma unroll
        for (int h = 0; h < 8; ++h) p_s[h * 256 + kidx] = lg[h]; }
    LDS_WAIT();
    for (int h = 0; h < 8; ++h) { float v[4], mx = -INFINITY;
#pragma unroll
        for (int i = 0; i < 4; ++i) { v[i] = p_s[h * 256 + lane + 64 * i]; mx = fmaxf(mx, v[i]); }
        mx = wave_max(mx); float sm = 0.f;
#pragma unroll
        for (int i = 0; i < 4; ++i) { v[i] = __expf(v[i] - mx); sm += v[i]; }
        sm = wave_sum(sm); const float inv = 1.f / sm;
#pragma unroll
        for (int i = 0; i < 4; ++i) p_s[h * 256 + lane + 64 * i] = v[i] * inv; }
    LDS_WAIT();
    float cx[8][2];
#pragma unroll
    for (int h = 0; h < 8; ++h) { cx[h][0] = 0.f; cx[h][1] = 0.f; }
    for (int k = 0; k < nsel; ++k) { const int s = sel_s[k]; const unsigned w = *(const GAS unsigned*)(F.KV + (size_t)(b * SEQ + s) * CL + 2 * lane); const float k0 = bflo(w), k1 = bfhi(w);
#pragma unroll
        for (int h = 0; h < 8; ++h) { const float p = p_s[h * 256 + k]; cx[h][0] += p * k0; cx[h][1] += p * k1; } }
#pragma unroll
    for (int h = 0; h < 8; ++h) { qa_s[h * 128 + 2 * lane] = cx[h][0]; qa_s[h * 128 + 2 * lane + 1] = cx[h][1]; }
    LDS_WAIT();
    float o8[8]; float ss = 0.f;
#pragma unroll
    for (int h = 0; h < 8; ++h) { float a = 0.f; const float* w = F.in[I_WUV] + h * 64 + lane;
        for (int c = 0; c < 128; ++c) a += qa_s[h * 128 + c] * w[(size_t)c * 512];
        o8[h] = a; ss += a * a; }
    const float rstd = 1.f / sqrtf(wave_sum(ss) * (1.f / 512.f) + EPS);
#pragma unroll
    for (int h = 0; h < 8; ++h) F.MIX[(size_t)m * D + h * 64 + lane] = (bf16)f2bf(o8[h] * rstd * F.in[I_NATT][h * 64 + lane]);
    LDS_WAIT();
}
__device__ __forceinline__ void naive_attn_phase(Frame& F) {
    LAS float* L = (LAS float*)(F.lds + RING_OFF + F.wave * 16384);
    const int gw = F.vcu * NWAVES + F.wave, NGW = F.G * NWAVES;
    for (int idx = gw; idx < M; idx += NGW) { const int b = idx >> 11, tt = idx & (SEQ - 1), t = (b & 1) ? (SEQ - 1 - tt) : tt; naive_attn_query(F, b * SEQ + t, L); }
}

namespace idx {
typedef short bf16x8 __attribute__((ext_vector_type(8)));
typedef float f32x16 __attribute__((ext_vector_type(16)));
constexpr int CHUNK_KEYS = 256, CHUNK_BYTES = CHUNK_KEYS * 128;
__device__ __forceinline__ unsigned sortable(float s) { const unsigned u = __float_as_uint(s); return u ^ ((unsigned)((int)u >> 31) | 0x80000000u); }
__device__ __forceinline__ float relu_i(float x) { const int i = __float_as_int(x); return __int_as_float(i > 0 ? i : 0); }
__device__ __forceinline__ int half_sum(int v, int hi) {
    v += __builtin_amdgcn_update_dpp(0, v, 0x111, 0xf, 0xf, false);
    v += __builtin_amdgcn_update_dpp(0, v, 0x112, 0xf, 0xf, false);
    v += __builtin_amdgcn_update_dpp(0, v, 0x114, 0xf, 0xf, false);
    v += __builtin_amdgcn_update_dpp(0, v, 0x118, 0xf, 0xf, false);
    v += __builtin_amdgcn_update_dpp(0, v, 0x142, 0xa, 0xf, false);
    const int lo = __builtin_amdgcn_readlane(v, 31), up = __builtin_amdgcn_readlane(v, 63);
    return hi ? up : lo;
}
#define IDX_CNT4(x0, y0, x1, y1) do { unsigned long long t0_, t1_, t2_, t3_; asm volatile( \
        "v_cmp_ge_u32_e64 %2, %6, %10\n\tv_cmp_ge_u32_e64 %3, %7, %11\n\tv_cmp_ge_u32_e64 %4, %8, %10\n\tv_cmp_ge_u32_e64 %5, %9, %11\n\t" \
        "v_addc_co_u32_e64 %0, %2, 0, %0, %2\n\tv_addc_co_u32_e64 %1, %3, 0, %1, %3\n\tv_addc_co_u32_e64 %0, %4, 0, %0, %4\n\tv_addc_co_u32_e64 %1, %5, 0, %1, %5" \
        : "+v"(cnt0), "+v"(cnt1), "=&s"(t0_), "=&s"(t1_), "=&s"(t2_), "=&s"(t3_) : "v"(x0), "v"(y0), "v"(x1), "v"(y1), "v"(c0), "v"(c1)); } while (0)
#define IDX_WL(dst, val, ln) asm volatile("v_writelane_b32 %0, %1, %2" : "+v"(dst) : "s"(val), "i"(ln))
#define IDX_FOR_KB(...) _Pragma("unroll") for (int g_ = 0; g_ < 8; ++g_) { if (8 * g_ <= qb) { _Pragma("unroll") for (int k_ = 0; k_ < 8; ++k_) { const int kb = 8 * g_ + k_; __VA_ARGS__ } } }
#define IDX_FOR_KB2(...) _Pragma("unroll") for (int g_ = 0; g_ < 8; ++g_) { if (8 * g_ <= qb) { _Pragma("unroll") for (int k_ = 0; k_ < 8; k_ += 2) { const int kb = 8 * g_ + k_; __VA_ARGS__ } } }
__device__ __forceinline__ void idx_unit(Frame& F, int b, int qb, LAS unsigned char* lds) {
    const int tid = F.tid, lane = F.lane, w = F.wave, r32 = lane & 31, hi = lane >> 5;
    const int q0 = 32 * qb; const size_t rowbase = (size_t)b * SEQ;
    const int ri = (r32 & 3) + 4 * (r32 >> 3), hii = (r32 >> 2) & 1;
    const bf16* arow = F.PROJ + (rowbase + q0 + 4 * w + 2 * hii + (ri >> 3)) * NPROJ + PQI + (ri & 7) * 64 + 8 * hi;
    bf16x8 A[4];
#pragma unroll
    for (int s = 0; s < 4; ++s) A[s] = *(const GAS bf16x8*)(arow + 16 * s);
    float wv[2][8];
#pragma unroll
    for (int qq = 0; qq < 2; ++qq) { ld8bf(F.PROJ + (rowbase + q0 + 4 * w + 2 * hi + qq) * NPROJ + PWI, wv[qq]);
#pragma unroll
        for (int h = 0; h < 8; ++h) wv[qq][h] *= IDX_SCALE; }
    const int lim0 = 4 * w + 2 * hi;
    unsigned sc[64][2];
#pragma unroll
    for (int p = 0; p < 64; ++p) { sc[p][0] = 0u; sc[p][1] = 0u; }
    const bf16* kptr = F.PROJ + (rowbase + 32 * w + (lane >> 3)) * NPROJ + PKI;
    unsigned coff[4];
#pragma unroll
    for (int i = 0; i < 4; ++i) coff[i] = (unsigned)((((lane & 7) ^ ((4 * i + (lane >> 4)) & 7)) * 8) + 8 * i * NPROJ);
#define IDX_DMA(bufb) do { _Pragma("unroll") for (int i_ = 0; i_ < 4; ++i_) __builtin_amdgcn_global_load_lds((const unsigned*)(kptr + coff[i_]), (LAS unsigned*)(lds + (bufb) + (4 * w + i_) * 1024), 16, 0, 0); \
        kptr += (size_t)CHUNK_KEYS * NPROJ; } while (0)
    unsigned boff[4];
#pragma unroll
    for (int s = 0; s < 4; ++s) boff[s] = (unsigned)(r32 * 128 + (((2 * s + hi) ^ ((r32 >> 1) & 7)) << 4));
    IDX_DMA(0);
    const int nch = (qb >> 3) + 1;
#pragma unroll 1
    for (int ch = 0; ch < nch; ++ch) {
        asm volatile("s_waitcnt vmcnt(0)" ::: "memory");
        __syncthreads();
        const int cb = (ch & 1) * CHUNK_BYTES;
        if (ch + 1 < nch) IDX_DMA(CHUNK_BYTES - cb);
#pragma unroll
        for (int p = 63; p >= 8; --p) { sc[p][0] = sc[p - 8][0]; sc[p][1] = sc[p - 8][1]; }
#pragma unroll
        for (int k = 0; k < 8; ++k) {
            f32x16 acc = {};
#pragma unroll
            for (int s = 0; s < 4; ++s) { const bf16x8 B = *(const LAS bf16x8*)(lds + cb + boff[s] + k * 4096);
                acc = __builtin_amdgcn_mfma_f32_32x32x16_bf16(A[s], B, acc, 0, 0, 0); }
            float s0 = 0.f, s1 = 0.f;
#pragma unroll
            for (int h = 0; h < 8; ++h) { s0 = fmaf(relu_i(acc[h]), wv[0][h], s0); s1 = fmaf(relu_i(acc[8 + h]), wv[1][h], s1); }
            unsigned u0 = sortable(s0), u1 = sortable(s1);
            const int kb = 8 * ch + k;
            if (kb >= qb) { if (kb > qb || r32 > lim0) u0 = 0u; if (kb > qb || r32 > lim0 + 1) u1 = 0u; }
            sc[k][0] = u0; sc[k][1] = u1;
            __builtin_amdgcn_sched_barrier(0);
        }
    }
    __syncthreads();
    unsigned T0 = 1u, T1 = 1u; bool d0 = true, d1 = true;
    if (qb >= 8) {
        T0 = 0u; T1 = 0u; d0 = false; d1 = false;
#pragma unroll 1
        for (int bit = 31; bit >= 0; --bit) {
            const unsigned c0 = T0 | (1u << bit), c1 = T1 | (1u << bit); int cnt0 = 0, cnt1 = 0;
            IDX_FOR_KB2( IDX_CNT4(sc[kb][0], sc[kb][1], sc[kb + 1][0], sc[kb + 1][1]); )
            const int cnt = half_sum(cnt0 | (cnt1 << 16), hi);
            const int n0 = cnt & 0xffff, n1 = cnt >> 16;
            if (!d0 && n0 >= TOPK) { T0 = c0; d0 = (n0 == TOPK); }
            if (!d1 && n1 >= TOPK) { T1 = c1; d1 = (n1 == TOPK); }
            if (__all(d0 && d1)) break;
        }
    }
    unsigned mw0 = 0u, mw1 = 0u, mw2 = 0u, mw3 = 0u;
    if (__all(d0 && d1)) {
        IDX_FOR_KB( const unsigned long long m0 = __ballot(sc[kb][0] >= T0), m1 = __ballot(sc[kb][1] >= T1);
            IDX_WL(mw0, (unsigned)m0, kb); IDX_WL(mw2, (unsigned)(m0 >> 32), kb);
            IDX_WL(mw1, (unsigned)m1, kb); IDX_WL(mw3, (unsigned)(m1 >> 32), kb); )
    } else {
        int cg = 0;
        IDX_FOR_KB( cg += (sc[kb][0] > T0 ? 1 : 0) + (sc[kb][1] > T1 ? 65536 : 0); )
        cg = half_sum(cg, hi);
        const int need0 = d0 ? (1 << 20) : TOPK - (cg & 0xffff), need1 = d1 ? (1 << 20) : TOPK - (cg >> 16);
        int taken0 = 0, taken1 = 0; const unsigned lt = (1u << r32) - 1u;
#pragma unroll
        for (int g_ = 7; g_ >= 0; --g_) { if (g_ < nch) {
#pragma unroll
            for (int k_ = 0; k_ < 8; ++k_) { const int kb = 8 * g_ + k_;
                const bool e0 = sc[kb][0] == T0, e1 = sc[kb][1] == T1;
                const unsigned long long em0 = __ballot(e0), em1 = __ballot(e1);
                const unsigned h0 = hi ? (unsigned)(em0 >> 32) : (unsigned)em0, h1 = hi ? (unsigned)(em1 >> 32) : (unsigned)em1;
                const bool s0 = sc[kb][0] > T0 || (e0 && taken0 + __popc(h0 & lt) < need0), s1 = sc[kb][1] > T1 || (e1 && taken1 + __popc(h1 & lt) < need1);
                taken0 += __popc(h0); taken1 += __popc(h1);
                const unsigned long long m0 = __ballot(s0), m1 = __ballot(s1);
                IDX_WL(mw0, (unsigned)m0, kb); IDX_WL(mw2, (unsigned)(m0 >> 32), kb);
                IDX_WL(mw1, (unsigned)m1, kb); IDX_WL(mw3, (unsigned)(m1 >> 32), kb); } } }
    }
    const int kbl = (lane < 8 * nch) ? 8 * (nch - 1 - (lane >> 3)) + (lane & 7) : lane;
    unsigned* mrow = F.MASK + (rowbase + q0 + 4 * w) * 64 + kbl;
    mrow[0] = mw0; mrow[64] = mw1; mrow[128] = mw2; mrow[192] = mw3;
#undef IDX_DMA
}
#undef IDX_FOR_KB
#undef IDX_FOR_KB2
#undef IDX_WL
#undef IDX_CNT4
__device__ __forceinline__ void idx_phase(Frame& F) {
    for (int v2 = 2 * F.vcu; v2 < 512; v2 += 2 * F.G)
        for (int u = 0; u < 2 * (1 + ((REP_MASK >> 5) & 1)); ++u) { const int v = v2 >> 1, b = v >> 5, j = v & 31; idx_unit(F, b, (u & 1) ? j : 63 - j, F.lds + RING_OFF); }
}
}

namespace att {
typedef short bf16x8 __attribute__((ext_vector_type(8)));
typedef short s16x4 __attribute__((ext_vector_type(4)));
typedef float f32x16 __attribute__((ext_vector_type(16)));
typedef unsigned u32x4 __attribute__((ext_vector_type(4)));
typedef float f32x2_t __attribute__((ext_vector_type(2))); typedef __bf16 bf16x2_t __attribute__((ext_vector_type(2)));
constexpr float LOG2E = 1.4426950408889634f;
constexpr int NBUF = 3, L_K = 0, L_V = NBUF * 16384, L_TBL = 2 * NBUF * 16384, TBL_N = 320, L_MASK = L_TBL + 8 * TBL_N * 4, MROW = 66, L_RMS = L_MASK + 32 * MROW * 4, L_END = L_RMS + 8 * 32 * 4;
static_assert(L_END <= RING_BYTES, "attention LDS map");
#define ATT_KSWZ(row, colB) ((row) * 256 + ((colB) ^ (((row) & 15) << 4)))
#define ATT_SBAR() __builtin_amdgcn_sched_barrier(0)
__device__ __forceinline__ unsigned cvtpk(float lo, float hi) { f32x2_t v = {lo, hi}; bf16x2_t b = __builtin_convertvector(v, bf16x2_t); return __builtin_bit_cast(unsigned, b); }
__device__ __forceinline__ int v_st(int k, int c) { const int kk = (k & ~0xC) | ((k & 4) << 1) | ((k & 8) >> 1); return ((kk >> 3) * 4 + (c >> 5)) * 512 + ((kk & 7) * 32 + (c & 31)) * 2; }
__device__ __forceinline__ int v_rd_base(int lane) { return ((lane & 3) << 3) | (((lane >> 2) & 3) << 6) | (((lane >> 4) & 1) << 5) | (((lane >> 5) & 1) << 8); }
constexpr int v_rd_off(int d0, int ks, int half) { return d0 * 512 + ks * 4096 + half * 2048; }
template <int OFF> __device__ __forceinline__ s16x4 tr_read(int vb) { s16x4 r; asm volatile("ds_read_b64_tr_b16 %0, %1 offset:%2" : "=&v"(r) : "v"(vb), "i"(OFF) : "memory"); return r; }
template <int D0> __device__ __forceinline__ void pv_rd(s16x4 (&l)[4], s16x4 (&h)[4], int vb) {
    l[0] = tr_read<v_rd_off(D0, 0, 0)>(vb); h[0] = tr_read<v_rd_off(D0, 0, 1)>(vb); l[1] = tr_read<v_rd_off(D0, 1, 0)>(vb); h[1] = tr_read<v_rd_off(D0, 1, 1)>(vb);
    l[2] = tr_read<v_rd_off(D0, 2, 0)>(vb); h[2] = tr_read<v_rd_off(D0, 2, 1)>(vb); l[3] = tr_read<v_rd_off(D0, 3, 0)>(vb); h[3] = tr_read<v_rd_off(D0, 3, 1)>(vb);
}
#define ATT_PK(L, H) (bf16x8){L[0], L[1], L[2], L[3], H[0], H[1], H[2], H[3]}
__device__ __forceinline__ void pv_mm(f32x16& od, const s16x4 (&l)[4], const s16x4 (&h)[4], bf16x8 pa0, bf16x8 pa1, bf16x8 pa2, bf16x8 pa3) {
    od = __builtin_amdgcn_mfma_f32_32x32x16_bf16(ATT_PK(l[0], h[0]), pa0, od, 0, 0, 0);
    od = __builtin_amdgcn_mfma_f32_32x32x16_bf16(ATT_PK(l[1], h[1]), pa1, od, 0, 0, 0);
    od = __builtin_amdgcn_mfma_f32_32x32x16_bf16(ATT_PK(l[2], h[2]), pa2, od, 0, 0, 0);
    od = __builtin_amdgcn_mfma_f32_32x32x16_bf16(ATT_PK(l[3], h[3]), pa3, od, 0, 0, 0);
}
#undef ATT_PK
#define ATT_LWAIT(n) do { asm volatile("s_waitcnt lgkmcnt(" #n ")" ::: "memory"); ATT_SBAR(); } while (0)
__device__ __forceinline__ void pv_all(f32x16 (&o)[4], int vb, bf16x8 pa0, bf16x8 pa1, bf16x8 pa2, bf16x8 pa3) {
    s16x4 la[4], ha[4], lb[4], hb[4];
    asm volatile("s_waitcnt lgkmcnt(0)" ::: "memory");
    pv_rd<0>(la, ha, vb); pv_rd<1>(lb, hb, vb);
    ATT_LWAIT(8); pv_mm(o[0], la, ha, pa0, pa1, pa2, pa3);
    pv_rd<2>(la, ha, vb);
    ATT_LWAIT(8); pv_mm(o[1], lb, hb, pa0, pa1, pa2, pa3);
    pv_rd<3>(lb, hb, vb);
    ATT_LWAIT(8); pv_mm(o[2], la, ha, pa0, pa1, pa2, pa3);
    ATT_LWAIT(0); pv_mm(o[3], lb, hb, pa0, pa1, pa2, pa3);
}
#undef ATT_LWAIT
__device__ __forceinline__ float max3f(float a, float b, float c) { float r; asm("v_max3_f32 %0, %1, %2, %3" : "=v"(r) : "v"(a), "v"(b), "v"(c)); return r; }
__device__ __forceinline__ float and_f(float p, int m) { float r; asm("s_nop 0\n\tv_and_b32 %0, %1, %2" : "=v"(r) : "v"(p), "v"(m)); return r; }
__device__ __forceinline__ bf16x8 pack8(const f32x16& x, int s, float sc) {
    u32x4 w = {cvtpk(x[8 * s] * sc, x[8 * s + 1] * sc), cvtpk(x[8 * s + 2] * sc, x[8 * s + 3] * sc), cvtpk(x[8 * s + 4] * sc, x[8 * s + 5] * sc), cvtpk(x[8 * s + 6] * sc, x[8 * s + 7] * sc)};
    return __builtin_bit_cast(bf16x8, w);
}

typedef short v4i16_t __attribute__((ext_vector_type(4)));
__device__ __forceinline__ s16x4 vtr(const LAS unsigned char* p) { return __builtin_bit_cast(s16x4, __builtin_amdgcn_ds_read_tr16_b64_v4i16((LAS v4i16_t*)p)); }
__device__ __forceinline__ void qk_tile(f32x16& p0, f32x16& p1, const LAS unsigned char* Ks, const bf16x8 (&qr)[8], int r32, int hi) {
    p0 = f32x16{}; p1 = f32x16{};
#pragma unroll
    for (int d0 = 0; d0 < 8; ++d0) { const int cbyte = (d0 * 16 + hi * 8) * 2;
        const bf16x8 k0f = *(const LAS bf16x8*)(Ks + ATT_KSWZ(r32, cbyte)), k1f = *(const LAS bf16x8*)(Ks + ATT_KSWZ(32 + r32, cbyte));
        p0 = __builtin_amdgcn_mfma_f32_32x32x16_bf16(k0f, qr[d0], p0, 0, 0, 0); p1 = __builtin_amdgcn_mfma_f32_32x32x16_bf16(k1f, qr[d0], p1, 0, 0, 0); }
}
__device__ __forceinline__ void pv_tile(f32x16 (&o)[4], const LAS unsigned char* vp, bf16x8 pa0, bf16x8 pa1, bf16x8 pa2, bf16x8 pa3) {
#pragma unroll
    for (int d0 = 0; d0 < 4; ++d0) {
        s16x4 l[4], hh[4];
#pragma unroll
        for (int ks = 0; ks < 4; ++ks) { l[ks] = vtr(vp + v_rd_off(d0, ks, 0)); hh[ks] = vtr(vp + v_rd_off(d0, ks, 1)); }
#define ATT_PK(L, H) (bf16x8){L[0], L[1], L[2], L[3], H[0], H[1], H[2], H[3]}
        o[d0] = __builtin_amdgcn_mfma_f32_32x32x16_bf16(ATT_PK(l[0], hh[0]), pa0, o[d0], 0, 0, 0);
        o[d0] = __builtin_amdgcn_mfma_f32_32x32x16_bf16(ATT_PK(l[1], hh[1]), pa1, o[d0], 0, 0, 0);
        o[d0] = __builtin_amdgcn_mfma_f32_32x32x16_bf16(ATT_PK(l[2], hh[2]), pa2, o[d0], 0, 0, 0);
        o[d0] = __builtin_amdgcn_mfma_f32_32x32x16_bf16(ATT_PK(l[3], hh[3]), pa3, o[d0], 0, 0, 0);
#undef ATT_PK
        ATT_SBAR();
    }
}
__device__ __forceinline__ void sm_partial(f32x16& p0, f32x16& p1, const LAS float* tb, bool near, float boff, unsigned long long mwd, int hi, float& m_run, float& alpha, int& w1) {
    if (near) {
#pragma unroll
        for (int r = 0; r < 16; ++r) { p0[r] += tb[(r & 3) + 8 * (r >> 2)]; p1[r] += tb[32 + (r & 3) + 8 * (r >> 2)]; } }
    asm volatile("s_nop 15\n\ts_nop 7" : "+v"(p0), "+v"(p1));
    float rm = max3f(p0[0], p1[0], p0[1]); rm = max3f(rm, p1[1], p0[2]); rm = max3f(rm, p1[2], p0[3]); rm = max3f(rm, p1[3], p0[4]);
#pragma unroll
    for (int r = 4; r < 15; r += 2) { rm = max3f(rm, p1[r], p0[r + 1]); rm = max3f(rm, p1[r + 1], r + 2 < 16 ? p0[r + 2] : p1[15]); }
    { auto rr = __builtin_amdgcn_permlane32_swap(__float_as_uint(rm), __float_as_uint(rm), false, false); rm = max3f(__uint_as_float(rr[0]), __uint_as_float(rr[1]), __uint_as_float(rr[1])); }
    const float mnew = max3f(m_run, rm + boff, rm + boff), off = mnew - boff; alpha = __builtin_amdgcn_exp2f(m_run - mnew); m_run = mnew;
    const int w0 = (int)((unsigned)mwd >> (4 * hi)); w1 = (int)((unsigned)(mwd >> 32) >> (4 * hi));
#pragma unroll
    for (int r = 0; r < 16; ++r) { const int pos = (r & 3) + 8 * (r >> 2); p0[r] = and_f(__builtin_amdgcn_exp2f(p0[r] - off), __builtin_amdgcn_sbfe(w0, pos, 1)); p1[r] -= off; }
}
__device__ __forceinline__ void sm_finish(f32x16& p0, f32x16& p1, int w1, float alpha, float& l_run, bf16x8& pa0, bf16x8& pa1, bf16x8& pa2, bf16x8& pa3) {
    float ps = 0.f;
#pragma unroll
    for (int r = 0; r < 16; ++r) { const int pos = (r & 3) + 8 * (r >> 2); p1[r] = and_f(__builtin_amdgcn_exp2f(p1[r]), __builtin_amdgcn_sbfe(w1, pos, 1)); ps += p0[r] + p1[r]; }
    { auto rr = __builtin_amdgcn_permlane32_swap(__float_as_uint(ps), __float_as_uint(ps), false, false); ps = __uint_as_float(rr[0]) + __uint_as_float(rr[1]); }
    l_run = l_run * alpha + ps;
#define ATT_PK4(P, BASE, OUT) do { unsigned a0 = cvtpk(P[BASE + 0], P[BASE + 1]), a1 = cvtpk(P[BASE + 2], P[BASE + 3]);   \
    unsigned b0 = cvtpk(P[BASE + 4], P[BASE + 5]), b1 = cvtpk(P[BASE + 6], P[BASE + 7]);                              \
    auto r0 = __builtin_amdgcn_permlane32_swap(a0, b0, false, false); auto r1 = __builtin_amdgcn_permlane32_swap(a1, b1, false, false); \
    u32x4 w_ = {r0[0], r1[0], r0[1], r1[1]}; OUT = __builtin_bit_cast(bf16x8, w_); } while (0)
    ATT_PK4(p0, 0, pa0); ATT_PK4(p0, 8, pa1); ATT_PK4(p1, 0, pa2); ATT_PK4(p1, 8, pa3);
#undef ATT_PK4
}
__device__ __forceinline__ void attn_tables(Frame& F, LAS unsigned char* lds) {
    LAS float* tbl = (LAS float*)(lds + L_TBL);
    for (int i = F.tid; i < 8 * TBL_N; i += NWAVES * 64) { const int h = i / TBL_N, dist = 255 - (i % TBL_N); tbl[i] = dist >= 0 ? F.in[I_RELB][rel_bucket(dist) * 8 + h] * LOG2E : 0.f; }
    __syncthreads();
}
__device__ __forceinline__ void attn_unit(Frame& F, int b, int qb, LAS unsigned char* lds) {
    const int tid = F.tid, lane = F.lane, h = F.wave; int r32 = lane & 31, hi = lane >> 5;
    const int q0 = 32 * qb, NT = (qb >> 1) + 1; const size_t rowbase = (size_t)b * SEQ;
    LAS unsigned* msk = (LAS unsigned*)(lds + L_MASK); const LAS float* tbl = (const LAS float*)(lds + L_TBL); LAS float* rms = (LAS float*)(lds + L_RMS);
    bf16x8 qr[8];
    for (int prep_ = 0; prep_ < 1 + ((REP_MASK >> 21) & 1); ++prep_) {
#pragma unroll
    for (int i = 0; i < 4; ++i) { const int wd = tid + 512 * i; msk[(wd >> 6) * MROW + (wd & 63)] = F.MASK[(rowbase + q0 + (wd >> 6)) * 64 + (wd & 63)]; }
    {
        bf16x8 Bq[4];
        const bf16* qrow = F.PROJ + (rowbase + q0 + r32) * NPROJ + PQ + h * 64 + 8 * hi;
#pragma unroll
        for (int s = 0; s < 4; ++s) Bq[s] = *(const GAS bf16x8*)(qrow + 16 * s);
        const int ri = (r32 & 3) + 4 * (r32 >> 3), hii = (r32 >> 2) & 1;
#pragma unroll
        for (int cb = 0; cb < 4; ++cb) { const int c = 32 * cb + 16 * (ri >> 3) + 8 * hii + (ri & 7); const bf16* wrow = F.Wuk + ((size_t)c * 8 + h) * 64 + 8 * hi;
            f32x16 acc = {};
#pragma unroll
            for (int s = 0; s < 4; ++s) acc = __builtin_amdgcn_mfma_f32_32x32x16_bf16(*(const GAS bf16x8*)(wrow + 16 * s), Bq[s], acc, 0, 0, 0);
            qr[2 * cb] = pack8(acc, 0, 0.125f * LOG2E); qr[2 * cb + 1] = pack8(acc, 1, 0.125f * LOG2E); }
    }
    }
    const float b31 = F.in[I_RELB][31 * 8 + h] * LOG2E;
    int sr = tid >> 4, scol = (tid & 15) * 8; asm volatile("" : "+v"(sr), "+v"(scol));
    const int vst0 = v_st(sr, scol), vst1 = v_st(32 + sr, scol);
    const int vb0 = (int)(unsigned)(uintptr_t)(lds + L_V) + v_rd_base(lane);
    const bf16* kvb = F.KV + rowbase * CL + (size_t)sr * CL + scol;
    v4u st0, st1;
#define ATT_SLOAD(k0) do { st0 = *(const GAS v4u*)(kvb + (size_t)(k0) * CL); st1 = *(const GAS v4u*)(kvb + (size_t)((k0) + 32) * CL); } while (0)
#define ATT_SWRITE(bf) do { *(LAS v4u*)(lds + L_V + (bf) * 16384 + vst0) = st0; *(LAS v4u*)(lds + L_V + (bf) * 16384 + vst1) = st1; \
        *(LAS v4u*)(lds + L_K + (bf) * 16384 + ATT_KSWZ(sr, scol * 2)) = st0; *(LAS v4u*)(lds + L_K + (bf) * 16384 + ATT_KSWZ(32 + sr, scol * 2)) = st1; } while (0)
    float m_run = -INFINITY, l_run = 0.f; f32x16 o[4] = {};
    const LAS unsigned char* vp0 = lds + L_V + v_rd_base(lane);
    f32x16 pA0, pA1, pB0, pB1; float alA = 0.f, alB = 0.f; int w1A = 0, w1B = 0; bf16x8 pa0, pa1, pa2, pa3;
    int cur = 0, prv = 2 * 16384, nxt = 16384;
    const bf16* kvn = kvb + (size_t)64 * CL; const LAS unsigned* mp = msk + r32 * MROW; const LAS float* tbj = tbl + h * TBL_N + (255 - (q0 + r32) + 4 * hi);
    int kleft = q0 - 176;
#define ATT_ROT() do { const int t_ = prv; prv = cur; cur = nxt; nxt = t_; kvn += (size_t)64 * CL; mp += 2; tbj += 64; kleft -= 64; \
        asm volatile("" : "+v"(kvn), "+v"(mp), "+v"(tbj)); } while (0)
#define ATT_PARTIAL(P0, P1, AL, W1) do { const bool far_ = kleft >= 0; sm_partial(P0, P1, tbj, !far_, far_ ? b31 : 0.f, *(const LAS unsigned long long*)mp, hi, m_run, AL, W1); } while (0)
#define ATT_RESC(AL) do { if (__any((AL) < 1.f)) { _Pragma("unroll") for (int d_ = 0; d_ < 4; ++d_) _Pragma("unroll") for (int r_ = 0; r_ < 16; ++r_) o[d_][r_] *= (AL); } } while (0)
#define ATT_SLOADP() do { st0 = *(const GAS v4u*)kvn; st1 = *(const GAS v4u*)(kvn + (size_t)32 * CL); } while (0)
#define ATT_SWRITEO(off) do { *(LAS v4u*)(lds + L_V + (off) + vst0) = st0; *(LAS v4u*)(lds + L_V + (off) + vst1) = st1; \
        *(LAS v4u*)(lds + L_K + (off) + ATT_KSWZ(sr, scol * 2)) = st0; *(LAS v4u*)(lds + L_K + (off) + ATT_KSWZ(32 + sr, scol * 2)) = st1; } while (0)
#define ATT_STEP(C0, C1, ALC, W1C, P0, P1, ALP, W1P, more_) do { \
        ATT_SBAR(); qk_tile(C0, C1, lds + L_K + cur, qr, r32, hi); \
        sm_finish(P0, P1, W1P, ALP, l_run, pa0, pa1, pa2, pa3); \
        _Pragma("unroll") for (int i_ = 0; i_ < 16; ++i_) { __builtin_amdgcn_sched_group_barrier(0x008, 1, 0); __builtin_amdgcn_sched_group_barrier(0x100, 1, 0); __builtin_amdgcn_sched_group_barrier(0x002, 7, 0); } \
        ATT_SBAR(); \
        if (more_) ATT_SLOADP(); \
        pv_tile(o, vp0 + prv, pa0, pa1, pa2, pa3); \
        ATT_PARTIAL(C0, C1, ALC, W1C); \
        ATT_RESC(ALC); \
        if (more_) ATT_SWRITEO(nxt); \
        __syncthreads(); ATT_ROT(); } while (0)
    ATT_SLOAD(0); ATT_SWRITE(0); __syncthreads();
    if (NT > 1) ATT_SLOADP();
    qk_tile(pA0, pA1, lds + L_K, qr, r32, hi);
    ATT_PARTIAL(pA0, pA1, alA, w1A);
    if (NT > 1) ATT_SWRITEO(nxt);
    __syncthreads(); ATT_ROT();
    int j = 1;
    if (((NT - 1) & 1) != 0) {
        ATT_STEP(pB0, pB1, alB, w1B, pA0, pA1, alA, w1A, j + 1 < NT); pA0 = pB0; pA1 = pB1; alA = alB; w1A = w1B; ++j; }
#pragma unroll 1
    for (; j < NT; j += 2) {
        ATT_STEP(pB0, pB1, alB, w1B, pA0, pA1, alA, w1A, true);
        ATT_STEP(pA0, pA1, alA, w1A, pB0, pB1, alB, w1B, j + 2 < NT);
    }
    sm_finish(pA0, pA1, w1A, alA, l_run, pa0, pa1, pa2, pa3);
    pv_tile(o, vp0 + prv, pa0, pa1, pa2, pa3);
#undef ATT_STEP
#undef ATT_PARTIAL
#undef ATT_RESC
#undef ATT_ROT
#undef ATT_SLOADP
#undef ATT_SWRITEO
    for (int erep_ = 0; erep_ < 1 + ((REP_MASK >> 20) & 1); ++erep_) {
    const float inv = 1.f / l_run;
    { const int l2 = lane_now(); r32 = l2 & 31; hi = l2 >> 5; }
    f32x16 ot[2] = {};
    { const bf16* wf = F.WuvT + (size_t)h * 8192 + (size_t)lane_now() * 8;
      bf16x8 wfr[16];
#pragma unroll
      for (int f = 0; f < 16; ++f) wfr[f] = *(const GAS bf16x8*)(wf + f * 512);
#pragma unroll
      for (int cb = 0; cb < 4; ++cb)
#pragma unroll
          for (int s = 0; s < 2; ++s) { const bf16x8 Bo = pack8(o[cb], s, inv);
#pragma unroll
              for (int db = 0; db < 2; ++db) ot[db] = __builtin_amdgcn_mfma_f32_32x32x16_bf16(wfr[(db * 4 + cb) * 2 + s], Bo, ot[db], 0, 0, 0); } }
    float ss = 0.f;
#pragma unroll
    for (int r = 0; r < 16; ++r) ss += ot[0][r] * ot[0][r] + ot[1][r] * ot[1][r];
    { auto rr = __builtin_amdgcn_permlane32_swap(__float_as_uint(ss), __float_as_uint(ss), false, false); ss = __uint_as_float(rr[0]) + __uint_as_float(rr[1]); }
    if (hi == 0) rms[h * 32 + r32] = ss;
    __syncthreads();
    float tot = 0.f;
#pragma unroll
    for (int hh = 0; hh < 8; ++hh) tot += rms[hh * 32 + r32];
    const float rstd = 1.f / sqrtf(tot * (1.f / 512.f) + EPS);
    bf16* orow = F.MIX + (rowbase + q0 + r32) * D + h * 64 + 4 * hi; const float* gn = F.in[I_NATT] + h * 64 + 4 * hi;
#pragma unroll
    for (int db = 0; db < 2; ++db)
#pragma unroll
        for (int g4 = 0; g4 < 4; ++g4) { const int dd = 32 * db + 8 * g4; const f32x4 gv = *(const GAS f32x4*)(gn + dd);
            const unsigned x0 = cvtpk(ot[db][4 * g4] * rstd * gv.x, ot[db][4 * g4 + 1] * rstd * gv.y), x1 = cvtpk(ot[db][4 * g4 + 2] * rstd * gv.z, ot[db][4 * g4 + 3] * rstd * gv.w);
            *(GAS unsigned long long*)(orow + dd) = (unsigned long long)x0 | ((unsigned long long)x1 << 32); }
    if (erep_ + 1 < 1 + ((REP_MASK >> 20) & 1)) __syncthreads();
    }
    __syncthreads();
#undef ATT_SLOAD
#undef ATT_SWRITE
}
__device__ __forceinline__ void attn_phase(Frame& F) {
    attn_tables(F, F.lds + RING_OFF);
    for (int v2 = 2 * F.vcu; v2 < 512; v2 += 2 * F.G)
        for (int u = 0; u < 2 * (1 + ((REP_MASK >> 6) & 1)); ++u) { const int v = v2 >> 1, b = v >> 5, j = v & 31; attn_unit(F, b, (u & 1) ? j : 63 - j, F.lds + RING_OFF); }
}
#undef ATT_KSWZ
#undef ATT_SBAR
}

struct Args { const float* in[20]; float* out; unsigned char* ws; int ph_lo, ph_hi, li, pad; };
__global__ void __launch_bounds__(NWAVES * 64, 2) mk_fwd(Args args) {
    extern __shared__ __attribute__((aligned(16))) unsigned char lds[];
    Frame F;
    F.lds = (LAS unsigned char*)lds;
    F.MISC = (volatile LAS unsigned*)(F.lds + MISC_OFF);
    F.tid = threadIdx.x; F.lane = F.tid & 63; F.wave = __builtin_amdgcn_readfirstlane(F.tid >> 6);
    F.G = gridDim.x; { const int bx = blockIdx.x; F.vcu = (F.G % 8 == 0) ? (bx % 8) * (F.G / 8) + bx / 8 : bx; }
    unsigned char* ws = args.ws;
    F.ctl = (gu32*)(ws + WS_CTL);
#pragma unroll
    for (int i = 0; i < 20; ++i) F.in[i] = args.in[i];
    F.out = args.out;
    F.Wgu1 = (bf16*)(ws + WS_WGU1); F.Wd1 = (bf16*)(ws + WS_WD1); F.Win = (bf16*)(ws + WS_WIN); F.Wout = (bf16*)(ws + WS_WOUT); F.Wgu2 = (bf16*)(ws + WS_WGU2); F.Wd2 = (bf16*)(ws + WS_WD2);
    F.Wuk = (bf16*)(ws + WS_WUK); F.WuvT = (bf16*)(ws + WS_WUV);
    F.XN = (bf16*)(ws + WS_XN); F.MIX = (bf16*)(ws + WS_MIX); F.KV = (bf16*)(ws + WS_KV); F.ACT = (bf16*)(ws + WS_ACT); F.PROJ = (bf16*)(ws + WS_ACT); F.MASK = (unsigned*)(ws + WS_MASK); F.SS = (float*)(ws + WS_SS); F.HB = (bf16*)(ws + WS_HB);
    for (int u = F.tid; u < (LDS_BYTES - LDSCTL_OFF) / 4; u += NWAVES * 64) ((LAS unsigned*)(F.lds + LDSCTL_OFF))[u] = 0u;
    __syncthreads();
    XcdBarrier bar; bar.bar = (unsigned*)(F.ctl + CW_BAR); bar.x = 0; bar.st = nullptr;
    if (N_LAUNCHES != PER_PHASE) bar = xcd_barrier_post((unsigned*)(F.ctl + CW_BAR), F.MISC + 8);

    const int lo = args.ph_lo, hi = args.ph_hi;
#ifndef PH_MASK
#define PH_MASK 0xFFF
#endif
#define IN(k) (((PH_MASK >> (k)) & 1) && lo <= (k) && (k) < hi && (F.lane = lane_now(), F.tid = F.wave * 64 + F.lane, true))
#define SEAM(k) do { if (IN(k) && (k) + 1 < hi) { xcd_barrier(bar, F.wave); if (REP_MASK & 0x2000) xcd_barrier(bar, F.wave); } } while (0)

    if (IN(0)) { p0_prologue(F); if (REP_MASK & 1) { VM_WAIT(); __syncthreads(); p0_prologue(F); } SEAM(0); }
    if (IN(1)) { pg8::Gemm g{F.XN, F.Wgu1, M, FF2, FFN1_FP8 ? D / 2 : D}; pg8::StaticOrder S; S.init(M, FF2, F.G, (int)blockIdx.x, 1 + ((REP_MASK >> 1) & 1));
        pg8::rstd_table((LAS float*)(F.lds + RTAB_OFF), S, F.SS, 1.0f / D, EPS, F.wave);
        pg8::EpiSwiglu<FFN1_FP8 != 0> E{F.ACT, FF, (const LAS float*)(F.lds + RTAB_OFF), FFN1_FP8 ? 1.0f / WSC_GU : 1.0f};
        pg8::gemm_phase<pg8::EpiSwiglu<FFN1_FP8 != 0>, pg8::StaticOrder, PG8_ALIGN, PG8_SP2, FFN1_FP8 != 0>(F.lds + RING_OFF, g, S, E, F.wave);
        if (late_weights(F) && blockIdx.x >= 128) weight_items<1>(F, ((int)blockIdx.x - 128) * NWAVES + F.wave, 128 * NWAVES);
        SEAM(1); }
    if (IN(2)) { pg8::Gemm g{F.ACT, F.Wd1, M, D, FFN1_FP8 ? FF / 2 : FF}; pg8::StaticOrder S; S.init(M, D, F.G, (int)blockIdx.x, 1 + ((REP_MASK >> 2) & 1));
        pg8::EpiRes2<false, false, true> E{F.in[I_X], F.HB, nullptr, F.SS, D, FFN1_FP8 ? 0.5f / WSC_DN : 0.5f};
        pg8::gemm_phase<pg8::EpiRes2<false, false, true>, pg8::StaticOrder, PG8_ALIGN, PG8_SP2, FFN1_FP8 != 0>(F.lds + RING_OFF, g, S, E, F.wave); SEAM(2); }
    if (IN(4)) { pg8::Gemm g{F.HB, F.Win, M, NPROJ, D}; pg8::StaticOrder S; S.init(M, NPROJ, F.G, (int)blockIdx.x, 1 + ((REP_MASK >> 4) & 1));
        pg8::rstd_table((LAS float*)(F.lds + RTAB_OFF), S, F.SS, 1.0f / D, EPS, F.wave);
        pg8::EpiBf16Rs E{F.PROJ, NPROJ, (const LAS float*)(F.lds + RTAB_OFF)};
        pg8::gemm_phase<pg8::EpiBf16Rs, pg8::StaticOrder, PG8_ALIGN, PG8_SP2>(F.lds + RING_OFF, g, S, E, F.wave); SEAM(4); }
#ifndef USE_NAIVE_ATTN
#define USE_NAIVE_ATTN 0
#endif
    if (IN(5)) { prep_phase(F); if (REP_MASK & 0x1000) prep_phase(F); if (!USE_NAIVE_ATTN) idx::idx_phase(F); SEAM(5); }
    if (IN(6)) { if (USE_NAIVE_ATTN) naive_attn_phase(F); else att::attn_phase(F); SEAM(6); }
    if (IN(7)) { pg8::Gemm g{F.MIX, F.Wout, M, D, D}; pg8::StaticOrder S; S.init(M, D, F.G, (int)blockIdx.x);
        pg8::EpiRes2<true, true, true> E{F.HB, F.HB, (unsigned char*)F.XN, F.SS, D, 1.0f};
        pg8::gemm_phase<pg8::EpiRes2<true, true, true>, pg8::StaticOrder, PG8_ALIGN, PG8_SP2>(F.lds + RING_OFF, g, S, E, F.wave); SEAM(7); }
    if (IN(9)) { pg8::Gemm g{F.XN, F.Wgu2, M, FF2, D / 2}; pg8::StaticOrder S; S.init(M, FF2, F.G, (int)blockIdx.x);
        pg8::rstd_table((LAS float*)(F.lds + RTAB_OFF), S, F.SS, 1.0f / D, EPS, F.wave);
        pg8::EpiSwiglu<true> E{F.ACT, FF, (const LAS float*)(F.lds + RTAB_OFF), 1.0f / WSC_GU};
        pg8::gemm_phase<pg8::EpiSwiglu<true>, pg8::StaticOrder, PG8_ALIGN, PG8_SP2, true>(F.lds + RING_OFF, g, S, E, F.wave); SEAM(9); }
    if (IN(10)) { pg8::Gemm g{F.ACT, F.Wd2, M, D, FF / 2}; pg8::StaticOrder S; S.init(M, D, F.G, (int)blockIdx.x);
        pg8::EpiRes2<true, false, false> E{F.HB, F.HB, nullptr, nullptr, D, 0.5f / WSC_DN};
        pg8::gemm_phase<pg8::EpiRes2<true, false, false>, pg8::StaticOrder, PG8_ALIGN, PG8_SP2, true>(F.lds + RING_OFF, g, S, E, F.wave); SEAM(10); }
    if (IN(11)) { const bool poison = __hip_atomic_load((gu32*)(F.ctl + CW_BAR + XB_TMO), RLX_AGENT) != 0u;
        const int gw = F.vcu * NWAVES + F.wave, NGW = F.G * NWAVES;
        for (int m = gw; m < M; m += 4 * NGW) { const int rows[4] = {m, min(m + NGW, M - 1), min(m + 2 * NGW, M - 1), min(m + 3 * NGW, M - 1)}; rows4_bf16_to_f32((int)__builtin_amdgcn_mbcnt_hi(~0u, __builtin_amdgcn_mbcnt_lo(~0u, 0u)), F.HB, F.in[I_NF], F.out, rows, poison); } }
#undef IN
#undef SEAM
}

extern "C" void kernel_launch(void* const* d_in, const int* in_sizes, int n_in, void* d_out, int out_size, void* d_ws, size_t ws_size, hipStream_t stream) {
    static int grid = 0;
    if (grid == 0) {
        if (n_in != 20 || in_sizes[0] != M * D || out_size != M * D || ws_size < WS_END) { fprintf(stderr, "kernel_launch: shape mismatch (n_in %d, in0 %d, out %d, ws %zu); nothing launched\n", n_in, n_in > 0 ? in_sizes[0] : -1, out_size, ws_size); grid = -1; return; }
        int dev = 0, cus = 0, per_cu = 0;
        if (hipGetDevice(&dev) != hipSuccess || hipDeviceGetAttribute(&cus, hipDeviceAttributeMultiprocessorCount, dev) != hipSuccess) { fprintf(stderr, "kernel_launch: hipGetDevice / hipDeviceGetAttribute failed\n"); grid = -1; return; }
        if (hipFuncSetAttribute((const void*)mk_fwd, hipFuncAttributeMaxDynamicSharedMemorySize, LDS_BYTES) != hipSuccess) { fprintf(stderr, "kernel_launch: hipFuncSetAttribute failed\n"); grid = -1; return; }
        if (hipOccupancyMaxActiveBlocksPerMultiprocessor(&per_cu, (const void*)mk_fwd, NWAVES * 64, LDS_BYTES) != hipSuccess || per_cu < 1)
            fprintf(stderr, "kernel_launch: note: occupancy query reports %d workgroups per CU\n", per_cu);
        (void)hipGetLastError();
        grid = cus;
    }
    if (grid < 0) return;
    if (hipMemsetAsync((char*)d_ws + WS_CTL, 0, CTL_ZERO_BYTES, stream) != hipSuccess) { fprintf(stderr, "kernel_launch: hipMemsetAsync failed\n"); return; }
    Args a{};
    for (int i = 0; i < 20; ++i) a.in[i] = (const float*)d_in[i];
    a.out = (float*)d_out; a.ws = (unsigned char*)d_ws;
    for (int li = 0; li < N_LAUNCHES; ++li) {
        a.ph_lo = (N_LAUNCHES == PER_PHASE) ? li : 0; a.ph_hi = (N_LAUNCHES == PER_PHASE) ? li + 1 : PER_PHASE; a.li = li;
        hipLaunchKernelGGL(mk_fwd, dim3(grid), dim3(NWAVES * 64), LDS_BYTES, stream, a);
        const hipError_t le = hipPeekAtLastError();
        if (le != hipSuccess) { fprintf(stderr, "kernel_launch: launch %d failed: %s\n", li, hipGetErrorName(le)); break; }
    }
}
```
